# Optimizing an MI355X kernel written in HIP

```python
import math
import jax, jax.numpy as jnp
from jax import lax
import numpy as np

D_MODEL = 2048
BATCH = 4
SEQ = 4096
DEPTH = 2

GRID_W = 64
CTX_LEN = 256
D_MIX = D_MODEL
RET_HEADS = 4
RET_DK = 128
RET_DV = 128
RET_W = RET_HEADS * RET_DV
ATT_HEADS = 4
ATT_KV_HEADS = 2
ATT_HD = 128
ATT_W = ATT_HEADS * ATT_HD
WINDOW = 128
ATT_BLOCK = 128
SSD_HEADS = 16
SSD_HD = 64
SSD_W = SSD_HEADS * SSD_HD
SSD_GROUPS = 2
SSD_STATE = 128
SSD_CONV = 3
CHUNK = 128
D_FF = 5632
FFN_RES = 0.5
ROPE_BASE = 10000.0
NORM_EPS = 1e-6
N_MOD = 9

RET_QK_W = RET_HEADS * RET_DK
RET_COLS = 2 * RET_QK_W + 2 * RET_W
ATT_KV_W = ATT_KV_HEADS * ATT_HD
ATT_COLS = ATT_W + 2 * ATT_KV_W
SSD_BC_W = SSD_GROUPS * SSD_STATE
SSD_CONV_CH = SSD_W + 2 * SSD_BC_W
SSD_COLS = SSD_W + SSD_CONV_CH + 2 * SSD_HEADS
IN_COLS = RET_COLS + ATT_COLS + SSD_COLS

kernel_name = "hybrid_retention_swa_ssd_macaron_dit"

F32 = jnp.float32


def rmsnorm(x, w):
    xf = x.astype(F32)
    y = xf * lax.rsqrt(jnp.mean(xf * xf, axis=-1, keepdims=True) + NORM_EPS)
    return (y * w.astype(F32)).astype(x.dtype)


def adaln(cond, w, b):
    return (jax.nn.silu(cond) @ w + b).reshape(cond.shape[0], N_MOD, D_MODEL)


def modulated_norm(x, mod, i, w):
    h = rmsnorm(x, w)
    return h * (1.0 + mod[:, 3 * i + 1, None, :]) + mod[:, 3 * i, None, :]


def gated_residual(x, y, mod, i, w, weight):
    return x + weight * mod[:, 3 * i + 2, None, :] * rmsnorm(y, w)


def swiglu(h, w_gu, w_down):
    g, u = jnp.split(h @ w_gu, 2, axis=-1)
    return (jax.nn.silu(g) * u) @ w_down


def ffn_sublayer(x, mod, i, nw, w_gu, w_down):
    h = modulated_norm(x, mod, i, nw[2 * i])
    return gated_residual(x, swiglu(h, w_gu, w_down), mod, i, nw[2 * i + 1], FFN_RES)


def flip_t(a):
    return jnp.flip(a, axis=1)


def rope_half(x, ang):
    cos = jnp.cos(ang)[:, None, :]
    sin = jnp.sin(ang)[:, None, :]
    x1, x2 = jnp.split(x.astype(F32), 2, axis=-1)
    return jnp.concatenate([x1 * cos - x2 * sin, x1 * sin + x2 * cos], axis=-1)


def axial_rope(x, row, col):
    half = x.shape[-1] // 2
    freqs = ROPE_BASE ** (-jnp.arange(0, half, 2, dtype=F32) / half)
    xr = rope_half(x[..., :half], row.astype(F32)[:, None] * freqs[None, :])
    xc = rope_half(x[..., half:], col.astype(F32)[:, None] * freqs[None, :])
    return jnp.concatenate([xr, xc], axis=-1).astype(x.dtype)


def retention_scan(q, k, v, log_g, s0):
    b, t, h, dk = q.shape
    dv = v.shape[-1]
    n = t // CHUNK
    qc = q.reshape(b, n, CHUNK, h, dk)
    kc = k.reshape(b, n, CHUNK, h, dk)
    vc = v.reshape(b, n, CHUNK, h, dv)
    idx = jnp.arange(CHUNK, dtype=F32)
    rel = idx[:, None] - idx[None, :]
    dmask = jnp.where(rel >= 0, jnp.exp(log_g[:, None, None] * jnp.maximum(rel, 0.0)), 0.0)
    inner = jnp.einsum('bnihd,bnjhd->bnhij', qc, kc) * dmask
    y_intra = jnp.einsum('bnhij,bnjhe->bnihe', inner, vc)
    k_decay = jnp.exp(log_g[:, None] * (CHUNK - 1.0 - idx)[None, :])
    contrib = jnp.einsum('bnjhd,hj,bnjhe->bnhde', kc, k_decay, vc)
    chunk_decay = jnp.exp(log_g * CHUNK)[None, :, None, None]

    def step(s, u):
        return s * chunk_decay + u, s

    s_final, s_prev = lax.scan(step, s0, jnp.moveaxis(contrib, 1, 0))
    s_prev = jnp.moveaxis(s_prev, 0, 1)
    q_decay = jnp.exp(log_g[:, None] * (idx + 1.0)[None, :])
    y_cross = jnp.einsum('bnihd,hi,bnhde->bnihe', qc, q_decay, s_prev)
    return (y_intra + y_cross).reshape(b, t, h, dv), s_final


def retention_scan_rev(q, k, v, log_g, s0):
    y, s = retention_scan(flip_t(q), flip_t(k), flip_t(v), log_g, s0)
    return flip_t(y), s


def retention_heads(p):
    b, t = p.shape[:2]
    q = p[..., :RET_QK_W].reshape(b, t, RET_HEADS, RET_DK).astype(F32) * RET_DK ** -0.5
    k = p[..., RET_QK_W:2 * RET_QK_W].reshape(b, t, RET_HEADS, RET_DK).astype(F32)
    v = p[..., 2 * RET_QK_W:2 * RET_QK_W + RET_W].reshape(b, t, RET_HEADS, RET_DV).astype(F32)
    g = p[..., 2 * RET_QK_W + RET_W:]
    return q, k, v, g


def retention_out(y, g, norm_w, dtype):
    b, t = y.shape[:2]
    mu = jnp.mean(y, axis=-1, keepdims=True)
    var = jnp.mean(jnp.square(y - mu), axis=-1, keepdims=True)
    yn = ((y - mu) * lax.rsqrt(var + NORM_EPS)).reshape(b, t, RET_W) * norm_w.astype(F32)
    return (yn * jax.nn.silu(g.astype(F32))).astype(dtype)


def retention_group(pl, pc, log_decay, norm_w, ctx_out):
    lg = -jnp.abs(log_decay.astype(F32))
    ql, kl, vl, gl = retention_heads(pl)
    qc, kc, vc, gc = retention_heads(pc)
    s0 = jnp.zeros((pc.shape[0], RET_HEADS, RET_DK, RET_DV), F32)
    yc_f, s_f = retention_scan(qc, kc, vc, lg[0], s0)
    yc_b, s_b = retention_scan_rev(qc, kc, vc, lg[1], s0)
    yl_f, _ = retention_scan(ql, kl, vl, lg[0], s_f)
    yl_b, _ = retention_scan_rev(ql, kl, vl, lg[1], s_b)
    out_l = retention_out(yl_f + yl_b, gl, norm_w, pl.dtype)
    out_c = retention_out(yc_f + yc_b, gc, norm_w, pc.dtype) if ctx_out else None
    return out_l, out_c


def window_gqa_group(pl, pc, sink, row, col, ctx_out):
    b, t = pl.shape[:2]
    n_ctx = pc.shape[1]
    grp = ATT_HEADS // ATT_KV_HEADS
    scale = ATT_HD ** -0.5
    ql = axial_rope(pl[..., :ATT_W].reshape(b, t, ATT_HEADS, ATT_HD), row, col)
    kl = axial_rope(pl[..., ATT_W:ATT_W + ATT_KV_W].reshape(b, t, ATT_KV_HEADS, ATT_HD), row, col)
    vl = pl[..., ATT_W + ATT_KV_W:].reshape(b, t, ATT_KV_HEADS, ATT_HD)
    kc = pc[..., ATT_W:ATT_W + ATT_KV_W].reshape(b, n_ctx, ATT_KV_HEADS, ATT_HD)
    vc = pc[..., ATT_W + ATT_KV_W:].reshape(b, n_ctx, ATT_KV_HEADS, ATT_HD)
    sink = sink.astype(F32).reshape(ATT_KV_HEADS, grp)

    nb = t // ATT_BLOCK
    qb = ql.reshape(b, nb, ATT_BLOCK, ATT_KV_HEADS, grp, ATT_HD)
    pad = ((0, 0), (ATT_BLOCK, ATT_BLOCK), (0, 0), (0, 0))
    kp = jnp.pad(kl, pad).reshape(b, nb + 2, ATT_BLOCK, ATT_KV_HEADS, ATT_HD)
    vp = jnp.pad(vl, pad).reshape(b, nb + 2, ATT_BLOCK, ATT_KV_HEADS, ATT_HD)
    kw = jnp.concatenate([kp[:, :-2], kp[:, 1:-1], kp[:, 2:]], axis=2)
    vw = jnp.concatenate([vp[:, :-2], vp[:, 1:-1], vp[:, 2:]], axis=2)
    s_loc = jnp.einsum('bnihgd,bnjhd->bnhgij', qb, kw, preferred_element_type=F32) * scale
    s_cx = jnp.einsum('bnihgd,bjhd->bnhgij', qb, kc, preferred_element_type=F32) * scale
    blk = jnp.arange(nb)
    qpos = blk[:, None] * ATT_BLOCK + jnp.arange(ATT_BLOCK)[None, :]
    kpos = (blk[:, None] - 1) * ATT_BLOCK + jnp.arange(3 * ATT_BLOCK)[None, :]
    valid = ((jnp.abs(kpos[:, None, :] - qpos[:, :, None]) <= WINDOW)
             & (kpos[:, None, :] >= 0) & (kpos[:, None, :] < t))
    s_loc = jnp.where(valid[None, :, None, None], s_loc, -jnp.inf)
    sink_col = jnp.broadcast_to(sink[None, None, :, :, None, None], s_loc.shape[:-1] + (1,))
    p = jax.nn.softmax(jnp.concatenate([s_loc, s_cx, sink_col], axis=-1), axis=-1)
    w3 = 3 * ATT_BLOCK
    o = (jnp.einsum('bnhgij,bnjhd->bnihgd', p[..., :w3].astype(vl.dtype), vw)
         + jnp.einsum('bnhgij,bjhd->bnihgd', p[..., w3:w3 + n_ctx].astype(vl.dtype), vc))
    out_l = o.reshape(b, t, ATT_W)

    out_c = None
    if ctx_out:
        qc = pc[..., :ATT_W].reshape(b, n_ctx, ATT_KV_HEADS, grp, ATT_HD)
        sc = jnp.einsum('bihgd,bjhd->bhgij', qc, kc, preferred_element_type=F32) * scale
        sink_c = jnp.broadcast_to(sink[None, :, :, None, None], sc.shape[:-1] + (1,))
        pcx = jax.nn.softmax(jnp.concatenate([sc, sink_c], axis=-1), axis=-1)
        oc = jnp.einsum('bhgij,bjhd->bihgd', pcx[..., :n_ctx].astype(vc.dtype), vc)
        out_c = oc.reshape(b, n_ctx, ATT_W)
    return out_l, out_c


def dwconv_silu(u, w, bias):
    k = w.shape[0]
    y = lax.conv_general_dilated(u, w[:, None, :], window_strides=(1,),
                                 padding=((k // 2, k // 2),),
                                 dimension_numbers=('NWC', 'WIO', 'NWC'),
                                 feature_group_count=u.shape[-1])
    return jax.nn.silu(y + bias)


def ssd_scan(x, dt, a, bm, cm, s0):
    b, t, h, p = x.shape
    g, n = bm.shape[2], bm.shape[3]
    r = h // g
    nc = t // CHUNK
    xc = (x * dt[..., None]).reshape(b, nc, CHUNK, g, r, p)
    la = (dt * a[None, None, :]).reshape(b, nc, CHUNK, g, r)
    acum = jnp.cumsum(la, axis=2)
    bc = bm.reshape(b, nc, CHUNK, g, n)
    cc = cm.reshape(b, nc, CHUNK, g, n)
    tri = jnp.tril(jnp.ones((CHUNK, CHUNK), dtype=bool))[None, None, :, :, None, None]
    diff = acum[:, :, :, None] - acum[:, :, None, :]
    lmat = jnp.exp(jnp.where(tri, diff, -jnp.inf))
    cb = jnp.einsum('bclgn,bcsgn->bclsg', cc, bc)
    y_diag = jnp.einsum('bclsgr,bcsgrp->bclgrp', cb[..., None] * lmat, xc)
    decay_states = jnp.exp(acum[:, :, -1:] - acum)
    states = jnp.einsum('bclgn,bclgrp->bcgrpn', bc, xc * decay_states[..., None])
    chunk_decay = jnp.exp(acum[:, :, -1])

    def step(s, inp):
        u, dcy = inp
        return s * dcy[..., None, None] + u, s

    s_final, s_prev = lax.scan(step, s0, (jnp.moveaxis(states, 1, 0), jnp.moveaxis(chunk_decay, 1, 0)))
    s_prev = jnp.moveaxis(s_prev, 0, 1)
    y_off = jnp.einsum('bclgn,bcgrpn->bclgrp', cc, s_prev) * jnp.exp(acum)[..., None]
    return (y_diag + y_off).reshape(b, t, h, p), s_final


def ssd_scan_rev(x, dt, a, bm, cm, s0):
    y, s = ssd_scan(flip_t(x), flip_t(dt), a, flip_t(bm), flip_t(cm), s0)
    return flip_t(y), s


def ssd_prep(p, conv_w, conv_b, dt_bias):
    b, t = p.shape[:2]
    z = p[..., :SSD_W]
    xbc = dwconv_silu(p[..., SSD_W:SSD_W + SSD_CONV_CH], conv_w, conv_b)
    xs = xbc[..., :SSD_W].reshape(b, t, SSD_HEADS, SSD_HD).astype(F32)
    bm = xbc[..., SSD_W:SSD_W + SSD_BC_W].reshape(b, t, SSD_GROUPS, SSD_STATE).astype(F32)
    cm = xbc[..., SSD_W + SSD_BC_W:].reshape(b, t, SSD_GROUPS, SSD_STATE).astype(F32)
    dt = jax.nn.softplus(p[..., SSD_W + SSD_CONV_CH:].reshape(b, t, 2, SSD_HEADS).astype(F32)
                         + dt_bias.astype(F32))
    return z, xs, bm, cm, dt


def ssd_out(y, xs, z, d_skip, norm_w):
    b, t = y.shape[:2]
    y = (y + d_skip.astype(F32)[:, None] * xs).reshape(b, t, SSD_W) * jax.nn.silu(z.astype(F32))
    return rmsnorm(y, norm_w).astype(z.dtype)


def ssd_group(pl, pc, conv_w, conv_b, a_log, dt_bias, d_skip, norm_w, ctx_out):
    a = -jnp.exp(a_log.astype(F32))
    zl, xl, bl, cl, dtl = ssd_prep(pl, conv_w, conv_b, dt_bias)
    zc, xc, bc, cc, dtc = ssd_prep(pc, conv_w, conv_b, dt_bias)
    s0 = jnp.zeros((pc.shape[0], SSD_GROUPS, SSD_HEADS // SSD_GROUPS, SSD_HD, SSD_STATE), F32)
    yc_f, s_f = ssd_scan(xc, dtc[:, :, 0], a[0], bc, cc, s0)
    yc_b, s_b = ssd_scan_rev(xc, dtc[:, :, 1], a[1], bc, cc, s0)
    yl_f, _ = ssd_scan(xl, dtl[:, :, 0], a[0], bl, cl, s_f)
    yl_b, _ = ssd_scan_rev(xl, dtl[:, :, 1], a[1], bl, cl, s_b)
    out_l = ssd_out(yl_f + yl_b, xl, zl, d_skip, norm_w)
    out_c = ssd_out(yc_f + yc_b, xc, zc, d_skip, norm_w) if ctx_out else None
    return out_l, out_c


def parallel_mixer(hl, hc, w_in, w_out, ret_log_decay, ret_norm_w, attn_sink,
                   conv_w, conv_b, a_log, dt_bias, d_skip, ssd_norm_w, row, col, ctx_out):
    pl = hl @ w_in
    pc = hc @ w_in
    c1, c2 = RET_COLS, RET_COLS + ATT_COLS
    ra_l, ra_c = retention_group(pl[..., :c1], pc[..., :c1], ret_log_decay, ret_norm_w, ctx_out)
    at_l, at_c = window_gqa_group(pl[..., c1:c2], pc[..., c1:c2], attn_sink, row, col, ctx_out)
    ss_l, ss_c = ssd_group(pl[..., c2:], pc[..., c2:], conv_w, conv_b, a_log, dt_bias,
                           d_skip, ssd_norm_w, ctx_out)
    yl = jnp.concatenate([ra_l, at_l, ss_l], axis=-1) @ w_out
    yc = jnp.concatenate([ra_c, at_c, ss_c], axis=-1) @ w_out if ctx_out else None
    return yl, yc


def setup_inputs(seed: int = 0) -> dict:
    key = jax.random.key(seed)
    ks = jax.random.split(key, 24)

    def nrm(k, shape, s):
        return jax.random.normal(k, shape, F32) * s

    L = DEPTH
    ret_base = jnp.asarray(np.log1p(-2.0 ** (-5.0 - np.arange(RET_HEADS))), dtype=F32)
    dt0 = jnp.exp(jax.random.uniform(ks[19], (L, 2, SSD_HEADS), F32, math.log(1e-3), math.log(1e-1)))
    return {
        "x": nrm(ks[0], (BATCH, SEQ, D_MODEL), 1.0),
        "c": nrm(ks[1], (BATCH, D_MODEL), 1.0),
        "ctx": nrm(ks[2], (BATCH, CTX_LEN, D_MODEL), 1.0),
        "c_ctx": nrm(ks[3], (D_MODEL,), 1.0),
        "w_ada": nrm(ks[4], (L, D_MODEL, N_MOD * D_MODEL), 0.5 * D_MODEL ** -0.5),
        "b_ada": nrm(ks[5], (L, N_MOD * D_MODEL), 0.02),
        "norm_w": 1.0 + nrm(ks[6], (L, 6, D_MODEL), 0.05),
        "ffn1_gu": nrm(ks[7], (L, D_MODEL, 2 * D_FF), D_MODEL ** -0.5),
        "ffn1_down": nrm(ks[8], (L, D_FF, D_MODEL), D_FF ** -0.5),
        "ffn2_gu": nrm(ks[9], (L, D_MODEL, 2 * D_FF), D_MODEL ** -0.5),
        "ffn2_down": nrm(ks[10], (L, D_FF, D_MODEL), D_FF ** -0.5),
        "w_in": nrm(ks[11], (L, D_MODEL, IN_COLS), D_MODEL ** -0.5),
        "w_out": nrm(ks[12], (L, D_MIX, D_MODEL), D_MIX ** -0.5),
        "ret_log_decay": ret_base[None, None, :] * (1.0 + nrm(ks[13], (L, 2, RET_HEADS), 0.05)),
        "ret_norm_w": 1.0 + nrm(ks[14], (L, RET_W), 0.05),
        "attn_sink": nrm(ks[15], (L, ATT_HEADS), 0.5),
        "ssd_conv_w": nrm(ks[16], (L, SSD_CONV, SSD_CONV_CH), SSD_CONV ** -0.5),
        "ssd_conv_b": nrm(ks[17], (L, SSD_CONV_CH), 0.02),
        "ssd_a_log": jnp.log(jax.random.uniform(ks[18], (L, 2, SSD_HEADS), F32, 1.0, 16.0)),
        "ssd_dt_bias": dt0 + jnp.log(-jnp.expm1(-dt0)),
        "ssd_d": 1.0 + nrm(ks[20], (L, SSD_HEADS), 0.05),
        "ssd_norm_w": 1.0 + nrm(ks[21], (L, SSD_W), 0.05),
    }


def reference(x, c, ctx, c_ctx, w_ada, b_ada, norm_w, ffn1_gu, ffn1_down, ffn2_gu, ffn2_down,
              w_in, w_out, ret_log_decay, ret_norm_w, attn_sink, ssd_conv_w, ssd_conv_b,
              ssd_a_log, ssd_dt_bias, ssd_d, ssd_norm_w):
    t = x.shape[1]
    rows = t // GRID_W
    row = jnp.repeat(jnp.arange(rows), GRID_W)
    col = jnp.tile(jnp.arange(GRID_W), rows)
    xl, xc = x, ctx
    for layer in range(DEPTH):
        last = layer == DEPTH - 1
        nw = norm_w[layer]
        mod_l = adaln(c, w_ada[layer], b_ada[layer])
        mod_c = adaln(c_ctx[None, :], w_ada[layer], b_ada[layer])
        xl = ffn_sublayer(xl, mod_l, 0, nw, ffn1_gu[layer], ffn1_down[layer])
        xc = ffn_sublayer(xc, mod_c, 0, nw, ffn1_gu[layer], ffn1_down[layer])
        hl = modulated_norm(xl, mod_l, 1, nw[2])
        hc = modulated_norm(xc, mod_c, 1, nw[2])
        yl, yc = parallel_mixer(hl, hc, w_in[layer], w_out[layer], ret_log_decay[layer],
                                ret_norm_w[layer], attn_sink[layer], ssd_conv_w[layer],
                                ssd_conv_b[layer], ssd_a_log[layer], ssd_dt_bias[layer],
                                ssd_d[layer], ssd_norm_w[layer], row, col, not last)
        xl = gated_residual(xl, yl, mod_l, 1, nw[3], 1.0)
        xl = ffn_sublayer(xl, mod_l, 2, nw, ffn2_gu[layer], ffn2_down[layer])
        if not last:
            xc = gated_residual(xc, yc, mod_c, 1, nw[3], 1.0)
            xc = ffn_sublayer(xc, mod_c, 2, nw, ffn2_gu[layer], ffn2_down[layer])
    return xl
```

```cpp
#include <hip/hip_runtime.h>
#include <cstdio>
#include <cstdint>
#include <cmath>
namespace pg8 {
#define PG8_LAS __attribute__((address_space(3)))
typedef unsigned short bf16_t;
typedef short bf16x8 __attribute__((ext_vector_type(8)));
typedef float f32x4 __attribute__((ext_vector_type(4)));
typedef unsigned u32x4 __attribute__((ext_vector_type(4)));
constexpr int BM = 256, BK = 64, HALF = 128, HTB = HALF * BK * 2  , STAGE_BYTES = 8 * HTB, NXCD = 8, WGM = 4;

#ifndef PG8_SWZ128
#define PG8_SWZ128 0
#endif
#if PG8_SWZ128
__host__ __device__ __forceinline__ int lds_sw(int r) { return (r & 7) ^ ((r >> 3) & 1); }
__host__ __device__ __forceinline__ int lds_byte(int r, int c) { return (r >> 3) * 1024 + (r & 7) * 128 + ((((c >> 3) ^ lds_sw(r)) & 7) << 4) + (c & 7) * 2; }
__host__ __device__ __forceinline__ void stage_rc(int b, int& R, int& C) { R = (b >> 10) * 8 + ((b >> 7) & 7); C = ((((b >> 4) & 7) ^ lds_sw(R)) << 3) + ((b & 15) >> 1); }
#else
__host__ __device__ __forceinline__ int lds_byte(int r, int c) { const int st = (r >> 4) * 2 + (c >> 5), rr = r & 15, cc = c & 31, ob = rr * 64 + cc * 2; return st * 1024 + (ob ^ (((ob >> 9) & 1) << 5)); }
__host__ __device__ __forceinline__ void stage_rc(int b, int& R, int& C) { const int st = b / 1024, sb = b % 1024, swz = sb ^ (((sb >> 9) & 1) << 5); R = (st >> 1) * 16 + swz / 64; C = (st & 1) * 32 + (swz % 64) / 2; }
#endif
__host__ __device__ __forceinline__ int perm32(int rho) { const int n = rho >> 4, i = rho & 15; return 8 * (i >> 2) + 4 * n + (i & 3); }

struct Unit { int pm, pn, kt0, nt, part; };
struct Gemm { const bf16_t* A; const bf16_t* Bt; int lda, K; };

struct StaticOrder {
    int nM, nN, nwg, G, c, ntk, nMt, S;
    __host__ __device__ void init(int Mfull, int N, int K, int G_, int c_, int Mtail = 0, int S_ = 1) { nM = Mfull / BM; nN = N / BM; nwg = nM * nN; G = G_; c = c_; ntk = K / BK; nMt = Mtail / BM; S = S_; }
    __host__ __device__ bool next(int i, Unit& u) const {
        const long L = (long)i * G + c; int pm, pn, kt0 = 0, nt = ntk, part = -1;
        if (L >= nwg) { const int t = (int)(L - nwg); if (t >= nMt * nN * S) return false;
            const int s = t % S, q = t / S; pn = q % nN; pm = nM + q / nN; nt = ntk / S; kt0 = s * nt; part = s; }
        else { int wgid = (int)L; { const int q = nwg / NXCD, r = nwg % NXCD, xcd = wgid % NXCD, off = wgid / NXCD; wgid = (xcd < r ? xcd * (q + 1) : r * (q + 1) + (xcd - r) * q) + off; }
            const int nig = WGM * nN, gid = wgid / nig, fm = gid * WGM, gsz = (nM - fm) < WGM ? (nM - fm) : WGM;
            pm = fm + ((wgid % nig) % gsz); pn = (wgid % nig) / gsz; }
        u.pm = pm; u.pn = pn; u.kt0 = kt0; u.nt = nt; u.part = part; return true;
    }
    __device__ __forceinline__ void a_ready(const Unit&) const {}
    __device__ __forceinline__ void done(const Unit&) const {}
};


__device__ __forceinline__ unsigned cvt_pk_bf16(float lo, float hi) { unsigned r; asm volatile("v_cvt_pk_bf16_f32 %0, %1, %2" : "=v"(r) : "v"(lo), "v"(hi)); return r; }
__device__ __forceinline__ float silu_f(float x) { return x * __builtin_amdgcn_rcpf(1.0f + __builtin_amdgcn_exp2f(x * -1.44269504089f)); }

struct EpiF32 {
    static constexpr bool PERM = false, AFTER_DRAIN = false;
    float* C; int ldc; float* Cpart; int tail_row0, tail_rows;
    __device__ __forceinline__ void operator()(const f32x4 (&acc)[2][2][4][2], const Unit& u, int wr, int wc, int fr, int fq) const {
        int row0 = u.pm * BM + wr * 64 + fr; const int col0 = u.pn * BM + wc * 32 + 4 * fq; float* base = C;
        if (u.part >= 0) { row0 -= tail_row0; base = Cpart + (size_t)u.part * tail_rows * ldc; }
#pragma unroll
        for (int ai = 0; ai < 2; ++ai)
#pragma unroll
            for (int m = 0; m < 4; ++m) { float* rowp = base + (size_t)(row0 + ai * HALF + m * 16) * ldc + col0;
#pragma unroll
                for (int bj = 0; bj < 2; ++bj)
#pragma unroll
                    for (int n = 0; n < 2; ++n) *(f32x4*)(rowp + bj * HALF + n * 16) = acc[ai][bj][m][n]; }
    }
};
struct EpiYbf16 {
    static constexpr bool PERM = true, AFTER_DRAIN = false;
    bf16_t* C; int ldc; bf16_t* Cpart; int tail_row0, tail_rows;
    __device__ __forceinline__ void operator()(const f32x4 (&acc)[2][2][4][2], const Unit& u, int wr, int wc, int fr, int fq) const {
        int row0 = u.pm * BM + wr * 64 + fr; const int col0 = u.pn * BM + wc * 32 + 8 * fq; bf16_t* base = C;
        if (u.part >= 0) { row0 -= tail_row0; base = Cpart + (size_t)u.part * tail_rows * ldc; }
#pragma unroll
        for (int ai = 0; ai < 2; ++ai)
#pragma unroll
            for (int m = 0; m < 4; ++m) { bf16_t* rowp = base + (size_t)(row0 + ai * HALF + m * 16) * ldc + col0;
#pragma unroll
                for (int bj = 0; bj < 2; ++bj) { const f32x4 v0 = acc[ai][bj][m][0], v1 = acc[ai][bj][m][1];
                    u32x4 w; w.x = cvt_pk_bf16(v0[0], v0[1]); w.y = cvt_pk_bf16(v0[2], v0[3]); w.z = cvt_pk_bf16(v1[0], v1[1]); w.w = cvt_pk_bf16(v1[2], v1[3]);
                    *(u32x4*)(rowp + bj * HALF) = w; } }
    }
};
struct EpiSwiGLU {
    static constexpr bool PERM = true, AFTER_DRAIN = false;
    bf16_t* O; int ldc;
    __device__ __forceinline__ void operator()(const f32x4 (&acc)[2][2][4][2], const Unit& u, int wr, int wc, int fr, int fq) const {
        const int row0 = u.pm * BM + wr * 64 + fr, col0 = u.pn * HALF + wc * 32 + 8 * fq;
#pragma unroll
        for (int ai = 0; ai < 2; ++ai)
#pragma unroll
            for (int m = 0; m < 4; ++m) { bf16_t* rowp = O + (size_t)(row0 + ai * HALF + m * 16) * ldc + col0;
                const f32x4 g0 = acc[ai][0][m][0], g1 = acc[ai][0][m][1], u0 = acc[ai][1][m][0], u1 = acc[ai][1][m][1];
                u32x4 w; w.x = cvt_pk_bf16(silu_f(g0[0]) * u0[0], silu_f(g0[1]) * u0[1]); w.y = cvt_pk_bf16(silu_f(g0[2]) * u0[2], silu_f(g0[3]) * u0[3]);
                w.z = cvt_pk_bf16(silu_f(g1[0]) * u1[0], silu_f(g1[1]) * u1[1]); w.w = cvt_pk_bf16(silu_f(g1[2]) * u1[2], silu_f(g1[3]) * u1[3]);
                *(u32x4*)rowp = w; }
    }
};
struct EpiProj {
    static constexpr bool PERM = true, AFTER_DRAIN = false;
    bf16_t* O; int ldc;
    __device__ __forceinline__ void operator()(const f32x4 (&acc)[2][2][4][2], const Unit& u, int wr, int wc, int fr, int fq) const {
        const int row0 = u.pm * BM + wr * 64 + fr, col0 = u.pn * BM + wc * 32 + 8 * fq;
#pragma unroll
        for (int ai = 0; ai < 2; ++ai)
#pragma unroll
            for (int m = 0; m < 4; ++m) { const int row = row0 + ai * HALF + m * 16; bf16_t* rowp = O + (size_t)row * ldc + col0;
#pragma unroll
                for (int bj = 0; bj < 2; ++bj) { const f32x4 v0 = acc[ai][bj][m][0], v1 = acc[ai][bj][m][1];
                    u32x4 w; w.x = cvt_pk_bf16(v0[0], v0[1]); w.y = cvt_pk_bf16(v0[2], v0[3]); w.z = cvt_pk_bf16(v1[0], v1[1]); w.w = cvt_pk_bf16(v1[2], v1[3]);
                    *(u32x4*)(rowp + bj * HALF) = w; } }
    }
};

template <class Epi, class Sched, bool ALIGN_EPI = false, bool SP2 = false>
__device__ __forceinline__ void gemm_phase(PG8_LAS unsigned char* lds, const Gemm g, const Sched& S, const Epi& E) {
    int tid_ = threadIdx.x; asm volatile("" : "+v"(tid_)); const int tid = tid_, wid = __builtin_amdgcn_readfirstlane(tid >> 6), lane = tid & 63, wr = wid >> 2, wc = wid & 3, fr = lane & 15, fq = lane >> 4;
    const int K = g.K, lda = g.lda;
    unsigned voffA[2], voffB[2];
#pragma unroll
    for (int i = 0; i < 2; ++i) { int R, C; stage_rc(tid * 16 + i * 8192, R, C); const int Rb = Epi::PERM ? ((R & ~31) + perm32(R & 31)) : R;
        voffA[i] = (unsigned)(R * lda + C) * 2u; voffB[i] = (unsigned)(Rb * K + C) * 2u; }
    const size_t kstep = (size_t)(BK * 2);
    const size_t hstepB = (size_t)HALF * K * 2, hstepA = (size_t)HALF * lda * 2;
    const size_t tstepB = 2 * hstepB, tstepA = 2 * hstepA;
    const unsigned ldsw = (unsigned)wid * 1024u;
    const int aoffk[2] = {lds_byte(wr * 64 + fr, fq * 8), lds_byte(wr * 64 + fr, 32 + fq * 8)}, boffk[2] = {lds_byte(wc * 32 + fr, fq * 8), lds_byte(wc * 32 + fr, 32 + fq * 8)};
#define PG8_SA(b, h) (((b) * 2 + (h)) * HTB)
#define PG8_SB(b, h) ((4 + (b) * 2 + (h)) * HTB)
#define PG8_STAGE(bufoff, gbase, voff) do { _Pragma("unroll") for (int _i = 0; _i < 2; ++_i) \
        __builtin_amdgcn_global_load_lds((const unsigned*)((const char*)(gbase) + (voff)[_i]), (PG8_LAS unsigned*)(lds + (bufoff) + ldsw + _i * 8192), 16, 0, 0); } while (0)
#define PG8_LDA(dst, b, h) do { _Pragma("unroll") for (int m = 0; m < 4; ++m) _Pragma("unroll") for (int k = 0; k < 2; ++k) dst[m][k] = *(const PG8_LAS bf16x8*)(lds + PG8_SA(b, h) + aoffk[k] + m * 2048); } while (0)
#define PG8_LDB(dst, b, h) do { _Pragma("unroll") for (int n = 0; n < 2; ++n) _Pragma("unroll") for (int k = 0; k < 2; ++k) dst[n][k] = *(const PG8_LAS bf16x8*)(lds + PG8_SB(b, h) + boffk[k] + n * 2048); } while (0)
#define PG8_MMA(ai, bj, At, Bt) do { __builtin_amdgcn_s_setprio(1); _Pragma("unroll") for (int m = 0; m < 4; ++m) _Pragma("unroll") for (int n = 0; n < 2; ++n) _Pragma("unroll") for (int k = 0; k < 2; ++k) \
        acc[ai][bj][m][n] = __builtin_amdgcn_mfma_f32_16x16x32_bf16(Bt[n][k], At[m][k], acc[ai][bj][m][n], 0, 0, 0); __builtin_amdgcn_s_setprio(0); } while (0)
#define PG8_WAIT_V(n) asm volatile("s_waitcnt vmcnt(" #n ")" ::: "memory")
#define PG8_WAIT_L(n) asm volatile("s_waitcnt lgkmcnt(" #n ")" ::: "memory")
#define PG8_BAR __builtin_amdgcn_s_barrier()
#define PG8_SCHED __builtin_amdgcn_sched_barrier(0)
    Unit cur, nxt; int ui = 0;
    if (!S.next(0, cur)) return;
    f32x4 acc[2][2][4][2];
#pragma unroll
    for (int a = 0; a < 2; ++a)
#pragma unroll
        for (int b = 0; b < 2; ++b)
#pragma unroll
            for (int m = 0; m < 4; ++m)
#pragma unroll
                for (int n = 0; n < 2; ++n) acc[a][b][m][n] = (f32x4){0.f, 0.f, 0.f, 0.f};
    bf16x8 At[4][2], B0[2][2], B1[2][2];
    const char* cA = (const char*)g.A + (size_t)cur.pm * tstepA + (size_t)cur.kt0 * kstep; const char* cB = (const char*)g.Bt + (size_t)cur.pn * tstepB + (size_t)cur.kt0 * kstep;
    S.a_ready(cur);
    if constexpr (SP2) {
        PG8_STAGE(PG8_SB(0, 0), cB, voffB); PG8_STAGE(PG8_SB(0, 1), cB + hstepB, voffB); PG8_STAGE(PG8_SA(0, 0), cA, voffA); PG8_STAGE(PG8_SA(0, 1), cA + hstepA, voffA);
        if (wr == 1) PG8_BAR;
        PG8_WAIT_V(2); PG8_BAR;
        PG8_STAGE(PG8_SB(1, 0), cB + kstep, voffB); PG8_STAGE(PG8_SA(1, 0), cA + kstep, voffA); PG8_STAGE(PG8_SB(1, 1), cB + hstepB + kstep, voffB);
        PG8_WAIT_V(6); PG8_BAR;
    } else {
        PG8_STAGE(PG8_SB(0, 0), cB, voffB); PG8_STAGE(PG8_SA(0, 0), cA, voffA); PG8_STAGE(PG8_SB(0, 1), cB + hstepB, voffB); PG8_STAGE(PG8_SA(0, 1), cA + hstepA, voffA);
        if (wr == 1) PG8_BAR;
        PG8_WAIT_V(4); PG8_BAR;
        PG8_STAGE(PG8_SB(1, 0), cB + kstep, voffB); PG8_STAGE(PG8_SA(1, 0), cA + kstep, voffA); PG8_STAGE(PG8_SB(1, 1), cB + hstepB + kstep, voffB);
        PG8_WAIT_V(6); PG8_BAR;
    }
    for (;;) {
        const bool has_next = S.next(ui + 1, nxt);
        const char* nA = has_next ? (const char*)g.A + (size_t)nxt.pm * tstepA + (size_t)nxt.kt0 * kstep : cA; const char* nB = has_next ? (const char*)g.Bt + (size_t)nxt.pn * tstepB + (size_t)nxt.kt0 * kstep : cB;
        const int nt = cur.nt;
        for (int t = 0; t < nt; t += 2) {
            const bool last = (t == nt - 2);
            const char* a1 = cA + (size_t)(t + 1) * kstep;
            const char* a2 = last ? nA : cA + (size_t)(t + 2) * kstep; const char* b2 = last ? nB : cB + (size_t)(t + 2) * kstep;
            const char* a3 = a2 + kstep; const char* b3 = b2 + kstep;
            if (last && has_next) S.a_ready(nxt);
            if constexpr (SP2) {
            PG8_STAGE(PG8_SA(1, 1), a1 + hstepA, voffA); PG8_SCHED; PG8_LDB(B0, 0, 0); PG8_LDB(B1, 0, 1); PG8_SCHED; PG8_LDA(At, 0, 0);
            PG8_WAIT_V(8); PG8_WAIT_L(0); PG8_BAR; PG8_MMA(0, 0, At, B0); PG8_MMA(0, 1, At, B1); PG8_BAR; PG8_SCHED;
            PG8_STAGE(PG8_SB(0, 0), b2, voffB); PG8_STAGE(PG8_SB(0, 1), b2 + hstepB, voffB); PG8_STAGE(PG8_SA(0, 0), a2, voffA); PG8_SCHED; PG8_LDA(At, 0, 1);
            PG8_WAIT_V(8); PG8_WAIT_L(0); PG8_BAR; PG8_MMA(1, 0, At, B0); PG8_MMA(1, 1, At, B1); PG8_BAR; PG8_SCHED;
            PG8_STAGE(PG8_SA(0, 1), a2 + hstepA, voffA); PG8_SCHED; PG8_LDB(B0, 1, 0); PG8_LDB(B1, 1, 1); PG8_SCHED; PG8_LDA(At, 1, 0);
            PG8_WAIT_V(8); PG8_WAIT_L(0); PG8_BAR; PG8_MMA(0, 0, At, B0); PG8_MMA(0, 1, At, B1); PG8_BAR; PG8_SCHED;
            PG8_STAGE(PG8_SB(1, 0), b3, voffB); PG8_STAGE(PG8_SB(1, 1), b3 + hstepB, voffB); PG8_STAGE(PG8_SA(1, 0), a3, voffA); PG8_SCHED; PG8_LDA(At, 1, 1);
            PG8_WAIT_V(8); PG8_WAIT_L(0); PG8_BAR; PG8_MMA(1, 0, At, B0); PG8_MMA(1, 1, At, B1); PG8_BAR; PG8_SCHED;
            } else {
            PG8_LDB(B0, 0, 0); PG8_SCHED; PG8_LDA(At, 0, 0); PG8_STAGE(PG8_SA(1, 1), a1 + hstepA, voffA);
            PG8_WAIT_L(8); PG8_BAR; PG8_WAIT_L(0); PG8_MMA(0, 0, At, B0); PG8_BAR; PG8_SCHED;
            PG8_LDB(B1, 0, 1); PG8_STAGE(PG8_SB(0, 0), b2, voffB);
            PG8_BAR; PG8_WAIT_L(0); PG8_MMA(0, 1, At, B1); PG8_BAR;
            PG8_LDA(At, 0, 1); PG8_STAGE(PG8_SA(0, 0), a2, voffA);
            PG8_BAR; PG8_WAIT_L(0); PG8_MMA(1, 0, At, B0); PG8_BAR; PG8_SCHED;
            PG8_STAGE(PG8_SB(0, 1), b2 + hstepB, voffB);
            PG8_WAIT_V(6); PG8_BAR; PG8_MMA(1, 1, At, B1); PG8_BAR;
            PG8_LDB(B0, 1, 0); PG8_SCHED; PG8_LDA(At, 1, 0); PG8_STAGE(PG8_SA(0, 1), a2 + hstepA, voffA);
            PG8_WAIT_L(8); PG8_BAR; PG8_WAIT_L(0); PG8_MMA(0, 0, At, B0); PG8_BAR; PG8_SCHED;
            PG8_LDB(B1, 1, 1); PG8_STAGE(PG8_SB(1, 0), b3, voffB);
            PG8_BAR; PG8_WAIT_L(0); PG8_MMA(0, 1, At, B1); PG8_BAR;
            PG8_LDA(At, 1, 1); PG8_STAGE(PG8_SA(1, 0), a3, voffA);
            PG8_BAR; PG8_WAIT_L(0); PG8_MMA(1, 0, At, B0); PG8_BAR; PG8_SCHED;
            PG8_STAGE(PG8_SB(1, 1), b3 + hstepB, voffB);
            PG8_WAIT_V(6); PG8_BAR; PG8_MMA(1, 1, At, B1); PG8_BAR;
            }
        }
        if constexpr (ALIGN_EPI) { if (wr == 0) PG8_BAR; }
        if constexpr (!Epi::AFTER_DRAIN) { E(acc, cur, wr, wc, fr, fq); S.done(cur); }
        if (!has_next) break;
#pragma unroll
        for (int a = 0; a < 2; ++a)
#pragma unroll
            for (int b = 0; b < 2; ++b)
#pragma unroll
                for (int m = 0; m < 4; ++m)
#pragma unroll
                    for (int n = 0; n < 2; ++n) acc[a][b][m][n] = (f32x4){0.f, 0.f, 0.f, 0.f};
        cur = nxt; cA = nA; cB = nB; ++ui;
        if constexpr (ALIGN_EPI) { if (wr == 1) PG8_BAR; }
    }
    PG8_WAIT_V(0);
    if constexpr (!ALIGN_EPI) { if (wr == 0) PG8_BAR; }
    PG8_BAR;
    if constexpr (Epi::AFTER_DRAIN) { E.fused(acc, cur, wr, wc, fr, fq, lds, wid, lane); S.done(cur); }
#undef PG8_SA
#undef PG8_SB
#undef PG8_STAGE
#undef PG8_LDA
#undef PG8_LDB
#undef PG8_MMA
#undef PG8_WAIT_V
#undef PG8_WAIT_L
#undef PG8_BAR
#undef PG8_SCHED
}
}

constexpr int D = 2048, NB = 4, T = 4096, CL = 256, ML = NB * T, MC = NB * CL, M = ML + MC;
constexpr int DFF = 5632, NGU = 2 * DFF, INC = 5664, INP = 5632, NMODC = 9 * D;
constexpr int NCR = M / 128;
constexpr int NLAYER = 2, KSPLIT = 4;
constexpr float EPS = 1e-6f;
constexpr int NWAVES = 8, NTHR = 512;
constexpr int PC_RQ = 0, PC_RK = 512, PC_RV = 1024, PC_RG = 1536, PC_AQ = 2048, PC_AK = 2560, PC_AV = 2816, PC_Z = 3072, PC_XBC = 4096, PC_DT = 5632;

constexpr size_t MiB = 1u << 20;
constexpr size_t WS_CTL = 0, CTL_ZERO_BYTES = 1 * MiB;
constexpr size_t WS_MOD = 1 * MiB;
constexpr size_t WS_MODP = 2 * MiB;
constexpr size_t WS_WGU1 = 14 * MiB, WS_WD1 = 58 * MiB, WS_WGU2 = 80 * MiB, WS_WD2 = 124 * MiB, WS_WIN = 146 * MiB, WS_WOUT = 169 * MiB;
constexpr size_t WS_XC = 177 * MiB;
constexpr size_t WS_A = 185 * MiB;
constexpr size_t WS_PH = 253 * MiB;
constexpr size_t WS_Y = 449 * MiB;
constexpr size_t WS_XB = 517 * MiB;
constexpr size_t WS_DTRAW = 585 * MiB, WS_DT = 588 * MiB, WS_CUMF = 591 * MiB, WS_RCUMB = 593 * MiB;
constexpr size_t WS_AQ = 595 * MiB, WS_AK = 612 * MiB, WS_SX = 621 * MiB, WS_SB = 655 * MiB, WS_SC = 664 * MiB;
constexpr size_t WS_YR = 673 * MiB, WS_YS = 707 * MiB;
constexpr size_t WS_RS = 775 * MiB;
constexpr size_t WS_SS = 843 * MiB;
constexpr size_t WS_SDEC = 979 * MiB;
constexpr size_t WS_YP = 980 * MiB;
constexpr size_t WS_RSB = 1012 * MiB, WS_SSB = 1046 * MiB;
constexpr size_t WS_END = 1114 * MiB;
static_assert(WS_MODP + (size_t)2 * 16 * 5 * NMODC * 4 <= WS_WGU1 && WS_WGU1 + (size_t)NGU * D * 2 <= WS_WD1 && WS_WD1 + (size_t)D * DFF * 2 <= WS_WGU2 && WS_WIN + (size_t)INC * D * 2 <= WS_WOUT && WS_WOUT + (size_t)D * D * 2 <= WS_XC, "ws map 1");
static_assert(WS_XC + (size_t)MC * D * 4 <= WS_A && WS_A + (size_t)M * D * 2 <= WS_PH && WS_PH + (size_t)M * INP * 2 <= WS_Y && WS_Y + (size_t)M * D * 4 <= WS_DTRAW, "ws map 2");
static_assert(WS_DTRAW + (size_t)M * 32 * 4 <= WS_DT && WS_DT + (size_t)M * 32 * 4 <= WS_CUMF && WS_CUMF + (size_t)M * 16 * 4 <= WS_RCUMB && WS_RCUMB + (size_t)M * 16 * 4 <= WS_AQ, "ws map 3");
static_assert(WS_AQ + (size_t)M * 512 * 2 <= WS_AK && WS_AK + (size_t)M * 256 * 2 <= WS_SX && WS_SX + (size_t)M * 1024 * 2 <= WS_SB && WS_SB + (size_t)M * 256 * 2 <= WS_SC && WS_SC + (size_t)M * 256 * 2 <= WS_YR, "ws map 4");
static_assert(WS_YR + (size_t)M * 512 * 4 <= WS_YS && WS_YS + (size_t)M * 1024 * 4 <= WS_RS && WS_RS + (size_t)NCR * 8 * 16384 * 4 <= WS_SS && WS_SS + (size_t)NCR * 32 * 8192 * 4 <= WS_SDEC, "ws map 5");
constexpr int CW_BAR = 4096;

constexpr int RING_OFF = 0, RING_BYTES = 131072;
constexpr int TS = 272, TILE = 128 * TS, HTILE = 64 * TS;
constexpr int AUX_OFF = 143360;
constexpr int MISC_OFF = AUX_OFF + 16384;
constexpr int LDS_BYTES = MISC_OFF + 256;
static_assert(AUX_OFF >= RING_BYTES && AUX_OFF >= 4 * TILE && LDS_BYTES <= 163840, "LDS map");

#define GAS __attribute__((address_space(1)))
#define LAS __attribute__((address_space(3)))
typedef unsigned short bf16;
typedef unsigned v4u __attribute__((ext_vector_type(4)));
typedef float f32x4 __attribute__((ext_vector_type(4)));
typedef short bf16x8 __attribute__((ext_vector_type(8)));
typedef LAS unsigned char* ldsp;
__device__ __forceinline__ unsigned f2bf(float f) { unsigned u = __builtin_bit_cast(unsigned, f); return (u + 0x7fffu + ((u >> 16) & 1u)) >> 16; }
__device__ __forceinline__ unsigned cvtpk(float lo, float hi) { unsigned r; asm("v_cvt_pk_bf16_f32 %0, %1, %2" : "=v"(r) : "v"(lo), "v"(hi)); return r; }
__device__ __forceinline__ unsigned pk2(float lo, float hi) { return cvtpk(lo, hi); }
__device__ __forceinline__ float bf2f(unsigned b) { return __builtin_bit_cast(float, b << 16); }
__device__ __forceinline__ float bflo(unsigned w) { return __builtin_bit_cast(float, w << 16); }
__device__ __forceinline__ float bfhi(unsigned w) { return __builtin_bit_cast(float, w & 0xffff0000u); }
__device__ __forceinline__ float silu(float x) { return x * __builtin_amdgcn_rcpf(1.0f + __builtin_amdgcn_exp2f(x * -1.44269504089f)); }
__device__ __forceinline__ float rsq(float x) { return __builtin_amdgcn_rsqf(x); }
__device__ __forceinline__ float wave_sum(float v) {
#pragma unroll
    for (int o = 1; o < 64; o <<= 1) v += __shfl_xor(v, o);
    return v;
}
__device__ __forceinline__ float sum16(float v) { v += __shfl_xor(v, 1); v += __shfl_xor(v, 2); v += __shfl_xor(v, 4); v += __shfl_xor(v, 8); return v; }
__device__ __forceinline__ float max16(float v) { v = fmaxf(v, __shfl_xor(v, 1)); v = fmaxf(v, __shfl_xor(v, 2)); v = fmaxf(v, __shfl_xor(v, 4)); v = fmaxf(v, __shfl_xor(v, 8)); return v; }

__device__ __forceinline__ int launder(int x) { asm volatile("" : "+v"(x)); return x; }
__device__ __forceinline__ int opaque_s(int x) { asm volatile("" : "+s"(x)); return x; }
#define XB_TMO      128
#define XB_XCNT(j)  (256  + 64 * (j))
#define XB_XSUB(j)  (1280 + 64 * (j))
#define XB_XGEN(j)  (2304 + 64 * (j))
#define XB_TOP      3328
#define XB_TOPGEN   3392
#define XCD_BAR_WORDS 3456
#define XB_SPIN_CAP (1u << 18)

__device__ __forceinline__ unsigned xb_ld(unsigned* p)              { return __hip_atomic_load(p, __ATOMIC_RELAXED, __HIP_MEMORY_SCOPE_AGENT); }
__device__ __forceinline__ unsigned xb_add(unsigned* p, unsigned v) { return __hip_atomic_fetch_add(p, v, __ATOMIC_RELAXED, __HIP_MEMORY_SCOPE_AGENT); }
__device__ __forceinline__ unsigned xb_xcc_id() { return (unsigned)__builtin_amdgcn_s_getreg((3 << 11) | 20) & 0xFu; }
#define XB_SPIN(cond, bar) do { unsigned _sp = 0; while (cond) { __builtin_amdgcn_s_sleep(1); \
    if ((++_sp & 255u) == 0u) { if (xb_ld(&(bar)[XB_TMO])) break; if (_sp > XB_SPIN_CAP) { atomicAdd(&(bar)[XB_TMO], 1u); break; } } } } while (0)

struct XcdBarrier {
    unsigned* bar; unsigned x;
    volatile LAS unsigned* st;
};

__device__ __forceinline__ XcdBarrier xcd_barrier_post(unsigned* bar, volatile LAS unsigned* st) {
    XcdBarrier b; b.bar = bar; b.x = xb_xcc_id(); b.st = st;
    if (threadIdx.x == 0) (void)xb_add(&bar[XB_XCNT(b.x)], 1u);
    return b;
}
__device__ __forceinline__ void xcd_barrier_complete(unsigned* bar, unsigned x, unsigned& nloc, unsigned& nx) {
    const unsigned G = gridDim.x * gridDim.y * gridDim.z;
    unsigned sum, cnt, mine, sp = 0u;
    for (;;) {
        sum = 0u; cnt = 0u; mine = 0u;
#pragma unroll
        for (unsigned j = 0; j < 16; ++j) { const unsigned c = xb_ld(&bar[XB_XCNT(j)]); sum += c; cnt += (c > 0u) ? 1u : 0u; mine = (j == x) ? c : mine; }
        if (sum == G) break;
        __builtin_amdgcn_s_sleep(1);
        if ((++sp & 255u) == 0u) { if (xb_ld(&bar[XB_TMO])) break; if (sp > XB_SPIN_CAP) { atomicAdd(&bar[XB_TMO], 1u); break; } }
    }
    nloc = mine > 0u ? mine : 1u; nx = cnt > 0u ? cnt : 1u;
}

__device__ __forceinline__ void xcd_barrier(const XcdBarrier& b) {
    asm volatile("s_waitcnt vmcnt(0)" ::: "memory");
    __syncthreads();
    if (threadIdx.x == 0) {
        unsigned* bar = b.bar;
        __builtin_amdgcn_s_waitcnt(0);
        unsigned nloc = b.st[0], nx = b.st[1];
        if (nloc == 0u) { unsigned xo = b.x; asm volatile("" : "+s"(xo)); xcd_barrier_complete(bar, xo, nloc, nx); b.st[0] = nloc; b.st[1] = nx; }
        const unsigned old = xb_add(&bar[XB_XSUB(b.x)], 1u);
        const unsigned gen = old / nloc;
        if (old + 1u == (gen + 1u) * nloc) {
            __builtin_amdgcn_fence(__ATOMIC_RELEASE, "agent");
            asm volatile("s_waitcnt vmcnt(0)" ::: "memory");
            const unsigned og = xb_add(&bar[XB_TOP], 1u);
            const unsigned tg = og / nx;
            if (og + 1u == (tg + 1u) * nx) xb_add(&bar[XB_TOPGEN], 1u);
            else XB_SPIN(xb_ld(&bar[XB_TOPGEN]) == tg, bar);
            __builtin_amdgcn_fence(__ATOMIC_ACQUIRE, "agent");
            xb_add(&bar[XB_XGEN(b.x)], 1u);
            asm volatile("s_waitcnt vmcnt(0)" ::: "memory");
        } else {
            XB_SPIN(xb_ld(&bar[XB_XGEN(b.x)]) == gen, bar);
            __builtin_amdgcn_fence(__ATOMIC_ACQUIRE, "agent");
            asm volatile("s_waitcnt vmcnt(0)" ::: "memory");
        }
    }
    __syncthreads();
}

struct Args { const float* in[22]; float* out; unsigned char* ws; int ph_lo, ph_hi; };
struct Frame {
    ldsp lds;
    volatile LAS unsigned* MISC;
    int tid, lane, wave, G, bid;
    float* out;
    unsigned char* ws;
};
__device__ __forceinline__ const float* inp(int i) { const __attribute__((address_space(4))) Args* ka = (const __attribute__((address_space(4))) Args*)__builtin_amdgcn_kernarg_segment_ptr(); return ka->in[opaque_s(i)]; }
__device__ __forceinline__ float* wsf(const Frame& F, size_t off) { return (float*)(F.ws + ((size_t)(unsigned)opaque_s((int)(off >> 20)) << 20)); }
__device__ __forceinline__ bf16* wsb(const Frame& F, size_t off) { return (bf16*)(F.ws + ((size_t)(unsigned)opaque_s((int)(off >> 20)) << 20)); }
enum { I_X = 0, I_C, I_CTX, I_CCTX, I_WADA, I_BADA, I_NORMW, I_GU1, I_D1, I_GU2, I_D2, I_WIN, I_WOUT, I_RDEC, I_RNW, I_SINK, I_CONVW, I_CONVB, I_ALOG, I_DTB, I_DSKIP, I_SNW };

struct TrItem { const float* W; bf16* WT; int K, N, drow0, k0, n0; };
__device__ __forceinline__ void tr_load(const TrItem& t, f32x4 (&v)[16], int lane) {
    const int c4 = 4 * (lane & 15), kq = lane >> 4; const bool okc = t.n0 + c4 < t.N;
#pragma unroll
    for (int i = 0; i < 16; ++i) { v[i] = (f32x4){0.f, 0.f, 0.f, 0.f}; if (okc) v[i] = *(const f32x4*)(t.W + (size_t)(t.k0 + 4 * i + kq) * t.N + t.n0 + c4); }
}
__device__ __forceinline__ void tr_finish(const TrItem& t, const f32x4 (&v)[16], LAS float* scr, int lane) {
    const int c4 = 4 * (lane & 15), kq = lane >> 4;
#pragma unroll
    for (int i = 0; i < 16; ++i) { LAS float* d = scr + (4 * i + kq) * 65 + c4; d[0] = v[i].x; d[1] = v[i].y; d[2] = v[i].z; d[3] = v[i].w; }
    asm volatile("s_waitcnt lgkmcnt(0)" ::: "memory");
    const int c = lane & 7;
#pragma unroll
    for (int j = 0; j < 8; ++j) { const int n = (lane >> 3) + 8 * j; const LAS float* s = scr + (8 * c) * 65 + n;
        v4u o; o.x = pk2(s[0 * 65], s[1 * 65]); o.y = pk2(s[2 * 65], s[3 * 65]); o.z = pk2(s[4 * 65], s[5 * 65]); o.w = pk2(s[6 * 65], s[7 * 65]);
        if (t.n0 + n < t.N) *(v4u*)(t.WT + (size_t)(t.drow0 + n) * t.K + t.k0 + 8 * c) = o; }
    asm volatile("s_waitcnt lgkmcnt(0)" ::: "memory");
}
__device__ __forceinline__ void convert_set(Frame& F, int layer, bool second, int wg0, int part = 0) {
    const int tid = launder(F.tid), lane = tid & 63, wave = __builtin_amdgcn_readfirstlane(tid >> 6), bid = opaque_s(F.bid);
    if (bid < wg0) return;
    LAS float* scr = (LAS float*)(F.lds + wave * 16640);
    const int gw = (bid - wg0) * NWAVES + wave, NGW = (F.G - wg0) * NWAVES;
    constexpr int I_GU = (D / 64) * (NGU / 64), I_DN = (DFF / 64) * (D / 64), I_IN = (D / 64) * ((INC + 63) / 64), I_OUT = (D / 64) * (D / 64);
    const float* gu = inp(second ? I_GU2 : I_GU1) + (size_t)layer * D * NGU; const float* dn = inp(second ? I_D2 : I_D1) + (size_t)layer * DFF * D;
    const float* sq = second ? inp(I_WOUT) + (size_t)layer * D * D : inp(I_WIN) + (size_t)layer * D * INC;
    bf16* const pGU = wsb(F, second ? WS_WGU2 : WS_WGU1); bf16* const pDN = wsb(F, second ? WS_WD2 : WS_WD1); bf16* const pSQ = wsb(F, second ? WS_WOUT : WS_WIN);
    const int nsq = second ? I_OUT : I_IN, nsqb = second ? D / 64 : (INC + 63) / 64, Nsq = second ? D : INC;
    const int it0 = part == 2 || part == 5 ? I_GU : part == 4 ? I_GU / 2 : part == 6 ? I_GU + I_DN : 0;
    const int it1 = part == 1 || part == 4 ? I_GU : part == 3 ? I_GU / 2 : part == 5 ? I_GU + I_DN : I_GU + I_DN + nsq;
#define TR_DESCRIBE(it_, t_) do { int r_ = (it_); \
        if (r_ < I_GU) { const int kb = r_ / (NGU / 64), nb = r_ % (NGU / 64), n0 = 64 * nb, half = n0 >= DFF ? 1 : 0, c0 = n0 - half * DFF;     \
            t_.W = gu; t_.WT = pGU; t_.K = D; t_.N = NGU; t_.drow0 = 256 * (c0 >> 7) + 128 * half + (c0 & 127); t_.k0 = 64 * kb; t_.n0 = n0; } \
        else if (r_ < I_GU + I_DN) { r_ -= I_GU; const int kb = r_ / (D / 64), nb = r_ % (D / 64); t_.W = dn; t_.WT = pDN; t_.K = DFF; t_.N = D; t_.drow0 = 64 * nb; t_.k0 = 64 * kb; t_.n0 = 64 * nb; } \
        else { r_ -= I_GU + I_DN; const int kb = r_ / nsqb, nb = r_ % nsqb; t_.W = sq; t_.WT = pSQ; t_.K = D; t_.N = Nsq; t_.drow0 = 64 * nb; t_.k0 = 64 * kb; t_.n0 = 64 * nb; } } while (0)
    TrItem tc, tn; f32x4 vc[16], vn[16];
    int it = it0 + gw;
    if (it < it1) { TR_DESCRIBE(it, tc); tr_load(tc, vc, lane); }
    for (; it < it1; it += NGW) {
        const bool more = it + NGW < it1;
        if (more) { TR_DESCRIBE(it + NGW, tn); tr_load(tn, vn, lane); }
        tr_finish(tc, vc, scr, lane);
        if (more) { tc = tn;
#pragma unroll
            for (int i = 0; i < 16; ++i) vc[i] = vn[i]; }
    }
#undef TR_DESCRIBE
    __syncthreads();
}
__device__ __forceinline__ void ph_convert_weights(Frame& F, int layer) { convert_set(F, layer, false, 0); convert_set(F, layer, true, 0); }
__device__ __forceinline__ void ph_adaln_partial(Frame& F) {
    const int tid = launder(F.tid), lane = tid & 63, wave = __builtin_amdgcn_readfirstlane(tid >> 6), bid = opaque_s(F.bid); (void)lane; (void)wave; (void)bid;
    float* const pMODP = wsf(F, WS_MODP);    const float* const iC = inp(I_C);    const float* const iCCTX = inp(I_CCTX);    const float* const iWADA = inp(I_WADA);
    LAS float* s = (LAS float*)F.lds;
    for (int i = tid; i < 5 * D; i += NTHR) { const int v = i / D, k = i % D; const float c = (v < 4) ? iC[v * D + k] : iCCTX[k]; s[i] = c / (1.0f + expf(-c)); }
    __syncthreads();
    const int gw = bid * NWAVES + wave, NGW = F.G * NWAVES;
    constexpr int NBLK = NMODC / 256;
    for (int u = gw; u < 2 * NBLK * 16; u += NGW) {
        const int layer = u / (NBLK * 16), r = u % (NBLK * 16), ks = r % 16, nb = r / 16, n0 = nb * 256 + 4 * lane;
        const float* W = iWADA + (size_t)layer * D * NMODC + (size_t)(ks * 128) * NMODC + n0;
        f32x4 a0 = {0.f, 0.f, 0.f, 0.f}, a1 = a0, a2 = a0, a3 = a0, a4 = a0;
#pragma unroll 8
        for (int kk = 0; kk < 128; ++kk) { const f32x4 w = *(const f32x4*)(W + (size_t)kk * NMODC); const int k = ks * 128 + kk;
            a0 += w * s[k]; a1 += w * s[D + k]; a2 += w * s[2 * D + k]; a3 += w * s[3 * D + k]; a4 += w * s[4 * D + k]; }
        float* o = pMODP + ((size_t)(layer * 16 + ks) * 5) * NMODC + n0;
        *(f32x4*)(o) = a0; *(f32x4*)(o + NMODC) = a1; *(f32x4*)(o + 2 * NMODC) = a2; *(f32x4*)(o + 3 * NMODC) = a3; *(f32x4*)(o + 4 * NMODC) = a4;
    }
    __syncthreads();
}
__device__ __forceinline__ void ph_mod_reduce(Frame& F) {
    const int tid = launder(F.tid), lane = tid & 63, wave = __builtin_amdgcn_readfirstlane(tid >> 6), bid = opaque_s(F.bid); (void)lane; (void)wave; (void)bid;
    float* const pMOD = wsf(F, WS_MOD);    float* const pMODP = wsf(F, WS_MODP);    const float* const iBADA = inp(I_BADA);
    for (int i = bid * NTHR + tid; i < 2 * 5 * NMODC; i += F.G * NTHR) {
        const int layer = i / (5 * NMODC), rem = i % (5 * NMODC), v = rem / NMODC, n = rem % NMODC;
        float a = iBADA[layer * NMODC + n];
#pragma unroll
        for (int ks = 0; ks < 16; ++ks) a += pMODP[((size_t)(layer * 16 + ks) * 5 + v) * NMODC + n];
        pMOD[i] = a;
    }
}

template <bool XINB, bool XOUTB> __device__ __forceinline__ void ph_rows(Frame& F, int nrows, const void* xin_l, const void* xin_c, void* xout_l, void* xout_c, const bf16* Y, const bf16* Ypart,
                                        const float* modA, int gi, const float* wpost, float resw, bf16* Aout, const float* modB, int si, const float* wpre) {
    const int tid = launder(F.tid), lane = tid & 63, wave = __builtin_amdgcn_readfirstlane(tid >> 6), bid = opaque_s(F.bid);
    const int gw = bid * NWAVES + wave, NGW = F.G * NWAVES;
    typedef unsigned long long u64;
    f32x4 xf_c[8], xf_n[8]; u64 xb_c[8], xb_n[8], yb_c[8], yb_n[8];
#define ROWS_LOAD(rw, xf, xb, yb) do { const int rw_ = (rw); const bool lat_ = rw_ < ML; \
        if (XINB) { const bf16* xr_ = lat_ ? (const bf16*)xin_l + (size_t)rw_ * D : (const bf16*)xin_c + (size_t)(rw_ - ML) * D; _Pragma("unroll") for (int j = 0; j < 8; ++j) xb[j] = *(const u64*)(xr_ + 4 * lane + 256 * j); } \
        else { const float* xr_ = lat_ ? (const float*)xin_l + (size_t)rw_ * D : (const float*)xin_c + (size_t)(rw_ - ML) * D; _Pragma("unroll") for (int j = 0; j < 8; ++j) xf[j] = *(const f32x4*)(xr_ + 4 * lane + 256 * j); } \
        if (Y && (lat_ || !Ypart)) { _Pragma("unroll") for (int j = 0; j < 8; ++j) yb[j] = *(const u64*)(Y + (size_t)rw_ * D + 4 * lane + 256 * j); } } while (0)
#pragma unroll
    for (int j = 0; j < 8; ++j) { xf_c[j] = xf_n[j] = (f32x4){0.f, 0.f, 0.f, 0.f}; xb_c[j] = xb_n[j] = yb_c[j] = yb_n[j] = 0ull; }
    if (gw < nrows) ROWS_LOAD(gw, xf_c, xb_c, yb_c);
    for (int row = gw; row < nrows; row += NGW) {
        const bool lat = row < ML; const int v = lat ? (row >> 12) : 4;
        if (row + NGW < nrows) ROWS_LOAD(row + NGW, xf_n, xb_n, yb_n);
        f32x4 x[8];
#pragma unroll
        for (int j = 0; j < 8; ++j) { if (XINB) { const unsigned x0 = (unsigned)xb_c[j], x1 = (unsigned)(xb_c[j] >> 32); x[j] = (f32x4){bflo(x0), bfhi(x0), bflo(x1), bfhi(x1)}; } else x[j] = xf_c[j]; }
        if (Y) {
            f32x4 y[8]; float ss = 0.f;
            if (!lat && Ypart) {
#pragma unroll
                for (int j = 0; j < 8; ++j) { f32x4 a = {0.f, 0.f, 0.f, 0.f};
#pragma unroll
                    for (int sp = 0; sp < KSPLIT; ++sp) { const u64 yw = *(const u64*)(Ypart + ((size_t)sp * MC + (row - ML)) * D + 4 * lane + 256 * j); const unsigned y0 = (unsigned)yw, y1 = (unsigned)(yw >> 32);
                        a += (f32x4){bflo(y0), bfhi(y0), bflo(y1), bfhi(y1)}; }
                    y[j] = a; }
            } else {
#pragma unroll
                for (int j = 0; j < 8; ++j) { const unsigned y0 = (unsigned)yb_c[j], y1 = (unsigned)(yb_c[j] >> 32); y[j] = (f32x4){bflo(y0), bfhi(y0), bflo(y1), bfhi(y1)}; }
            }
#pragma unroll
            for (int j = 0; j < 8; ++j) { ss += (y[j].x * y[j].x + y[j].y * y[j].y) + (y[j].z * y[j].z + y[j].w * y[j].w); }
            const float rs = rsq(wave_sum(ss) * (1.0f / D) + EPS);
            const float* gp = modA + (size_t)v * NMODC + gi * D;
#pragma unroll
            for (int j = 0; j < 8; ++j) { const int c = 4 * lane + 256 * j; const f32x4 g = *(const f32x4*)(gp + c), w = *(const f32x4*)(wpost + c); x[j] += (g * resw) * (y[j] * rs * w); }
        }
        if (xout_l) {
            if (XOUTB) { bf16* xo = lat ? (bf16*)xout_l + (size_t)row * D : (bf16*)xout_c + (size_t)(row - ML) * D;
#pragma unroll
                for (int j = 0; j < 8; ++j) *(u64*)(xo + 4 * lane + 256 * j) = (u64)pk2(x[j].x, x[j].y) | ((u64)pk2(x[j].z, x[j].w) << 32);
            } else { float* xo = lat ? (float*)xout_l + (size_t)row * D : (float*)xout_c + (size_t)(row - ML) * D;
#pragma unroll
                for (int j = 0; j < 8; ++j) *(f32x4*)(xo + 4 * lane + 256 * j) = x[j]; } }
        if (Aout) {
            float ss = 0.f;
#pragma unroll
            for (int j = 0; j < 8; ++j) ss += (x[j].x * x[j].x + x[j].y * x[j].y) + (x[j].z * x[j].z + x[j].w * x[j].w);
            const float rs2 = rsq(wave_sum(ss) * (1.0f / D) + EPS);
            const float* shp = modB + (size_t)v * NMODC + si * D; const float* scp = shp + D; bf16* ao = Aout + (size_t)row * D;
#pragma unroll
            for (int j = 0; j < 8; ++j) { const int c = 4 * lane + 256 * j; const f32x4 sh = *(const f32x4*)(shp + c), sc = *(const f32x4*)(scp + c), w = *(const f32x4*)(wpre + c);
                const f32x4 h = (x[j] * rs2 * w) * (sc + 1.0f) + sh;
                *(u64*)(ao + c) = (u64)pk2(h.x, h.y) | ((u64)pk2(h.z, h.w) << 32); }
        }
#pragma unroll
        for (int j = 0; j < 8; ++j) { xf_c[j] = xf_n[j]; xb_c[j] = xb_n[j]; yb_c[j] = yb_n[j]; }
    }
#undef ROWS_LOAD
}


__device__ __forceinline__ void ph_dt_tasks(Frame& F, int layer) {
    const int tid = launder(F.tid), lane = tid & 63, wave = __builtin_amdgcn_readfirstlane(tid >> 6), bid = opaque_s(F.bid);
    float* const pDT = wsf(F, WS_DT); const bf16* const pA2 = wsb(F, WS_A); const bf16* const pWdt = wsb(F, WS_WIN) + (size_t)PC_DT * D;
    LAS f32x4* red = (LAS f32x4*)(F.lds + AUX_OFF);
    const int r = lane & 15, g = lane >> 4, kq = wave & 3; const float b0 = inp(I_DTB)[layer * 32 + r], b1 = inp(I_DTB)[layer * 32 + 16 + r];
    for (int it = bid; it < M / 32; it += F.G) {
        const int row0 = 32 * it + 16 * (wave >> 2);
        const bf16* ap = pA2 + (size_t)(row0 + r) * D + kq * 512 + 8 * g; const bf16* wp = pWdt + (size_t)r * D + kq * 512 + 8 * g;
        bf16x8 av[16];
#pragma unroll
        for (int ks = 0; ks < 16; ++ks) av[ks] = *(const bf16x8*)(ap + 32 * ks);
        f32x4 a0 = {0.f, 0.f, 0.f, 0.f}, a1 = a0;
#pragma unroll
        for (int ks = 0; ks < 16; ++ks) { const bf16x8 w0_ = *(const bf16x8*)(wp + 32 * ks), w1_ = *(const bf16x8*)(wp + (size_t)16 * D + 32 * ks);
            a0 = __builtin_amdgcn_mfma_f32_16x16x32_bf16(av[ks], w0_, a0, 0, 0, 0); a1 = __builtin_amdgcn_mfma_f32_16x16x32_bf16(av[ks], w1_, a1, 0, 0, 0); }
        red[(wave * 2 + 0) * 64 + lane] = a0; red[(wave * 2 + 1) * 64 + lane] = a1;
        __syncthreads();
        if (kq == 0) {
#pragma unroll
            for (int k = 1; k < 4; ++k) { a0 += red[((wave + k) * 2 + 0) * 64 + lane]; a1 += red[((wave + k) * 2 + 1) * 64 + lane]; }
#pragma unroll
            for (int q = 0; q < 4; ++q) { float* o = pDT + (size_t)(row0 + 4 * g + q) * 32 + r; const float x0 = a0[q] + b0, x1 = a1[q] + b1;
                o[0] = fmaxf(x0, 0.f) + log1pf(__expf(-fabsf(x0))); o[16] = fmaxf(x1, 0.f) + log1pf(__expf(-fabsf(x1))); }
        }
        __syncthreads();
    }
}
__device__ __forceinline__ void ph_prep(Frame& F, int layer) {
    const int tid = launder(F.tid), lane = tid & 63, wave = __builtin_amdgcn_readfirstlane(tid >> 6), bid = opaque_s(F.bid);
    const bf16* const pP = wsb(F, WS_PH); bf16* const pAQ = wsb(F, WS_AQ); bf16* const pAK = wsb(F, WS_AK); bf16* const pSX = wsb(F, WS_SX); bf16* const pSB = wsb(F, WS_SB); bf16* const pSC = wsb(F, WS_SC);
    const int gw = bid * NWAVES + wave, NGW = F.G * NWAVES;
    const float* cw = inp(I_CONVW) + (size_t)layer * 3 * 1536; const float* cb = inp(I_CONVB) + (size_t)layer * 1536;
    LAS float* cosT = (LAS float*)F.lds; LAS float* sinT = cosT + 2048;
    for (int i = tid; i < 2048; i += NTHR) { const float ang = (float)(i >> 5) * powf(10000.0f, -(float)(2 * (i & 31)) / 64.0f); float sn, cs; sincosf(ang, &sn, &cs); cosT[i] = cs; sinT[i] = sn; }
    f32x4 w0[3][2], w1[3][2], w2[3][2], wb[3][2];
#pragma unroll
    for (int r = 0; r < 3; ++r)
#pragma unroll
        for (int hf = 0; hf < 2; ++hf) { const int c = 8 * lane + 512 * r + 4 * hf; w0[r][hf] = *(const f32x4*)(cw + c); w1[r][hf] = *(const f32x4*)(cw + 1536 + c); w2[r][hf] = *(const f32x4*)(cw + 3072 + c); wb[r][hf] = *(const f32x4*)(cb + c); }
    __syncthreads();
    const int ch16 = lane & 15, fb = 8 * (ch16 & 3); const bool second = (ch16 & 4) != 0, colpart = (ch16 & 8) != 0;
    v4u qc, kc, u0c[3], u1c[3], u2c[3], qn, kn, u0n[3], u1n[3], u2n[3];
#define PREP_LOAD(rw, q_, k_, u0_, u1_, u2_) do { const int rw_ = (rw); const bool lat_ = rw_ < ML; const int t_ = lat_ ? (rw_ & (T - 1)) : ((rw_ - ML) & (CL - 1)), tl_ = lat_ ? T : CL; \
        const bf16* pr_ = pP + (size_t)rw_ * INP; q_ = *(const v4u*)(pr_ + PC_AQ + 8 * lane); k_ = *(const v4u*)(pr_ + PC_AK + 8 * (lane & 31)); \
        _Pragma("unroll") for (int r = 0; r < 3; ++r) { const int ch = 8 * lane + 512 * r; u1_[r] = *(const v4u*)(pr_ + PC_XBC + ch); u0_[r] = (v4u){0u, 0u, 0u, 0u}; u2_[r] = (v4u){0u, 0u, 0u, 0u}; \
            if (t_ > 0) u0_[r] = *(const v4u*)(pr_ - INP + PC_XBC + ch); if (t_ < tl_ - 1) u2_[r] = *(const v4u*)(pr_ + INP + PC_XBC + ch); } } while (0)
    qn = kn = (v4u){0u, 0u, 0u, 0u};
#pragma unroll
    for (int r = 0; r < 3; ++r) u0n[r] = u1n[r] = u2n[r] = (v4u){0u, 0u, 0u, 0u};
    if (gw < M) PREP_LOAD(gw, qc, kc, u0c, u1c, u2c);
    for (int row = gw; row < M; row += NGW) {
        const bool lat = row < ML; const int t = lat ? (row & (T - 1)) : ((row - ML) & (CL - 1));
        if (row + NGW < M) PREP_LOAD(row + NGW, qn, kn, u0n, u1n, u2n);
        f32x4 cs0 = {1.f, 1.f, 1.f, 1.f}, cs1 = cs0, sn0 = {0.f, 0.f, 0.f, 0.f}, sn1 = sn0;
        if (lat) { const int pos = colpart ? (t & 63) : (t >> 6); cs0 = *(const LAS f32x4*)(cosT + pos * 32 + fb); cs1 = *(const LAS f32x4*)(cosT + pos * 32 + fb + 4); sn0 = *(const LAS f32x4*)(sinT + pos * 32 + fb); sn1 = *(const LAS f32x4*)(sinT + pos * 32 + fb + 4);
            if (!second) { sn0 = -sn0; sn1 = -sn1; } }
        v4u qo, ko;
#pragma unroll
        for (int e = 0; e < 4; ++e) { const unsigned pq = (unsigned)__shfl_xor((int)qc[e], 4), pk = (unsigned)__shfl_xor((int)kc[e], 4);
            const float c0 = e < 2 ? cs0[2 * e] : cs1[2 * e - 4], c1 = e < 2 ? cs0[2 * e + 1] : cs1[2 * e - 3], s0 = e < 2 ? sn0[2 * e] : sn1[2 * e - 4], s1 = e < 2 ? sn0[2 * e + 1] : sn1[2 * e - 3];
            qo[e] = pk2(bflo(qc[e]) * c0 + bflo(pq) * s0, bfhi(qc[e]) * c1 + bfhi(pq) * s1); ko[e] = pk2(bflo(kc[e]) * c0 + bflo(pk) * s0, bfhi(kc[e]) * c1 + bfhi(pk) * s1); }
        *(v4u*)(pAQ + (size_t)row * 512 + 8 * lane) = qo;
        if (lane < 32) *(v4u*)(pAK + (size_t)row * 256 + 8 * lane) = ko;
#pragma unroll
        for (int r = 0; r < 3; ++r) {
            const int ch = 8 * lane + 512 * r;
            unsigned ow[4];
#pragma unroll
            for (int e2 = 0; e2 < 4; ++e2) { const int hf = e2 >> 1, k0 = 2 * (e2 & 1);
                const float ylo = w0[r][hf][k0] * bflo(u0c[r][e2]) + w1[r][hf][k0] * bflo(u1c[r][e2]) + w2[r][hf][k0] * bflo(u2c[r][e2]) + wb[r][hf][k0];
                const float yhi = w0[r][hf][k0 + 1] * bfhi(u0c[r][e2]) + w1[r][hf][k0 + 1] * bfhi(u1c[r][e2]) + w2[r][hf][k0 + 1] * bfhi(u2c[r][e2]) + wb[r][hf][k0 + 1];
                ow[e2] = pk2(silu(ylo), silu(yhi)); }
            const v4u o = {ow[0], ow[1], ow[2], ow[3]};
            if (ch < 1024) *(v4u*)(pSX + (size_t)row * 1024 + ch) = o;
            else if (ch < 1280) *(v4u*)(pSB + (size_t)row * 256 + (ch - 1024)) = o;
            else *(v4u*)(pSC + (size_t)row * 256 + (ch - 1280)) = o;
        }
        qc = qn; kc = kn;
#pragma unroll
        for (int r = 0; r < 3; ++r) { u0c[r] = u0n[r]; u1c[r] = u1n[r]; u2c[r] = u2n[r]; }
    }
#undef PREP_LOAD
    __syncthreads();
}

__device__ __forceinline__ int swz(int r, int c16) { return r * TS + (c16 << 4); }
__device__ __forceinline__ int swz_el(int r, int col) { return r * TS + (col << 1); }
template <int NT> __device__ __forceinline__ void mma_1xN(f32x4 (&acc)[NT], ldsp At, int arow0, ldsp Bt, int brow0, int lane) {
    const int r = lane & 15, g = lane >> 4;
#pragma unroll
    for (int ks = 0; ks < 4; ++ks) {
        const bf16x8 a = *(const LAS bf16x8*)(At + swz(arow0 + r, 4 * ks + g));
#pragma unroll
        for (int nt = 0; nt < NT; ++nt) {
            const bf16x8 b = *(const LAS bf16x8*)(Bt + swz(brow0 + 16 * nt + r, 4 * ks + g));
            acc[nt] = __builtin_amdgcn_mfma_f32_16x16x32_bf16(a, b, acc[nt], 0, 0, 0);
        }
        __builtin_amdgcn_sched_barrier(0);
    }
}
template <int NT> __device__ __forceinline__ void zero_acc(f32x4 (&acc)[NT]) {
#pragma unroll
    for (int i = 0; i < NT; ++i) acc[i] = (f32x4){0.f, 0.f, 0.f, 0.f};
}
__device__ __forceinline__ void stage_direct(ldsp tile, const bf16* g, int ld, int rows, int tid) {
    for (int c = tid; c < rows * 16; c += NTHR) { const int r = c >> 4, ch = c & 15; *(LAS v4u*)(tile + swz(r, ch)) = *(const v4u*)(g + (size_t)r * ld + ch * 8); }
}
__device__ __forceinline__ void stage_direct_f32(ldsp tile, const float* g, int ld, int rows, int tid) {
    for (int c = tid; c < rows * 16; c += NTHR) { const int r = c >> 4, ch = c & 15; const f32x4 a = *(const f32x4*)(g + (size_t)r * ld + ch * 8), b = *(const f32x4*)(g + (size_t)r * ld + ch * 8 + 4);
        *(LAS v4u*)(tile + swz(r, ch)) = (v4u){pk2(a.x, a.y), pk2(a.z, a.w), pk2(b.x, b.y), pk2(b.z, b.w)}; }
}
__device__ __forceinline__ void stage_tr(ldsp tile, const bf16* g, int ld, int ncols, const LAS float* rs, int tid) {
    const int nch = ncols >> 3;
    for (int c = tid; c < 128 * nch; c += NTHR) { const int r = c & 127, ch = c >> 7; const v4u v = *(const v4u*)(g + (size_t)r * ld + ch * 8); const float sc = rs ? rs[r] : 1.0f;
#pragma unroll
        for (int i = 0; i < 4; ++i) { const float lo = bflo(v[i]) * sc, hi = bfhi(v[i]) * sc;
            *(LAS bf16*)(tile + swz_el(ch * 8 + 2 * i, r)) = (bf16)f2bf(lo); *(LAS bf16*)(tile + swz_el(ch * 8 + 2 * i + 1, r)) = (bf16)f2bf(hi); } }
}

typedef short s16x4 __attribute__((ext_vector_type(4)));
constexpr int TSR = 272;
constexpr int TST = 288;
constexpr int TSX = 544;
__device__ __forceinline__ bf16x8 row_frag(ldsp t, int ts, int row0, int ks, int lane) { return *(const LAS bf16x8*)(t + (row0 + (lane & 15)) * ts + ((4 * ks + (lane >> 4)) << 4)); }
__device__ __forceinline__ bf16x8 tr_frag(ldsp t, int ts, int k0, int c0, int lane) {
    ldsp a = t + (k0 + 4 * (lane >> 4) + ((lane >> 2) & 3)) * ts + (c0 + 4 * (lane & 3)) * 2;
    const s16x4 lo = __builtin_amdgcn_ds_read_tr16_b64_v4i16((LAS s16x4*)a), hi = __builtin_amdgcn_ds_read_tr16_b64_v4i16((LAS s16x4*)(a + 16 * ts));
    return (bf16x8){lo[0], lo[1], lo[2], lo[3], hi[0], hi[1], hi[2], hi[3]};
}
__device__ __forceinline__ bf16x8 acc_frag(f32x4 lo, f32x4 hi) { const v4u w = {cvtpk(lo[0], lo[1]), cvtpk(lo[2], lo[3]), cvtpk(hi[0], hi[1]), cvtpk(hi[2], hi[3])}; return __builtin_bit_cast(bf16x8, w); }
__device__ __forceinline__ bf16x8 scale_frag(bf16x8 a, const LAS float* w, int k0, int lane) {
    const f32x4 wl = *(const LAS f32x4*)(w + k0 + 4 * (lane >> 4)), wh = *(const LAS f32x4*)(w + k0 + 16 + 4 * (lane >> 4)); const v4u x = __builtin_bit_cast(v4u, a);
    const v4u o = {cvtpk(bflo(x[0]) * wl[0], bfhi(x[0]) * wl[1]), cvtpk(bflo(x[1]) * wl[2], bfhi(x[1]) * wl[3]), cvtpk(bflo(x[2]) * wh[0], bfhi(x[2]) * wh[1]), cvtpk(bflo(x[3]) * wh[2], bfhi(x[3]) * wh[3])};
    return __builtin_bit_cast(bf16x8, o);
}
#define MFMA16(a, b, c) __builtin_amdgcn_mfma_f32_16x16x32_bf16(a, b, c, 0, 0, 0)
#define SCHED_FENCE() __builtin_amdgcn_sched_barrier(0)
template <int MT> __device__ __forceinline__ void mma_xt(f32x4 (&acc)[MT], ldsp t, int ts, const bf16x8 (&own)[4], int lane) {
    bf16x8 a[MT];
#pragma unroll
    for (int mt = 0; mt < MT; ++mt) a[mt] = row_frag(t, ts, 16 * mt, 0, lane);
#pragma unroll
    for (int ks = 0; ks < 4; ++ks) { bf16x8 an[MT];
        if (ks < 3) {
#pragma unroll
            for (int mt = 0; mt < MT; ++mt) an[mt] = row_frag(t, ts, 16 * mt, ks + 1, lane); }
#pragma unroll
        for (int mt = 0; mt < MT; ++mt) acc[mt] = MFMA16(a[mt], own[ks], acc[mt]);
        SCHED_FENCE();
        if (ks < 3) {
#pragma unroll
            for (int mt = 0; mt < MT; ++mt) a[mt] = an[mt]; }
    }
}
template <int NT, bool SWAP = false> __device__ __forceinline__ void mma_at(f32x4 (&acc)[NT], const bf16x8 (&afr)[4], ldsp t, int ts, int c0, int lane) {
    bf16x8 b[NT];
#pragma unroll
    for (int nt = 0; nt < NT; ++nt) b[nt] = tr_frag(t, ts, 0, c0 + 16 * nt, lane);
#pragma unroll
    for (int ks = 0; ks < 4; ++ks) { bf16x8 bn[NT];
        if (ks < 3) {
#pragma unroll
            for (int nt = 0; nt < NT; ++nt) bn[nt] = tr_frag(t, ts, 32 * (ks + 1), c0 + 16 * nt, lane); }
#pragma unroll
        for (int nt = 0; nt < NT; ++nt) acc[nt] = SWAP ? MFMA16(b[nt], afr[ks], acc[nt]) : MFMA16(afr[ks], b[nt], acc[nt]);
        SCHED_FENCE();
        if (ks < 3) {
#pragma unroll
            for (int nt = 0; nt < NT; ++nt) b[nt] = bn[nt]; }
    }
}
template <int ROWS, int COLS> struct Stage { static constexpr int CPR = COLS / 8, N = ROWS * CPR / NTHR; v4u v[N];
    __device__ __forceinline__ void load(const bf16* g, int ld, int tid) {
#pragma unroll
        for (int i = 0; i < N; ++i) { const int c = tid + NTHR * i, r = c / CPR, ch = c % CPR; v[i] = *(const v4u*)(g + (size_t)r * ld + ch * 8); } }
    __device__ __forceinline__ void store(ldsp tile, int ts, int tid) const {
#pragma unroll
        for (int i = 0; i < N; ++i) { const int c = tid + NTHR * i, r = c / CPR, ch = c % CPR; *(LAS v4u*)(tile + r * ts + (ch << 4)) = v[i]; } }
};

__device__ __forceinline__ void m2_ret_unit(Frame& F, int layer, int cr, int h, bool need_y) {
    const int tid = launder(F.tid), lane = tid & 63, w = __builtin_amdgcn_readfirstlane(tid >> 6), r = lane & 15, g = lane >> 4;
    const bf16* Pm = wsb(F, WS_PH) + (size_t)cr * 128 * INP; bf16* const pYR = wsb(F, WS_YR); bf16* const pRS = wsb(F, WS_RS);
    ldsp TK = F.lds, TV = F.lds + 128 * TSR;
    LAS float* aux = (LAS float*)(F.lds + AUX_OFF);
    LAS float* ef = aux; LAS float* eb = aux + 128; LAS float* nf = aux + 256; LAS float* nb = aux + 384; LAS float* wf = aux + 512; LAS float* wb = aux + 640;
    const float scale = 0.08838834764831845f;
    Stage<128, 128> sk, sv; sk.load(Pm + PC_RK + h * 128, INP, tid); sv.load(Pm + PC_RV + h * 128, INP, tid);
    bf16x8 qf[4];
#pragma unroll
    for (int ks = 0; ks < 4; ++ks) qf[ks] = *(const bf16x8*)(Pm + (size_t)(16 * w + r) * INP + PC_RQ + h * 128 + 32 * ks + 8 * g);
    const float lgf = -fabsf(inp(I_RDEC)[layer * 8 + h]), lgb = -fabsf(inp(I_RDEC)[layer * 8 + 4 + h]);
    __syncthreads();
    sk.store(TK, TSR, tid); sv.store(TV, TST, tid);
    if (tid < 128) { const float t = (float)tid; ef[tid] = __expf(lgf * t); nf[tid] = __expf(-lgf * t); eb[tid] = __expf(lgb * t); nb[tid] = __expf(-lgb * t); wf[tid] = __expf(lgf * (127.f - t)); wb[tid] = __expf(lgb * t); }
    __syncthreads();
    f32x4 s[8]; zero_acc(s); mma_xt<8>(s, TK, TSR, qf, lane);
    { const int i = 16 * w + r; const float efi = ef[i] * scale, nbi = nb[i] * scale;
#pragma unroll
      for (int mt = 0; mt < 8; ++mt) { const int j0 = 16 * mt + 4 * g; const f32x4 nfj = *(const LAS f32x4*)(nf + j0), ebj = *(const LAS f32x4*)(eb + j0);
#pragma unroll
          for (int q = 0; q < 4; ++q) { const int j = j0 + q; const float dec = (i >= j ? efi * nfj[q] : 0.f) + (i <= j ? nbi * ebj[q] : 0.f); s[mt][q] *= dec; } } }
    bf16x8 pa[4];
#pragma unroll
    for (int ks = 0; ks < 4; ++ks) pa[ks] = acc_frag(s[2 * ks], s[2 * ks + 1]);
    if (need_y) { f32x4 y[8]; zero_acc(y); mma_at<8, true>(y, pa, TV, TST, 0, lane);
#pragma unroll
        for (int nt = 0; nt < 8; ++nt) *(unsigned long long*)(pYR + (size_t)(cr * 128 + 16 * w + r) * 512 + h * 128 + 16 * nt + 4 * g) = (unsigned long long)cvtpk(y[nt][0], y[nt][1]) | ((unsigned long long)cvtpk(y[nt][2], y[nt][3]) << 32); }
#pragma unroll
    for (int dir = 0; dir < 2; ++dir) { bf16x8 va[4];
#pragma unroll
        for (int ks = 0; ks < 4; ++ks) va[ks] = scale_frag(tr_frag(TV, TST, 32 * ks, 16 * w, lane), dir ? wb : wf, 32 * ks, lane);
        f32x4 u[8]; zero_acc(u); mma_at<8, true>(u, va, TK, TSR, 0, lane);
        bf16* dst = pRS + ((size_t)(cr * 4 + h) * 2 + dir) * 16384 + (16 * w + r) * 128 + 4 * g;
#pragma unroll
        for (int nt = 0; nt < 8; ++nt) *(unsigned long long*)(dst + 16 * nt) = (unsigned long long)cvtpk(u[nt][0], u[nt][1]) | ((unsigned long long)cvtpk(u[nt][2], u[nt][3]) << 32); }
}
__device__ __forceinline__ void m2_ssd_unit(Frame& F, int layer, int cr, int grp, int hq, bool need_y) {
    const int tid = launder(F.tid), lane = tid & 63, w = __builtin_amdgcn_readfirstlane(tid >> 6), r = lane & 15, g = lane >> 4, m0 = cr * 128, h0 = grp * 8 + hq * 4;
    const bf16* const pSX = wsb(F, WS_SX); const bf16* const pSB = wsb(F, WS_SB); const bf16* const pSC = wsb(F, WS_SC); const float* const pDT = wsf(F, WS_DT);
    float* const pCUMF = wsf(F, WS_CUMF); float* const pRCUMB = wsf(F, WS_RCUMB); float* const pSDEC = wsf(F, WS_SDEC); bf16* const pYS = wsb(F, WS_YS); bf16* const pSS = wsb(F, WS_SS);
    ldsp TB = F.lds, TX = F.lds + 128 * TSR;
    LAS float* aux = (LAS float*)(F.lds + AUX_OFF);
    Stage<128, 128> sb; Stage<128, 256> sx; sb.load(pSB + (size_t)m0 * 256 + grp * 128, 256, tid); sx.load(pSX + (size_t)m0 * 1024 + h0 * 64, 1024, tid);
    bf16x8 cf[4];
#pragma unroll
    for (int ks = 0; ks < 4; ++ks) cf[ks] = *(const bf16x8*)(pSC + (size_t)(m0 + 16 * w + r) * 256 + grp * 128 + 32 * ks + 8 * g);
    const int chh = w >> 1, cdir = w & 1, ch_ = h0 + chh;
    const float alog_ = inp(I_ALOG)[layer * 32 + cdir * 16 + ch_], d0 = pDT[(size_t)(m0 + lane) * 32 + cdir * 16 + ch_], d1 = pDT[(size_t)(m0 + 64 + lane) * 32 + cdir * 16 + ch_];
    __syncthreads();
    sb.store(TB, TSR, tid); sx.store(TX, TSX, tid);
    {
      const int hh = chh, dir = cdir, h = ch_; const float a = -__expf(alog_);
      float p0 = d0 * a, p1 = d1 * a; const float l0 = p0, l1 = p1;
#pragma unroll
      for (int o = 1; o < 64; o <<= 1) { const float t0 = __shfl_up(p0, o), t1 = __shfl_up(p1, o); if (lane >= o) { p0 += t0; p1 += t1; } }
      const float tot0 = __shfl(p0, 63), tot = tot0 + __shfl(p1, 63); p1 += tot0;
      float c0, c1, w0, w1;
      if (dir == 0) { c0 = p0; c1 = p1; w0 = d0 * __expf(tot - p0); w1 = d1 * __expf(tot - p1); }
      else { c0 = tot - p0 + l0; c1 = tot - p1 + l1; w0 = d0 * __expf(tot - c0); w1 = d1 * __expf(tot - c1); }
      LAS float* base = aux + (hh * 2 + dir) * 384;
      const float L2E = 1.44269504089f;
      base[lane] = c0 * L2E; base[64 + lane] = c1 * L2E; base[128 + lane] = d0; base[192 + lane] = d1; base[256 + lane] = w0; base[320 + lane] = w1;
      float* cg = dir ? pRCUMB : pCUMF; cg[(size_t)(m0 + lane) * 16 + h] = c0 * L2E; cg[(size_t)(m0 + 64 + lane) * 16 + h] = c1 * L2E;
      if (lane == 0) pSDEC[(size_t)(cr * 16 + h) * 2 + dir] = __expf(tot);
    }
    __syncthreads();
    f32x4 cb[8]; zero_acc(cb); mma_xt<8>(cb, TB, TSR, cf, lane);
    for (int hh = 0; hh < 4; ++hh) {
        const int h = h0 + hh, l = 16 * w + r;
        const LAS float* cumf = aux + (hh * 2) * 384; const LAS float* dtf = cumf + 128; const LAS float* wf = cumf + 256;
        const LAS float* rcum = aux + (hh * 2 + 1) * 384; const LAS float* dtb = rcum + 128; const LAS float* wb = rcum + 256;
        const float cfl = cumf[l], rcl = rcum[l];
        f32x4 m[8];
#pragma unroll
        for (int mt = 0; mt < 8; ++mt) { const int s0 = 16 * mt + 4 * g;
            if (mt < w) { const f32x4 cs = *(const LAS f32x4*)(cumf + s0), ds = *(const LAS f32x4*)(dtf + s0);
#pragma unroll
                for (int q = 0; q < 4; ++q) m[mt][q] = cb[mt][q] * (__builtin_amdgcn_exp2f(cfl - cs[q]) * ds[q]);
            } else if (mt > w) { const f32x4 rs = *(const LAS f32x4*)(rcum + s0), es = *(const LAS f32x4*)(dtb + s0);
#pragma unroll
                for (int q = 0; q < 4; ++q) m[mt][q] = cb[mt][q] * (__builtin_amdgcn_exp2f(rcl - rs[q]) * es[q]);
            } else { const f32x4 cs = *(const LAS f32x4*)(cumf + s0), ds = *(const LAS f32x4*)(dtf + s0), rs = *(const LAS f32x4*)(rcum + s0), es = *(const LAS f32x4*)(dtb + s0);
#pragma unroll
                for (int q = 0; q < 4; ++q) { const int s = s0 + q; const float mf = (l >= s) ? __builtin_amdgcn_exp2f(cfl - cs[q]) * ds[q] : 0.f, mb = (l <= s) ? __builtin_amdgcn_exp2f(rcl - rs[q]) * es[q] : 0.f; m[mt][q] = cb[mt][q] * (mf + mb); } } }
        bf16x8 pa[4];
#pragma unroll
        for (int ks = 0; ks < 4; ++ks) pa[ks] = acc_frag(m[2 * ks], m[2 * ks + 1]);
        if (need_y) { f32x4 y[4]; zero_acc(y); mma_at<4, true>(y, pa, TX, TSX, hh * 64, lane);
#pragma unroll
            for (int nt = 0; nt < 4; ++nt) *(unsigned long long*)(pYS + (size_t)(m0 + 16 * w + r) * 1024 + h * 64 + 16 * nt + 4 * g) = (unsigned long long)cvtpk(y[nt][0], y[nt][1]) | ((unsigned long long)cvtpk(y[nt][2], y[nt][3]) << 32); }
#pragma unroll
        for (int dir = 0; dir < 2; ++dir) { bf16x8 xa[4];
#pragma unroll
            for (int ks = 0; ks < 4; ++ks) xa[ks] = scale_frag(tr_frag(TX, TSX, 32 * ks, hh * 64 + 16 * (w & 3), lane), dir ? wb : wf, 32 * ks, lane);
            f32x4 u[4]; zero_acc(u); mma_at<4, true>(u, xa, TB, TSR, 64 * (w >> 2), lane);
            bf16* dst = pSS + ((size_t)(cr * 16 + h) * 2 + dir) * 8192 + (16 * (w & 3) + r) * 128 + 64 * (w >> 2) + 4 * g;
#pragma unroll
            for (int nt = 0; nt < 4; ++nt) *(unsigned long long*)(dst + 16 * nt) = (unsigned long long)cvtpk(u[nt][0], u[nt][1]) | ((unsigned long long)cvtpk(u[nt][2], u[nt][3]) << 32); }
    }
}
__device__ __forceinline__ void m2_att_unit(Frame& F, int layer, int b, int qb, int qh, bool is_ctx) {
    const int tid = launder(F.tid), lane = tid & 63, w = __builtin_amdgcn_readfirstlane(tid >> 6), r = lane & 15, g = lane >> 4, kvh = qh >> 1;
    const bf16* const pAQ = wsb(F, WS_AQ); const bf16* const pAK = wsb(F, WS_AK); const bf16* const pP = wsb(F, WS_PH); bf16* const pA = wsb(F, WS_A);
    const int qrow0 = is_ctx ? (ML + b * CL + qb * 128) : (b * T + qb * 128);
    constexpr int KVB = 128 * TSR + 128 * TST;
    const float scale = 0.08838834764831845f;
    const int nleft = (!is_ctx && qb > 0) ? 1 : 0, nright = (!is_ctx && qb < T / 128 - 1) ? 1 : 0, nt_ = is_ctx ? 2 : 3 + nleft + nright, crow = ML + b * CL;
#define TILE_INFO(ti, row, mode) do { int t_ = (ti); row = crow + t_ * 128; mode = 0; \
        if (!is_ctx) { if (t_ == 0) row = qrow0; else if (nleft && t_ == 1) { row = qrow0 - 128; mode = 1; } else if (nright && t_ == 1 + nleft) { row = qrow0 + 128; mode = 2; } else row = crow + (t_ - 1 - nleft - nright) * 128; } } while (0)
    bf16x8 qf[4];
#pragma unroll
    for (int ks = 0; ks < 4; ++ks) qf[ks] = *(const bf16x8*)(pAQ + (size_t)(qrow0 + 16 * w + r) * 512 + qh * 128 + 32 * ks + 8 * g);
    float mrun = -1e30f, lrun = 0.f; f32x4 o[8]; zero_acc(o);
    v4u kr[4], vr[4];
    const int srow = tid >> 4, sch = tid & 15;
    { int row0_, mode0_; TILE_INFO(0, row0_, mode0_); (void)mode0_; const bf16* kg = pAK + (size_t)(row0_ + srow) * 256 + kvh * 128 + sch * 8; const bf16* vg = pP + (size_t)(row0_ + srow) * INP + PC_AV + kvh * 128 + sch * 8;
#pragma unroll
      for (int k = 0; k < 4; ++k) { kr[k] = *(const v4u*)(kg + (size_t)(32 * k) * 256); vr[k] = *(const v4u*)(vg + (size_t)(32 * k) * INP); } }
    __syncthreads();
#pragma unroll
    for (int k = 0; k < 4; ++k) { *(LAS v4u*)(F.lds + (srow + 32 * k) * TSR + (sch << 4)) = kr[k]; *(LAS v4u*)(F.lds + 128 * TSR + (srow + 32 * k) * TST + (sch << 4)) = vr[k]; }
    __syncthreads();
    for (int ti = 0; ti < nt_; ++ti) {
        ldsp TK = F.lds + (ti & 1) * KVB, TV = TK + 128 * TSR;
        int mode, row_cur; TILE_INFO(ti, row_cur, mode); (void)row_cur;
        if (ti + 1 < nt_) { int tr_, mode_n; TILE_INFO(ti + 1, tr_, mode_n); (void)mode_n; const bf16* kg = pAK + (size_t)(tr_ + srow) * 256 + kvh * 128 + sch * 8; const bf16* vg = pP + (size_t)(tr_ + srow) * INP + PC_AV + kvh * 128 + sch * 8;
#pragma unroll
            for (int k = 0; k < 4; ++k) { kr[k] = *(const v4u*)(kg + (size_t)(32 * k) * 256); vr[k] = *(const v4u*)(vg + (size_t)(32 * k) * INP); } }
        f32x4 s[8]; zero_acc(s); mma_xt<8>(s, TK, TSR, qf, lane);
        const int i = 16 * w + r; float mx = -1e30f;
#pragma unroll
        for (int mt = 0; mt < 8; ++mt)
#pragma unroll
            for (int q = 0; q < 4; ++q) { const int j = 16 * mt + 4 * g + q; const bool valid = (mode == 0) || (mode == 1 ? (j >= i) : (j <= i)); const float v = valid ? s[mt][q] * scale : -INFINITY; s[mt][q] = v; mx = fmaxf(mx, v); }
        mx = fmaxf(mx, __shfl_xor(mx, 16)); mx = fmaxf(mx, __shfl_xor(mx, 32));
        const float mnew = fmaxf(mrun, mx), alpha = __expf(mrun - mnew); float rsum = 0.f;
#pragma unroll
        for (int mt = 0; mt < 8; ++mt)
#pragma unroll
            for (int q = 0; q < 4; ++q) { const float p = __expf(s[mt][q] - mnew); s[mt][q] = p; rsum += p; }
        rsum += __shfl_xor(rsum, 16); rsum += __shfl_xor(rsum, 32);
        lrun = lrun * alpha + rsum; mrun = mnew;
        bf16x8 pa[4];
#pragma unroll
        for (int ks = 0; ks < 4; ++ks) pa[ks] = acc_frag(s[2 * ks], s[2 * ks + 1]);
#pragma unroll
        for (int nt = 0; nt < 8; ++nt) o[nt] = o[nt] * alpha;
        mma_at<8, true>(o, pa, TV, TST, 0, lane);
        if (ti + 1 < nt_) { ldsp NK = F.lds + ((ti + 1) & 1) * KVB, NV = NK + 128 * TSR;
#pragma unroll
            for (int k = 0; k < 4; ++k) { *(LAS v4u*)(NK + (srow + 32 * k) * TSR + (sch << 4)) = kr[k]; *(LAS v4u*)(NV + (srow + 32 * k) * TST + (sch << 4)) = vr[k]; } }
        __syncthreads();
    }
    const float sk = inp(I_SINK)[layer * 4 + qh];
    const float mfin = fmaxf(mrun, sk), afin = __expf(mrun - mfin), lfin = lrun * afin + __expf(sk - mfin), fq_ = afin / lfin;
#pragma unroll
    for (int nt = 0; nt < 8; ++nt) { const f32x4 ov = o[nt] * fq_;
        *(unsigned long long*)(pA + (size_t)(qrow0 + 16 * w + r) * D + 512 + qh * 128 + 16 * nt + 4 * g) = (unsigned long long)cvtpk(ov[0], ov[1]) | ((unsigned long long)cvtpk(ov[2], ov[3]) << 32); }
#undef TILE_INFO
}
__device__ __forceinline__ void ph_m2(Frame& F, int layer, bool ctx_out, int which = 7) {
    const int tid = launder(F.tid), lane = tid & 63, wave = __builtin_amdgcn_readfirstlane(tid >> 6), bid = opaque_s(F.bid); (void)lane; (void)wave; (void)bid;
    const int natt = 512 + (ctx_out ? 32 : 0);
    const int vb = (F.G & 7) == 0 ? (bid & 7) * (F.G >> 3) + (bid >> 3) : bid;
    if (which & 1) for (int u = vb; u < natt; u += F.G) {
        if (u < 512) m2_att_unit(F, layer, u >> 7, (u >> 2) & 31, u & 3, false);
        else { const int v = u - 512; m2_att_unit(F, layer, v >> 3, (v >> 2) & 1, v & 3, true); }
    }
    if (which & 2) for (int u = (vb + 224) % F.G; u < NCR * 4; u += F.G) { const int cr = u >> 2; m2_ssd_unit(F, layer, cr, (u >> 1) & 1, u & 1, ctx_out || cr < 128); }
    if (which & 4) for (int u = (vb + 192) % F.G; u < NCR * 4; u += F.G) { const int cr = u >> 2; m2_ret_unit(F, layer, cr, u & 3, ctx_out || cr < 128); }
    __syncthreads();
}

__device__ __forceinline__ int chain_cr(int b, int dir, int step) {
    if (step < 2) return 128 + b * 2 + (dir ? 1 - step : step);
    return b * 32 + (dir ? 33 - step : step - 2);
}
__device__ __forceinline__ void ph_scan(Frame& F, int layer) {
    const int tid = launder(F.tid), bid = opaque_s(F.bid);
    const bf16* const pRS = wsb(F, WS_RS); const bf16* const pSS = wsb(F, WS_SS); const float* const pSDEC = wsf(F, WS_SDEC); const float* const iRDEC = inp(I_RDEC);
    bf16* const pRSB = wsb(F, WS_RSB); bf16* const pSSB = wsb(F, WS_SSB);
    const int gt = bid * NTHR + tid, NT_ = F.G * NTHR;
    for (int it = gt; it < 65536 + 131072; it += NT_) {
        const bool ret = it < 65536; const int j = ret ? it : it - 65536;
        int e8, x, dir, h, b; if (ret) { e8 = j & 2047; x = j >> 11; dir = x & 1; h = (x >> 1) & 3; b = x >> 3; } else { e8 = j & 1023; x = j >> 10; dir = x & 1; h = (x >> 1) & 15; b = x >> 5; }
        const bf16* src = ret ? pRS : pSS; bf16* dstb = ret ? pRSB : pSSB; const int nh = ret ? 4 : 16, tsz = ret ? 16384 : 8192;
        const float rdec = ret ? __expf(-fabsf(iRDEC[layer * 8 + dir * 4 + h]) * 128.0f) : 0.f;
        float s[8];
#pragma unroll
        for (int k = 0; k < 8; ++k) s[k] = 0.f;
#pragma unroll
        for (int b0 = 0; b0 < 34; b0 += 12) { constexpr int NBMAX = 12; v4u u[NBMAX]; float dc[NBMAX]; size_t of[NBMAX];
#pragma unroll
            for (int i = 0; i < NBMAX; ++i) if (b0 + i < 34) { const int cr = chain_cr(b, dir, b0 + i); of[i] = ((size_t)(cr * nh + h) * 2 + dir) * tsz + e8 * 8; u[i] = *(const v4u*)(src + of[i]); dc[i] = ret ? rdec : pSDEC[(size_t)(cr * 16 + h) * 2 + dir]; }
#pragma unroll
            for (int i = 0; i < NBMAX; ++i) if (b0 + i < 34) {
                *(v4u*)(dstb + of[i]) = (v4u){pk2(s[0], s[1]), pk2(s[2], s[3]), pk2(s[4], s[5]), pk2(s[6], s[7])};
#pragma unroll
                for (int k = 0; k < 4; ++k) { s[2 * k] = s[2 * k] * dc[i] + bflo(u[i][k]); s[2 * k + 1] = s[2 * k + 1] * dc[i] + bfhi(u[i][k]); } } }
    }
}


__device__ __forceinline__ void m4_ret_unit(Frame& F, int layer, int cr, int h) {
    const int tid = launder(F.tid), lane = tid & 63, w = __builtin_amdgcn_readfirstlane(tid >> 6), r = lane & 15, g = lane >> 4, i = 16 * w + r;
    const bf16* const pYR = wsb(F, WS_YR); const bf16* const pRSB = wsb(F, WS_RSB); bf16* const pA = wsb(F, WS_A); const bf16* const pP = wsb(F, WS_PH);
    const size_t m = (size_t)cr * 128 + i;
    const float scale = 0.08838834764831845f;
    ldsp T0 = F.lds, T1 = F.lds + 128 * TSR;
    Stage<128, 128> s0, s1; s0.load(pRSB + ((size_t)(cr * 4 + h) * 2 + 0) * 16384, 128, tid); s1.load(pRSB + ((size_t)(cr * 4 + h) * 2 + 1) * 16384, 128, tid);
    bf16x8 qf[4];
#pragma unroll
    for (int ks = 0; ks < 4; ++ks) qf[ks] = *(const bf16x8*)(pP + m * INP + PC_RQ + h * 128 + 32 * ks + 8 * g);
    unsigned long long yq[8], gq[8];
#pragma unroll
    for (int mt = 0; mt < 8; ++mt) { yq[mt] = *(const unsigned long long*)(pYR + m * 512 + h * 128 + 16 * mt + 4 * g); gq[mt] = *(const unsigned long long*)(pP + m * INP + PC_RG + h * 128 + 16 * mt + 4 * g); }
    const float lgf = -fabsf(inp(I_RDEC)[layer * 8 + h]), lgb = -fabsf(inp(I_RDEC)[layer * 8 + 4 + h]);
    __syncthreads();
    s0.store(T0, TSR, tid); s1.store(T1, TSR, tid);
    __syncthreads();
    f32x4 af[8], ab[8]; zero_acc(af); zero_acc(ab);
    mma_xt<8>(af, T0, TSR, qf, lane); mma_xt<8>(ab, T1, TSR, qf, lane);
    const float qfac = __expf(lgf * (float)(i + 1)) * scale, qbac = __expf(lgb * (float)(128 - i)) * scale;
    f32x4 y[8]; float sm = 0.f;
#pragma unroll
    for (int mt = 0; mt < 8; ++mt) { const unsigned long long yw = yq[mt]; const unsigned y0 = (unsigned)yw, y1 = (unsigned)(yw >> 32);
        y[mt] = (f32x4){bflo(y0), bfhi(y0), bflo(y1), bfhi(y1)} + af[mt] * qfac + ab[mt] * qbac; sm += (y[mt][0] + y[mt][1]) + (y[mt][2] + y[mt][3]); }
    sm += __shfl_xor(sm, 16); sm += __shfl_xor(sm, 32);
    const float mu = sm * (1.0f / 128.0f); float vs = 0.f;
#pragma unroll
    for (int mt = 0; mt < 8; ++mt) { y[mt] = y[mt] - mu; vs += (y[mt][0] * y[mt][0] + y[mt][1] * y[mt][1]) + (y[mt][2] * y[mt][2] + y[mt][3] * y[mt][3]); }
    vs += __shfl_xor(vs, 16); vs += __shfl_xor(vs, 32);
    const float rstd = rsq(vs * (1.0f / 128.0f) + EPS);
    const float* nw = inp(I_RNW) + layer * 512 + h * 128;
#pragma unroll
    for (int mt = 0; mt < 8; ++mt) { const int e = 16 * mt + 4 * g; const f32x4 wv = *(const f32x4*)(nw + e);
        const unsigned long long gt = gq[mt]; const unsigned g0 = (unsigned)gt, g1 = (unsigned)(gt >> 32);
        const f32x4 o = y[mt] * rstd * wv;
        *(unsigned long long*)(pA + m * D + h * 128 + e) = (unsigned long long)pk2(o[0] * silu(bflo(g0)), o[1] * silu(bfhi(g0))) | ((unsigned long long)pk2(o[2] * silu(bflo(g1)), o[3] * silu(bfhi(g1))) << 32); }
}
__device__ __forceinline__ void m4_ssd_unit(Frame& F, int layer, int cr, int flags = 7) {
    const int tid = launder(F.tid), lane = tid & 63, w = __builtin_amdgcn_readfirstlane(tid >> 6), r = lane & 15, g = lane >> 4;
    const float* const pCUMF = wsf(F, WS_CUMF); const float* const pRCUMB = wsf(F, WS_RCUMB); const bf16* const pYS = wsb(F, WS_YS); const bf16* const pSSB = wsb(F, WS_SSB);
    bf16* const pA = wsb(F, WS_A); const bf16* const pP = wsb(F, WS_PH); const bf16* const pSX = wsb(F, WS_SX); const bf16* const pSC = wsb(F, WS_SC);
    const float* const nw = inp(I_SNW) + layer * 1024; const float* const dskp = inp(I_DSKIP) + layer * 16;
    const size_t m = (size_t)cr * 128 + 16 * w + r;
    typedef unsigned long long u64;
    constexpr int HB = 4 * 64 * TSR;
    v4u sr[8];
    const bf16* sbase = pSSB + (size_t)(cr * 16) * 2 * 8192 + (size_t)tid * 8;
#define M4_RHO(p) (16 * (2 * ((p) >> 5) + (((p) >> 2) & 1)) + 4 * (((p) >> 3) & 3) + ((p) & 3))
#define M4_COL(mt) (32 * ((mt) >> 1) + 8 * g + 4 * ((mt) & 1))
#define M4_STAGE_LD(step) _Pragma("unroll") for (int k = 0; k < 8; ++k) sr[k] = *(const v4u*)(sbase + (size_t)(step) * 32768 + (size_t)k * 4096)
#define M4_STAGE_ST(buf) _Pragma("unroll") for (int k = 0; k < 8; ++k) { const int c = tid + 512 * k; *(LAS v4u*)(F.lds + (buf) * HB + (c >> 10) * (64 * TSR) + M4_RHO((c >> 4) & 63) * TSR + ((c & 15) << 4)) = sr[k]; }
    u64 yq[2][4], xq[2][4], zq[2][4]; float cfq[2], cbq[2], dq[2];
#define M4_EPI_LD(step) _Pragma("unroll") for (int j = 0; j < 2; ++j) { const int hh_ = 2 * (step) + j; \
        _Pragma("unroll") for (int mt = 0; mt < 4; ++mt) { const int c = hh_ * 64 + M4_COL(mt); yq[j][mt] = *(const u64*)(pYS + m * 1024 + c); xq[j][mt] = *(const u64*)(pSX + m * 1024 + c); \
            zq[j][mt] = *(const u64*)(pP + m * INP + PC_Z + c); } \
        cfq[j] = pCUMF[m * 16 + hh_]; cbq[j] = pRCUMB[m * 16 + hh_]; dq[j] = dskp[hh_]; }
    const int s0 = cr & 7;
    M4_STAGE_LD(s0); M4_EPI_LD(s0);
    __syncthreads();
    M4_STAGE_ST(0);
    __syncthreads();
    bf16x8 cf[4]; float ssq = 0.f;
    for (int s = 0; s < 8; ++s) { const int sp = (s + s0) & 7, spn = (s + 1 + s0) & 7;
        if (s == 0 || (sp & 3) == 0) {
#pragma unroll
            for (int ks = 0; ks < 4; ++ks) cf[ks] = *(const bf16x8*)(pSC + m * 256 + (sp >> 2) * 128 + 32 * ks + 8 * g); }
        if (s < 7) { M4_STAGE_LD(spn); }
        ldsp T = F.lds + (s & 1) * HB;
        f32x4 acc[2][2][4];
#pragma unroll
        for (int j = 0; j < 2; ++j)
#pragma unroll
            for (int dir = 0; dir < 2; ++dir) { zero_acc(acc[j][dir]); if (flags & 1) mma_xt<4>(acc[j][dir], T + (2 * j + dir) * (64 * TSR), TSR, cf, lane); }
        if (flags & 2)
#pragma unroll
        for (int j = 0; j < 2; ++j) { const float ef = __builtin_amdgcn_exp2f(cfq[j]), eb = __builtin_amdgcn_exp2f(cbq[j]), dsk = dq[j];
#pragma unroll
            for (int mt = 0; mt < 4; ++mt) { const int c = (2 * sp + j) * 64 + M4_COL(mt);
                const unsigned x0 = (unsigned)xq[j][mt], x1 = (unsigned)(xq[j][mt] >> 32), z0 = (unsigned)zq[j][mt], z1 = (unsigned)(zq[j][mt] >> 32), y0 = (unsigned)yq[j][mt], y1 = (unsigned)(yq[j][mt] >> 32);
                f32x4 y = (f32x4){bflo(y0), bfhi(y0), bflo(y1), bfhi(y1)} + acc[j][0][mt] * ef + acc[j][1][mt] * eb;
                y[0] = (y[0] + dsk * bflo(x0)) * silu(bflo(z0)); y[1] = (y[1] + dsk * bfhi(x0)) * silu(bfhi(z0)); y[2] = (y[2] + dsk * bflo(x1)) * silu(bflo(z1)); y[3] = (y[3] + dsk * bfhi(x1)) * silu(bfhi(z1));
                ssq += (y[0] * y[0] + y[1] * y[1]) + (y[2] * y[2] + y[3] * y[3]);
                *(u64*)(pA + m * D + 1024 + c) = (u64)pk2(y[0], y[1]) | ((u64)pk2(y[2], y[3]) << 32); } }
        if (s < 7) { M4_EPI_LD(spn); M4_STAGE_ST((s + 1) & 1); }
        __syncthreads();
    }
#undef M4_RHO
#undef M4_STAGE_LD
#undef M4_STAGE_ST
#undef M4_EPI_LD
    ssq += __shfl_xor(ssq, 16); ssq += __shfl_xor(ssq, 32);
    const float rs = rsq(ssq * (1.0f / 1024.0f) + EPS);
    if (flags & 4)
#pragma unroll
    for (int bq = 0; bq < 4; ++bq) { u64 v[16]; f32x4 nv[16];
#pragma unroll
        for (int k = 0; k < 16; ++k) { const int c = (4 * bq + (k >> 2)) * 64 + M4_COL(k & 3); v[k] = *(const u64*)(pA + m * D + 1024 + c); nv[k] = *(const f32x4*)(nw + c); }
#pragma unroll
        for (int k = 0; k < 16; ++k) { const unsigned v0 = (unsigned)v[k], v1 = (unsigned)(v[k] >> 32); const f32x4 sc = nv[k] * rs;
            *(u64*)(pA + m * D + 1024 + (4 * bq + (k >> 2)) * 64 + M4_COL(k & 3)) = (u64)pk2(bflo(v0) * sc[0], bfhi(v0) * sc[1]) | ((u64)pk2(bflo(v1) * sc[2], bfhi(v1) * sc[3]) << 32); } }
#undef M4_COL
}
__device__ __forceinline__ void ph_m4(Frame& F, int layer, bool ctx_out, int which = 3) {
    const int bid = opaque_s(F.bid);
    const int ncr = ctx_out ? NCR : 128;
    if (bid < ncr) { if (which & 1) {
#ifdef PROBE_M4FLAGS
        for (int rep_ = 0; rep_ < 4; ++rep_) m4_ssd_unit(F, layer, bid, opaque_s(PROBE_M4FLAGS));
#endif
        m4_ssd_unit(F, layer, bid); } }
    else if (which & 2) for (int u = bid - ncr; u < ncr * 4; u += F.G - ncr) m4_ret_unit(F, layer, u >> 2, u & 3);
    __syncthreads();
    if (ctx_out && which == 3) convert_set(F, layer + 1, false, ncr, 1);
}

constexpr int PH_PER_LAYER = 13, PH_TOTAL = 3 + NLAYER * PH_PER_LAYER;
__global__ void __launch_bounds__(NTHR, 2) fwd_kernel(Args args) {
    extern __shared__ __attribute__((aligned(16))) unsigned char lds_raw[];
    Frame F;
    F.lds = (ldsp)lds_raw; F.MISC = (volatile LAS unsigned*)(F.lds + MISC_OFF);
    F.tid = threadIdx.x; F.lane = F.tid & 63; F.wave = __builtin_amdgcn_readfirstlane(F.tid >> 6); F.G = gridDim.x; F.bid = blockIdx.x;
    F.out = args.out; unsigned char* ws = args.ws; F.ws = ws;
    for (int u = F.tid; u < (LDS_BYTES - MISC_OFF) / 4; u += NTHR) ((LAS unsigned*)(F.lds + MISC_OFF))[u] = 0u;
    __syncthreads();
    const int lo = args.ph_lo, hi = args.ph_hi;
    XcdBarrier bar; bar.bar = (unsigned*)(ws + WS_CTL) + CW_BAR; bar.x = 0; bar.st = nullptr;
    if (hi - lo > 1) bar = xcd_barrier_post((unsigned*)(ws + WS_CTL) + CW_BAR, F.MISC + 8);
#define IN(k) ((unsigned)(opaque_s(k) - lo) < (unsigned)(hi - lo))
#if defined(PROBE_REP) && (PROBE_REP & 8)
#define PROBE_ROWS(x) x __syncthreads();
#else
#define PROBE_ROWS(x)
#endif
#define SEAM(k) do { if (IN(k) && IN((k) + 1)) xcd_barrier(bar); } while (0)

    if (IN(0)) { ph_adaln_partial(F); convert_set(F, 0, false, 0);
    }
    SEAM(0);
    if (IN(1)) ph_mod_reduce(F);
    SEAM(1);
    if (IN(2)) ph_rows<false, false>(F, M, inp(I_X), inp(I_CTX), nullptr, nullptr, nullptr, nullptr, nullptr, 0, nullptr, 0.f, wsb(F, WS_A), wsf(F, WS_MOD), 0, inp(I_NORMW));
    SEAM(2);
    for (int layer = 0; layer < NLAYER; ++layer) {
        const int pb = 3 + layer * PH_PER_LAYER; const bool last = layer == NLAYER - 1; const int Mrows = last ? ML : M;
#define modL (wsf(F, WS_MOD) + (size_t)layer * 5 * NMODC)
#define nw (inp(I_NORMW) + (size_t)layer * 6 * D)
        if (IN(pb + 0)) { pg8::Gemm gm{wsb(F, WS_A), wsb(F, WS_WGU1), D, D}; pg8::StaticOrder S; S.init(M, NGU, D, F.G, opaque_s(F.bid)); pg8::EpiSwiGLU E{wsb(F, WS_PH), DFF};
            pg8::gemm_phase<pg8::EpiSwiGLU, pg8::StaticOrder, true, true>(F.lds + RING_OFF, gm, S, E);
#if defined(PROBE_REP) && (PROBE_REP & 4)
            __syncthreads(); pg8::gemm_phase<pg8::EpiSwiGLU, pg8::StaticOrder, true, true>(F.lds + RING_OFF, gm, S, E);
#endif
        }
        if (IN(pb + 0)) convert_set(F, layer, true, (M / 256) * (NGU / 256) % F.G, 3);
        SEAM(pb + 0);
        if (IN(pb + 1)) { pg8::Gemm gm{wsb(F, WS_PH), wsb(F, WS_WD1), DFF, DFF}; pg8::StaticOrder S; S.init(ML, D, DFF, F.G, opaque_s(F.bid), MC, KSPLIT); pg8::EpiYbf16 E{wsb(F, WS_Y), D, wsb(F, WS_YP), ML, MC};
            pg8::gemm_phase<pg8::EpiYbf16, pg8::StaticOrder, true, true>(F.lds + RING_OFF, gm, S, E);
#if defined(PROBE_REP) && (PROBE_REP & 128)
            __syncthreads(); pg8::gemm_phase<pg8::EpiYbf16, pg8::StaticOrder, true, true>(F.lds + RING_OFF, gm, S, E);
#endif
        }
        if (IN(pb + 1)) convert_set(F, layer, true, (MC / 256) * (D / 256) * KSPLIT, 2);
        SEAM(pb + 1);
        if (IN(pb + 2)) { bf16* xb = wsb(F, WS_XB);
            if (layer == 0) ph_rows<false, true>(F, M, inp(I_X), inp(I_CTX), xb, xb + (size_t)ML * D, wsb(F, WS_Y), wsb(F, WS_YP), modL, 2, nw + D, 0.5f, wsb(F, WS_A), modL, 3, nw + 2 * D);
            else ph_rows<true, true>(F, M, xb, xb + (size_t)ML * D, xb, xb + (size_t)ML * D, wsb(F, WS_Y), wsb(F, WS_YP), modL, 2, nw + D, 0.5f, wsb(F, WS_A), modL, 3, nw + 2 * D); }
        SEAM(pb + 2);
        if (IN(pb + 3)) { pg8::Gemm gm{wsb(F, WS_A), wsb(F, WS_WIN), D, D}; pg8::StaticOrder S; S.init(M, INP, D, F.G, opaque_s(F.bid)); pg8::EpiProj E{wsb(F, WS_PH), INP};
            pg8::gemm_phase<pg8::EpiProj, pg8::StaticOrder, true, true>(F.lds + RING_OFF, gm, S, E);
#if defined(PROBE_REP) && (PROBE_REP & 256)
            __syncthreads(); pg8::gemm_phase<pg8::EpiProj, pg8::StaticOrder, true, true>(F.lds + RING_OFF, gm, S, E);
#endif
        }
        if (IN(pb + 3)) convert_set(F, layer, true, (M / 256) * (INP / 256) % F.G, 4);
        SEAM(pb + 3);
        if (IN(pb + 4)) { ph_dt_tasks(F, layer); ph_prep(F, layer);
#if defined(PROBE_REP) && (PROBE_REP & 1)
            ph_prep(F, layer);
#endif
        }
        SEAM(pb + 4);
        if (IN(pb + 5)) { ph_m2(F, layer, !last);
#if defined(PROBE_REP) && (PROBE_REP & 2)
            for (int rep_ = 0; rep_ < 4; ++rep_) ph_m2(F, layer, !last, PROBE_WHICH);
#endif
        }
        SEAM(pb + 5);
        if (IN(pb + 6)) {
#if defined(PROBE_REP) && (PROBE_REP & 32)
            ph_scan(F, layer); __syncthreads();
#endif
            ph_scan(F, layer); }
        SEAM(pb + 6);
        if (IN(pb + 7)) {
#if defined(PROBE_REP) && (PROBE_REP & 64)
            for (int rep_ = 0; rep_ < 4; ++rep_) { ph_m4(F, layer, !last, PROBE_WHICH); __syncthreads(); }
#endif
            ph_m4(F, layer, !last); }
        SEAM(pb + 7);
        if (IN(pb + 8)) { pg8::Gemm gm{wsb(F, WS_A), wsb(F, WS_WOUT), D, D}; pg8::StaticOrder S; S.init(ML, D, D, F.G, opaque_s(F.bid), last ? 0 : MC, KSPLIT); pg8::EpiYbf16 E{wsb(F, WS_Y), D, wsb(F, WS_YP), ML, MC};
            pg8::gemm_phase<pg8::EpiYbf16, pg8::StaticOrder, true, true>(F.lds + RING_OFF, gm, S, E); }
        SEAM(pb + 8);
        if (IN(pb + 9)) ph_rows<true, true>(F, Mrows, wsb(F, WS_XB), wsb(F, WS_XB) + (size_t)ML * D, wsb(F, WS_XB), wsb(F, WS_XB) + (size_t)ML * D, wsb(F, WS_Y), wsb(F, WS_YP), modL, 5, nw + 3 * D, 1.0f, wsb(F, WS_A), modL, 6, nw + 4 * D);
        SEAM(pb + 9);
        if (IN(pb + 10)) { pg8::Gemm gm{wsb(F, WS_A), wsb(F, WS_WGU2), D, D}; pg8::StaticOrder S; S.init(Mrows, NGU, D, F.G, opaque_s(F.bid)); pg8::EpiSwiGLU E{wsb(F, WS_PH), DFF};
            pg8::gemm_phase<pg8::EpiSwiGLU, pg8::StaticOrder, true, true>(F.lds + RING_OFF, gm, S, E); }
        if (IN(pb + 10) && !last) convert_set(F, layer + 1, false, (M / 256) * (NGU / 256) % F.G, 5);
        SEAM(pb + 10);
        if (IN(pb + 11)) { pg8::Gemm gm{wsb(F, WS_PH), wsb(F, WS_WD2), DFF, DFF}; pg8::StaticOrder S; S.init(ML, D, DFF, F.G, opaque_s(F.bid), last ? 0 : MC, KSPLIT); pg8::EpiYbf16 E{wsb(F, WS_Y), D, wsb(F, WS_YP), ML, MC};
            pg8::gemm_phase<pg8::EpiYbf16, pg8::StaticOrder, true, true>(F.lds + RING_OFF, gm, S, E); }
        if (IN(pb + 11) && !last) convert_set(F, layer + 1, false, (MC / 256) * (D / 256) * KSPLIT, 6);
        SEAM(pb + 11);
        if (IN(pb + 12)) {
            if (!last) { ph_rows<true, true>(F, M, wsb(F, WS_XB), wsb(F, WS_XB) + (size_t)ML * D, wsb(F, WS_XB), wsb(F, WS_XB) + (size_t)ML * D, wsb(F, WS_Y), wsb(F, WS_YP), modL, 8, nw + 5 * D, 0.5f, wsb(F, WS_A), modL + 5 * NMODC, 0, nw + 6 * D);
            }
            else ph_rows<true, false>(F, ML, wsb(F, WS_XB), wsb(F, WS_XB) + (size_t)ML * D, F.out, nullptr, wsb(F, WS_Y), nullptr, modL, 8, nw + 5 * D, 0.5f, nullptr, nullptr, 0, nullptr);
        }
        SEAM(pb + 12);
    }
#undef modL
#undef nw
#undef IN
#undef SEAM
}

#ifndef MK_SINGLE
#define MK_SINGLE 1
#endif
extern "C" void kernel_launch(void* const* d_in, const int* in_sizes, int n_in, void* d_out, int out_size, void* d_ws, size_t ws_size, hipStream_t stream) {
    static int grid = 0;
    if (grid == 0) {
        if (n_in != 22 || in_sizes[0] != ML * D || out_size != ML * D || ws_size < WS_END) { fprintf(stderr, "kernel_launch: unexpected shapes (n_in %d, in0 %d, out %d, ws %zu < %zu?); nothing launched\n", n_in, n_in > 0 ? in_sizes[0] : -1, out_size, ws_size, (size_t)WS_END); grid = -1; return; }
        int dev = 0, cus = 0, per_cu = 0;
        if (hipGetDevice(&dev) != hipSuccess || hipDeviceGetAttribute(&cus, hipDeviceAttributeMultiprocessorCount, dev) != hipSuccess) { grid = -1; return; }
        if (hipFuncSetAttribute((const void*)fwd_kernel, hipFuncAttributeMaxDynamicSharedMemorySize, LDS_BYTES) != hipSuccess) { fprintf(stderr, "kernel_launch: hipFuncSetAttribute failed\n"); grid = -1; return; }
        if (hipOccupancyMaxActiveBlocksPerMultiprocessor(&per_cu, (const void*)fwd_kernel, NTHR, LDS_BYTES) != hipSuccess || per_cu < 1) fprintf(stderr, "kernel_launch: occupancy query reports %d\n", per_cu);
        (void)hipGetLastError();
        grid = cus;
    }
    if (grid < 0) return;
    (void)hipMemsetAsync((char*)d_ws + WS_CTL, 0, CTL_ZERO_BYTES, stream);
    Args a{};
    for (int i = 0; i < 22; ++i) a.in[i] = (const float*)d_in[i];
    a.out = (float*)d_out; a.ws = (unsigned char*)d_ws;
#if MK_SINGLE
    a.ph_lo = 0; a.ph_hi = PH_TOTAL;
    hipLaunchKernelGGL(fwd_kernel, dim3(grid), dim3(NTHR), LDS_BYTES, stream, a);
#else
    for (int p = 0; p < PH_TOTAL; ++p) { a.ph_lo = p; a.ph_hi = p + 1; hipLaunchKernelGGL(fwd_kernel, dim3(grid), dim3(NTHR), LDS_BYTES, stream, a); }
#endif
}
```

```cpp
#include <hip/hip_runtime.h>
#include <cstdio>
#include <cstdint>
#include <cmath>
namespace pg8 {
#define PG8_LAS __attribute__((address_space(3)))
typedef unsigned short bf16_t;
typedef short bf16x8 __attribute__((ext_vector_type(8)));
typedef float f32x4 __attribute__((ext_vector_type(4)));
typedef unsigned u32x4 __attribute__((ext_vector_type(4)));
constexpr int BM = 256, BK = 64, HALF = 128, HTB = HALF * BK * 2  , STAGE_BYTES = 8 * HTB, NXCD = 8, WGM = 4;

#ifndef PG8_SWZ128
#define PG8_SWZ128 0
#endif
#if PG8_SWZ128
__host__ __device__ __forceinline__ int lds_sw(int r) { return (r & 7) ^ ((r >> 3) & 1); }
__host__ __device__ __forceinline__ int lds_byte(int r, int c) { return (r >> 3) * 1024 + (r & 7) * 128 + ((((c >> 3) ^ lds_sw(r)) & 7) << 4) + (c & 7) * 2; }
__host__ __device__ __forceinline__ void stage_rc(int b, int& R, int& C) { R = (b >> 10) * 8 + ((b >> 7) & 7); C = ((((b >> 4) & 7) ^ lds_sw(R)) << 3) + ((b & 15) >> 1); }
#else
__host__ __device__ __forceinline__ int lds_byte(int r, int c) { const int st = (r >> 4) * 2 + (c >> 5), rr = r & 15, cc = c & 31, ob = rr * 64 + cc * 2; return st * 1024 + (ob ^ (((ob >> 9) & 1) << 5)); }
__host__ __device__ __forceinline__ void stage_rc(int b, int& R, int& C) { const int st = b / 1024, sb = b % 1024, swz = sb ^ (((sb >> 9) & 1) << 5); R = (st >> 1) * 16 + swz / 64; C = (st & 1) * 32 + (swz % 64) / 2; }
#endif
__host__ __device__ __forceinline__ int perm32(int rho) { const int n = rho >> 4, i = rho & 15; return 8 * (i >> 2) + 4 * n + (i & 3); }

struct Unit { int pm, pn, kt0, nt, part; };
struct Gemm { const bf16_t* A; const bf16_t* Bt; int lda, K; };

struct StaticOrder {
    int nM, nN, nwg, G, c, ntk, nMt, S;
    __host__ __device__ void init(int Mfull, int N, int K, int G_, int c_, int Mtail = 0, int S_ = 1) { nM = Mfull / BM; nN = N / BM; nwg = nM * nN; G = G_; c = c_; ntk = K / BK; nMt = Mtail / BM; S = S_; }
    __host__ __device__ bool next(int i, Unit& u) const {
        const long L = (long)i * G + c; int pm, pn, kt0 = 0, nt = ntk, part = -1;
        if (L >= nwg) { const int t = (int)(L - nwg); if (t >= nMt * nN * S) return false;
            const int s = t % S, q = t / S; pn = q % nN; pm = nM + q / nN; nt = ntk / S; kt0 = s * nt; part = s; }
        else { int wgid = (int)L; { const int q = nwg / NXCD, r = nwg % NXCD, xcd = wgid % NXCD, off = wgid / NXCD; wgid = (xcd < r ? xcd * (q + 1) : r * (q + 1) + (xcd - r) * q) + off; }
            const int nig = WGM * nN, gid = wgid / nig, fm = gid * WGM, gsz = (nM - fm) < WGM ? (nM - fm) : WGM;
            pm = fm + ((wgid % nig) % gsz); pn = (wgid % nig) / gsz; }
        u.pm = pm; u.pn = pn; u.kt0 = kt0; u.nt = nt; u.part = part; return true;
    }
    __device__ __forceinline__ void a_ready(const Unit&) const {}
    __device__ __forceinline__ void done(const Unit&) const {}
};


__device__ __forceinline__ unsigned cvt_pk_bf16(float lo, float hi) { unsigned r; asm volatile("v_cvt_pk_bf16_f32 %0, %1, %2" : "=v"(r) : "v"(lo), "v"(hi)); return r; }
__device__ __forceinline__ float silu_f(float x) { return x * __builtin_amdgcn_rcpf(1.0f + __builtin_amdgcn_exp2f(x * -1.44269504089f)); }

struct EpiF32 {
    static constexpr bool PERM = false, AFTER_DRAIN = false;
    float* C; int ldc; float* Cpart; int tail_row0, tail_rows;
    __device__ __forceinline__ void operator()(const f32x4 (&acc)[2][2][4][2], const Unit& u, int wr, int wc, int fr, int fq) const {
        int row0 = u.pm * BM + wr * 64 + fr; const int col0 = u.pn * BM + wc * 32 + 4 * fq; float* base = C;
        if (u.part >= 0) { row0 -= tail_row0; base = Cpart + (size_t)u.part * tail_rows * ldc; }
#pragma unroll
        for (int ai = 0; ai < 2; ++ai)
#pragma unroll
            for (int m = 0; m < 4; ++m) { float* rowp = base + (size_t)(row0 + ai * HALF + m * 16) * ldc + col0;
#pragma unroll
                for (int bj = 0; bj < 2; ++bj)
#pragma unroll
                    for (int n = 0; n < 2; ++n) *(f32x4*)(rowp + bj * HALF + n * 16) = acc[ai][bj][m][n]; }
    }
};
struct EpiYbf16 {
    static constexpr bool PERM = true, AFTER_DRAIN = false;
    bf16_t* C; int ldc; bf16_t* Cpart; int tail_row0, tail_rows;
    __device__ __forceinline__ void operator()(const f32x4 (&acc)[2][2][4][2], const Unit& u, int wr, int wc, int fr, int fq) const {
        int row0 = u.pm * BM + wr * 64 + fr; const int col0 = u.pn * BM + wc * 32 + 8 * fq; bf16_t* base = C;
        if (u.part >= 0) { row0 -= tail_row0; base = Cpart + (size_t)u.part * tail_rows * ldc; }
#pragma unroll
        for (int ai = 0; ai < 2; ++ai)
#pragma unroll
            for (int m = 0; m < 4; ++m) { bf16_t* rowp = base + (size_t)(row0 + ai * HALF + m * 16) * ldc + col0;
#pragma unroll
                for (int bj = 0; bj < 2; ++bj) { const f32x4 v0 = acc[ai][bj][m][0], v1 = acc[ai][bj][m][1];
                    u32x4 w; w.x = cvt_pk_bf16(v0[0], v0[1]); w.y = cvt_pk_bf16(v0[2], v0[3]); w.z = cvt_pk_bf16(v1[0], v1[1]); w.w = cvt_pk_bf16(v1[2], v1[3]);
                    *(u32x4*)(rowp + bj * HALF) = w; } }
    }
};
struct EpiSwiGLU {
    static constexpr bool PERM = true, AFTER_DRAIN = false;
    bf16_t* O; int ldc;
    __device__ __forceinline__ void operator()(const f32x4 (&acc)[2][2][4][2], const Unit& u, int wr, int wc, int fr, int fq) const {
        const int row0 = u.pm * BM + wr * 64 + fr, col0 = u.pn * HALF + wc * 32 + 8 * fq;
#pragma unroll
        for (int ai = 0; ai < 2; ++ai)
#pragma unroll
            for (int m = 0; m < 4; ++m) { bf16_t* rowp = O + (size_t)(row0 + ai * HALF + m * 16) * ldc + col0;
                const f32x4 g0 = acc[ai][0][m][0], g1 = acc[ai][0][m][1], u0 = acc[ai][1][m][0], u1 = acc[ai][1][m][1];
                u32x4 w; w.x = cvt_pk_bf16(silu_f(g0[0]) * u0[0], silu_f(g0[1]) * u0[1]); w.y = cvt_pk_bf16(silu_f(g0[2]) * u0[2], silu_f(g0[3]) * u0[3]);
                w.z = cvt_pk_bf16(silu_f(g1[0]) * u1[0], silu_f(g1[1]) * u1[1]); w.w = cvt_pk_bf16(silu_f(g1[2]) * u1[2], silu_f(g1[3]) * u1[3]);
                *(u32x4*)rowp = w; }
    }
};
struct EpiProj {
    static constexpr bool PERM = true, AFTER_DRAIN = false;
    bf16_t* O; int ldc;
    __device__ __forceinline__ void operator()(const f32x4 (&acc)[2][2][4][2], const Unit& u, int wr, int wc, int fr, int fq) const {
        const int row0 = u.pm * BM + wr * 64 + fr, col0 = u.pn * BM + wc * 32 + 8 * fq;
#pragma unroll
        for (int ai = 0; ai < 2; ++ai)
#pragma unroll
            for (int m = 0; m < 4; ++m) { const int row = row0 + ai * HALF + m * 16; bf16_t* rowp = O + (size_t)row * ldc + col0;
#pragma unroll
                for (int bj = 0; bj < 2; ++bj) { const f32x4 v0 = acc[ai][bj][m][0], v1 = acc[ai][bj][m][1];
                    u32x4 w; w.x = cvt_pk_bf16(v0[0], v0[1]); w.y = cvt_pk_bf16(v0[2], v0[3]); w.z = cvt_pk_bf16(v1[0], v1[1]); w.w = cvt_pk_bf16(v1[2], v1[3]);
                    *(u32x4*)(rowp + bj * HALF) = w; } }
    }
};

template <class Epi, class Sched, bool ALIGN_EPI = false, bool SP2 = false>
__device__ __forceinline__ void gemm_phase(PG8_LAS unsigned char* lds, const Gemm g, const Sched& S, const Epi& E) {
    int tid_ = threadIdx.x; asm volatile("" : "+v"(tid_)); const int tid = tid_, wid = __builtin_amdgcn_readfirstlane(tid >> 6), lane = tid & 63, wr = wid >> 2, wc = wid & 3, fr = lane & 15, fq = lane >> 4;
    const int K = g.K, lda = g.lda;
    unsigned voffA[2], voffB[2];
#pragma unroll
    for (int i = 0; i < 2; ++i) { int R, C; stage_rc(tid * 16 + i * 8192, R, C); const int Rb = Epi::PERM ? ((R & ~31) + perm32(R & 31)) : R;
        voffA[i] = (unsigned)(R * lda + C) * 2u; voffB[i] = (unsigned)(Rb * K + C) * 2u; }
    const size_t kstep = (size_t)(BK * 2);
    const size_t hstepB = (size_t)HALF * K * 2, hstepA = (size_t)HALF * lda * 2;
    const size_t tstepB = 2 * hstepB, tstepA = 2 * hstepA;
    const unsigned ldsw = (unsigned)wid * 1024u;
    const int aoffk[2] = {lds_byte(wr * 64 + fr, fq * 8), lds_byte(wr * 64 + fr, 32 + fq * 8)}, boffk[2] = {lds_byte(wc * 32 + fr, fq * 8), lds_byte(wc * 32 + fr, 32 + fq * 8)};
#define PG8_SA(b, h) (((b) * 2 + (h)) * HTB)
#define PG8_SB(b, h) ((4 + (b) * 2 + (h)) * HTB)
#define PG8_STAGE(bufoff, gbase, voff) do { _Pragma("unroll") for (int _i = 0; _i < 2; ++_i) \
        __builtin_amdgcn_global_load_lds((const unsigned*)((const char*)(gbase) + (voff)[_i]), (PG8_LAS unsigned*)(lds + (bufoff) + ldsw + _i * 8192), 16, 0, 0); } while (0)
#define PG8_LDA(dst, b, h) do { _Pragma("unroll") for (int m = 0; m < 4; ++m) _Pragma("unroll") for (int k = 0; k < 2; ++k) dst[m][k] = *(const PG8_LAS bf16x8*)(lds + PG8_SA(b, h) + aoffk[k] + m * 2048); } while (0)
#define PG8_LDB(dst, b, h) do { _Pragma("unroll") for (int n = 0; n < 2; ++n) _Pragma("unroll") for (int k = 0; k < 2; ++k) dst[n][k] = *(const PG8_LAS bf16x8*)(lds + PG8_SB(b, h) + boffk[k] + n * 2048); } while (0)
#define PG8_MMA(ai, bj, At, Bt) do { __builtin_amdgcn_s_setprio(1); _Pragma("unroll") for (int m = 0; m < 4; ++m) _Pragma("unroll") for (int n = 0; n < 2; ++n) _Pragma("unroll") for (int k = 0; k < 2; ++k) \
        acc[ai][bj][m][n] = __builtin_amdgcn_mfma_f32_16x16x32_bf16(Bt[n][k], At[m][k], acc[ai][bj][m][n], 0, 0, 0); __builtin_amdgcn_s_setprio(0); } while (0)
#define PG8_WAIT_V(n) asm volatile("s_waitcnt vmcnt(" #n ")" ::: "memory")
#define PG8_WAIT_L(n) asm volatile("s_waitcnt lgkmcnt(" #n ")" ::: "memory")
#define PG8_BAR __builtin_amdgcn_s_barrier()
#define PG8_SCHED __builtin_amdgcn_sched_barrier(0)
    Unit cur, nxt; int ui = 0;
    if (!S.next(0, cur)) return;
    f32x4 acc[2][2][4][2];
#pragma unroll
    for (int a = 0; a < 2; ++a)
#pragma unroll
        for (int b = 0; b < 2; ++b)
#pragma unroll
            for (int m = 0; m < 4; ++m)
#pragma unroll
                for (int n = 0; n < 2; ++n) acc[a][b][m][n] = (f32x4){0.f, 0.f, 0.f, 0.f};
    bf16x8 At[4][2], B0[2][2], B1[2][2];
    const char* cA = (const char*)g.A + (size_t)cur.pm * tstepA + (size_t)cur.kt0 * kstep; const char* cB = (const char*)g.Bt + (size_t)cur.pn * tstepB + (size_t)cur.kt0 * kstep;
    S.a_ready(cur);
    if constexpr (SP2) {
        PG8_STAGE(PG8_SB(0, 0), cB, voffB); PG8_STAGE(PG8_SB(0, 1), cB + hstepB, voffB); PG8_STAGE(PG8_SA(0, 0), cA, voffA); PG8_STAGE(PG8_SA(0, 1), cA + hstepA, voffA);
        if (wr == 1) PG8_BAR;
        PG8_WAIT_V(2); PG8_BAR;
        PG8_STAGE(PG8_SB(1, 0), cB + kstep, voffB); PG8_STAGE(PG8_SA(1, 0), cA + kstep, voffA); PG8_STAGE(PG8_SB(1, 1), cB + hstepB + kstep, voffB);
        PG8_WAIT_V(6); PG8_BAR;
    } else {
        PG8_STAGE(PG8_SB(0, 0), cB, voffB); PG8_STAGE(PG8_SA(0, 0), cA, voffA); PG8_STAGE(PG8_SB(0, 1), cB + hstepB, voffB); PG8_STAGE(PG8_SA(0, 1), cA + hstepA, voffA);
        if (wr == 1) PG8_BAR;
        PG8_WAIT_V(4); PG8_BAR;
        PG8_STAGE(PG8_SB(1, 0), cB + kstep, voffB); PG8_STAGE(PG8_SA(1, 0), cA + kstep, voffA); PG8_STAGE(PG8_SB(1, 1), cB + hstepB + kstep, voffB);
        PG8_WAIT_V(6); PG8_BAR;
    }
    for (;;) {
        const bool has_next = S.next(ui + 1, nxt);
        const char* nA = has_next ? (const char*)g.A + (size_t)nxt.pm * tstepA + (size_t)nxt.kt0 * kstep : cA; const char* nB = has_next ? (const char*)g.Bt + (size_t)nxt.pn * tstepB + (size_t)nxt.kt0 * kstep : cB;
        const int nt = cur.nt;
        for (int t = 0; t < nt; t += 2) {
            const bool last = (t == nt - 2);
            const char* a1 = cA + (size_t)(t + 1) * kstep;
            const char* a2 = last ? nA : cA + (size_t)(t + 2) * kstep; const char* b2 = last ? nB : cB + (size_t)(t + 2) * kstep;
            const char* a3 = a2 + kstep; const char* b3 = b2 + kstep;
            if (last && has_next) S.a_ready(nxt);
            if constexpr (SP2) {
            PG8_LDB(B0, 0, 0); PG8_LDB(B1, 0, 1); PG8_SCHED; PG8_LDA(At, 0, 0); PG8_STAGE(PG8_SA(1, 1), a1 + hstepA, voffA);
            PG8_WAIT_V(8); PG8_WAIT_L(0); PG8_BAR; PG8_MMA(0, 0, At, B0); PG8_MMA(0, 1, At, B1); PG8_BAR; PG8_SCHED;
            PG8_LDA(At, 0, 1); PG8_STAGE(PG8_SB(0, 0), b2, voffB); PG8_STAGE(PG8_SB(0, 1), b2 + hstepB, voffB); PG8_STAGE(PG8_SA(0, 0), a2, voffA);
            PG8_WAIT_V(8); PG8_WAIT_L(0); PG8_BAR; PG8_MMA(1, 0, At, B0); PG8_MMA(1, 1, At, B1); PG8_BAR; PG8_SCHED;
            PG8_LDB(B0, 1, 0); PG8_LDB(B1, 1, 1); PG8_SCHED; PG8_LDA(At, 1, 0); PG8_STAGE(PG8_SA(0, 1), a2 + hstepA, voffA);
            PG8_WAIT_V(8); PG8_WAIT_L(0); PG8_BAR; PG8_MMA(0, 0, At, B0); PG8_MMA(0, 1, At, B1); PG8_BAR; PG8_SCHED;
            PG8_LDA(At, 1, 1); PG8_STAGE(PG8_SB(1, 0), b3, voffB); PG8_STAGE(PG8_SB(1, 1), b3 + hstepB, voffB); PG8_STAGE(PG8_SA(1, 0), a3, voffA);
            PG8_WAIT_V(8); PG8_WAIT_L(0); PG8_BAR; PG8_MMA(1, 0, At, B0); PG8_MMA(1, 1, At, B1); PG8_BAR; PG8_SCHED;
            } else {
            PG8_LDB(B0, 0, 0); PG8_SCHED; PG8_LDA(At, 0, 0); PG8_STAGE(PG8_SA(1, 1), a1 + hstepA, voffA);
            PG8_WAIT_L(8); PG8_BAR; PG8_WAIT_L(0); PG8_MMA(0, 0, At, B0); PG8_BAR; PG8_SCHED;
            PG8_LDB(B1, 0, 1); PG8_STAGE(PG8_SB(0, 0), b2, voffB);
            PG8_BAR; PG8_WAIT_L(0); PG8_MMA(0, 1, At, B1); PG8_BAR;
            PG8_LDA(At, 0, 1); PG8_STAGE(PG8_SA(0, 0), a2, voffA);
            PG8_BAR; PG8_WAIT_L(0); PG8_MMA(1, 0, At, B0); PG8_BAR; PG8_SCHED;
            PG8_STAGE(PG8_SB(0, 1), b2 + hstepB, voffB);
            PG8_WAIT_V(6); PG8_BAR; PG8_MMA(1, 1, At, B1); PG8_BAR;
            PG8_LDB(B0, 1, 0); PG8_SCHED; PG8_LDA(At, 1, 0); PG8_STAGE(PG8_SA(0, 1), a2 + hstepA, voffA);
            PG8_WAIT_L(8); PG8_BAR; PG8_WAIT_L(0); PG8_MMA(0, 0, At, B0); PG8_BAR; PG8_SCHED;
            PG8_LDB(B1, 1, 1); PG8_STAGE(PG8_SB(1, 0), b3, voffB);
            PG8_BAR; PG8_WAIT_L(0); PG8_MMA(0, 1, At, B1); PG8_BAR;
            PG8_LDA(At, 1, 1); PG8_STAGE(PG8_SA(1, 0), a3, voffA);
            PG8_BAR; PG8_WAIT_L(0); PG8_MMA(1, 0, At, B0); PG8_BAR; PG8_SCHED;
            PG8_STAGE(PG8_SB(1, 1), b3 + hstepB, voffB);
            PG8_WAIT_V(6); PG8_BAR; PG8_MMA(1, 1, At, B1); PG8_BAR;
            }
        }
        if constexpr (ALIGN_EPI) { if (wr == 0) PG8_BAR; }
        if constexpr (!Epi::AFTER_DRAIN) { E(acc, cur, wr, wc, fr, fq); S.done(cur); }
        if (!has_next) break;
#pragma unroll
        for (int a = 0; a < 2; ++a)
#pragma unroll
            for (int b = 0; b < 2; ++b)
#pragma unroll
                for (int m = 0; m < 4; ++m)
#pragma unroll
                    for (int n = 0; n < 2; ++n) acc[a][b][m][n] = (f32x4){0.f, 0.f, 0.f, 0.f};
        cur = nxt; cA = nA; cB = nB; ++ui;
        if constexpr (ALIGN_EPI) { if (wr == 1) PG8_BAR; }
    }
    PG8_WAIT_V(0);
    if constexpr (!ALIGN_EPI) { if (wr == 0) PG8_BAR; }
    PG8_BAR;
    if constexpr (Epi::AFTER_DRAIN) { E.fused(acc, cur, wr, wc, fr, fq, lds, wid, lane); S.done(cur); }
#undef PG8_SA
#undef PG8_SB
#undef PG8_STAGE
#undef PG8_LDA
#undef PG8_LDB
#undef PG8_MMA
#undef PG8_WAIT_V
#undef PG8_WAIT_L
#undef PG8_BAR
#undef PG8_SCHED
}
}

constexpr int D = 2048, NB = 4, T = 4096, CL = 256, ML = NB * T, MC = NB * CL, M = ML + MC;
constexpr int DFF = 5632, NGU = 2 * DFF, INC = 5664, INP = 5632, NMODC = 9 * D;
constexpr int NCR = M / 128;
constexpr int NLAYER = 2, KSPLIT = 4;
constexpr float EPS = 1e-6f;
constexpr int NWAVES = 8, NTHR = 512;
constexpr int PC_RQ = 0, PC_RK = 512, PC_RV = 1024, PC_RG = 1536, PC_AQ = 2048, PC_AK = 2560, PC_AV = 2816, PC_Z = 3072, PC_XBC = 4096, PC_DT = 5632;

constexpr size_t MiB = 1u << 20;
constexpr size_t WS_CTL = 0, CTL_ZERO_BYTES = 1 * MiB;
constexpr size_t WS_MOD = 1 * MiB;
constexpr size_t WS_MODP = 2 * MiB;
constexpr size_t WS_WGU1 = 14 * MiB, WS_WD1 = 58 * MiB, WS_WGU2 = 80 * MiB, WS_WD2 = 124 * MiB, WS_WIN = 146 * MiB, WS_WOUT = 169 * MiB;
constexpr size_t WS_XC = 177 * MiB;
constexpr size_t WS_A = 185 * MiB;
constexpr size_t WS_PH = 253 * MiB;
constexpr size_t WS_Y = 449 * MiB;
constexpr size_t WS_XB = 517 * MiB;
constexpr size_t WS_DTRAW = 585 * MiB, WS_DT = 588 * MiB, WS_CUMF = 591 * MiB, WS_RCUMB = 593 * MiB;
constexpr size_t WS_AQ = 595 * MiB, WS_AK = 612 * MiB, WS_SX = 621 * MiB, WS_SB = 655 * MiB, WS_SC = 664 * MiB;
constexpr size_t WS_YR = 673 * MiB, WS_YS = 707 * MiB;
constexpr size_t WS_RS = 775 * MiB;
constexpr size_t WS_SS = 843 * MiB;
constexpr size_t WS_SDEC = 979 * MiB;
constexpr size_t WS_YP = 980 * MiB;
constexpr size_t WS_RSB = 1012 * MiB, WS_SSB = 1046 * MiB;
constexpr size_t WS_END = 1114 * MiB;
static_assert(WS_MODP + (size_t)2 * 16 * 5 * NMODC * 4 <= WS_WGU1 && WS_WGU1 + (size_t)NGU * D * 2 <= WS_WD1 && WS_WD1 + (size_t)D * DFF * 2 <= WS_WGU2 && WS_WIN + (size_t)INC * D * 2 <= WS_WOUT && WS_WOUT + (size_t)D * D * 2 <= WS_XC, "ws map 1");
static_assert(WS_XC + (size_t)MC * D * 4 <= WS_A && WS_A + (size_t)M * D * 2 <= WS_PH && WS_PH + (size_t)M * INP * 2 <= WS_Y && WS_Y + (size_t)M * D * 4 <= WS_DTRAW, "ws map 2");
static_assert(WS_DTRAW + (size_t)M * 32 * 4 <= WS_DT && WS_DT + (size_t)M * 32 * 4 <= WS_CUMF && WS_CUMF + (size_t)M * 16 * 4 <= WS_RCUMB && WS_RCUMB + (size_t)M * 16 * 4 <= WS_AQ, "ws map 3");
static_assert(WS_AQ + (size_t)M * 512 * 2 <= WS_AK && WS_AK + (size_t)M * 256 * 2 <= WS_SX && WS_SX + (size_t)M * 1024 * 2 <= WS_SB && WS_SB + (size_t)M * 256 * 2 <= WS_SC && WS_SC + (size_t)M * 256 * 2 <= WS_YR, "ws map 4");
static_assert(WS_YR + (size_t)M * 512 * 4 <= WS_YS && WS_YS + (size_t)M * 1024 * 4 <= WS_RS && WS_RS + (size_t)NCR * 8 * 16384 * 4 <= WS_SS && WS_SS + (size_t)NCR * 32 * 8192 * 4 <= WS_SDEC, "ws map 5");
constexpr int CW_BAR = 4096;

constexpr int RING_OFF = 0, RING_BYTES = 131072;
constexpr int TS = 272, TILE = 128 * TS, HTILE = 64 * TS;
constexpr int AUX_OFF = 143360;
constexpr int MISC_OFF = AUX_OFF + 16384;
constexpr int LDS_BYTES = MISC_OFF + 256;
static_assert(AUX_OFF >= RING_BYTES && AUX_OFF >= 4 * TILE && LDS_BYTES <= 163840, "LDS map");

#define GAS __attribute__((address_space(1)))
#define LAS __attribute__((address_space(3)))
typedef unsigned short bf16;
typedef unsigned v4u __attribute__((ext_vector_type(4)));
typedef float f32x4 __attribute__((ext_vector_type(4)));
typedef short bf16x8 __attribute__((ext_vector_type(8)));
typedef LAS unsigned char* ldsp;
__device__ __forceinline__ unsigned f2bf(float f) { unsigned u = __builtin_bit_cast(unsigned, f); return (u + 0x7fffu + ((u >> 16) & 1u)) >> 16; }
__device__ __forceinline__ unsigned cvtpk(float lo, float hi) { unsigned r; asm("v_cvt_pk_bf16_f32 %0, %1, %2" : "=v"(r) : "v"(lo), "v"(hi)); return r; }
__device__ __forceinline__ unsigned pk2(float lo, float hi) { return cvtpk(lo, hi); }
__device__ __forceinline__ float bf2f(unsigned b) { return __builtin_bit_cast(float, b << 16); }
__device__ __forceinline__ float bflo(unsigned w) { return __builtin_bit_cast(float, w << 16); }
__device__ __forceinline__ float bfhi(unsigned w) { return __builtin_bit_cast(float, w & 0xffff0000u); }
__device__ __forceinline__ float silu(float x) { return x * __builtin_amdgcn_rcpf(1.0f + __builtin_amdgcn_exp2f(x * -1.44269504089f)); }
__device__ __forceinline__ float rsq(float x) { return __builtin_amdgcn_rsqf(x); }
__device__ __forceinline__ float wave_sum(float v) {
#pragma unroll
    for (int o = 1; o < 64; o <<= 1) v += __shfl_xor(v, o);
    return v;
}
__device__ __forceinline__ float sum16(float v) { v += __shfl_xor(v, 1); v += __shfl_xor(v, 2); v += __shfl_xor(v, 4); v += __shfl_xor(v, 8); return v; }
__device__ __forceinline__ float max16(float v) { v = fmaxf(v, __shfl_xor(v, 1)); v = fmaxf(v, __shfl_xor(v, 2)); v = fmaxf(v, __shfl_xor(v, 4)); v = fmaxf(v, __shfl_xor(v, 8)); return v; }

__device__ __forceinline__ int launder(int x) { asm volatile("" : "+v"(x)); return x; }
__device__ __forceinline__ int opaque_s(int x) { asm volatile("" : "+s"(x)); return x; }
#define XB_TMO      128
#define XB_XCNT(j)  (256  + 64 * (j))
#define XB_XSUB(j)  (1280 + 64 * (j))
#define XB_XGEN(j)  (2304 + 64 * (j))
#define XB_TOP      3328
#define XB_TOPGEN   3392
#define XCD_BAR_WORDS 3456
#define XB_SPIN_CAP (1u << 18)

__device__ __forceinline__ unsigned xb_ld(unsigned* p)              { return __hip_atomic_load(p, __ATOMIC_RELAXED, __HIP_MEMORY_SCOPE_AGENT); }
__device__ __forceinline__ unsigned xb_add(unsigned* p, unsigned v) { return __hip_atomic_fetch_add(p, v, __ATOMIC_RELAXED, __HIP_MEMORY_SCOPE_AGENT); }
__device__ __forceinline__ unsigned xb_xcc_id() { return (unsigned)__builtin_amdgcn_s_getreg((3 << 11) | 20) & 0xFu; }
#define XB_SPIN(cond, bar) do { unsigned _sp = 0; while (cond) { __builtin_amdgcn_s_sleep(1); \
    if ((++_sp & 255u) == 0u) { if (xb_ld(&(bar)[XB_TMO])) break; if (_sp > XB_SPIN_CAP) { atomicAdd(&(bar)[XB_TMO], 1u); break; } } } } while (0)

struct XcdBarrier {
    unsigned* bar; unsigned x;
    volatile LAS unsigned* st;
};

__device__ __forceinline__ XcdBarrier xcd_barrier_post(unsigned* bar, volatile LAS unsigned* st) {
    XcdBarrier b; b.bar = bar; b.x = xb_xcc_id(); b.st = st;
    if (threadIdx.x == 0) (void)xb_add(&bar[XB_XCNT(b.x)], 1u);
    return b;
}
__device__ __forceinline__ void xcd_barrier_complete(unsigned* bar, unsigned x, unsigned& nloc, unsigned& nx) {
    const unsigned G = gridDim.x * gridDim.y * gridDim.z;
    unsigned sum, cnt, mine, sp = 0u;
    for (;;) {
        sum = 0u; cnt = 0u; mine = 0u;
#pragma unroll
        for (unsigned j = 0; j < 16; ++j) { const unsigned c = xb_ld(&bar[XB_XCNT(j)]); sum += c; cnt += (c > 0u) ? 1u : 0u; mine = (j == x) ? c : mine; }
        if (sum == G) break;
        __builtin_amdgcn_s_sleep(1);
        if ((++sp & 255u) == 0u) { if (xb_ld(&bar[XB_TMO])) break; if (sp > XB_SPIN_CAP) { atomicAdd(&bar[XB_TMO], 1u); break; } }
    }
    nloc = mine > 0u ? mine : 1u; nx = cnt > 0u ? cnt : 1u;
}

__device__ __forceinline__ void xcd_barrier(const XcdBarrier& b) {
    asm volatile("s_waitcnt vmcnt(0)" ::: "memory");
    __syncthreads();
    if (threadIdx.x == 0) {
        unsigned* bar = b.bar;
        __builtin_amdgcn_s_waitcnt(0);
        unsigned nloc = b.st[0], nx = b.st[1];
        if (nloc == 0u) { unsigned xo = b.x; asm volatile("" : "+s"(xo)); xcd_barrier_complete(bar, xo, nloc, nx); b.st[0] = nloc; b.st[1] = nx; }
        const unsigned old = xb_add(&bar[XB_XSUB(b.x)], 1u);
        const unsigned gen = old / nloc;
        if (old + 1u == (gen + 1u) * nloc) {
            __builtin_amdgcn_fence(__ATOMIC_RELEASE, "agent");
            asm volatile("s_waitcnt vmcnt(0)" ::: "memory");
            const unsigned og = xb_add(&bar[XB_TOP], 1u);
            const unsigned tg = og / nx;
            if (og + 1u == (tg + 1u) * nx) xb_add(&bar[XB_TOPGEN], 1u);
            else XB_SPIN(xb_ld(&bar[XB_TOPGEN]) == tg, bar);
            __builtin_amdgcn_fence(__ATOMIC_ACQUIRE, "agent");
            xb_add(&bar[XB_XGEN(b.x)], 1u);
            asm volatile("s_waitcnt vmcnt(0)" ::: "memory");
        } else {
            XB_SPIN(xb_ld(&bar[XB_XGEN(b.x)]) == gen, bar);
            __builtin_amdgcn_fence(__ATOMIC_ACQUIRE, "agent");
            asm volatile("s_waitcnt vmcnt(0)" ::: "memory");
        }
    }
    __syncthreads();
}

struct Args { const float* in[22]; float* out; unsigned char* ws; int ph_lo, ph_hi; };
struct Frame {
    ldsp lds;
    volatile LAS unsigned* MISC;
    int tid, lane, wave, G, bid;
    float* out;
    unsigned char* ws;
};
__device__ __forceinline__ const float* inp(int i) { const __attribute__((address_space(4))) Args* ka = (const __attribute__((address_space(4))) Args*)__builtin_amdgcn_kernarg_segment_ptr(); return ka->in[opaque_s(i)]; }
__device__ __forceinline__ float* wsf(const Frame& F, size_t off) { return (float*)(F.ws + ((size_t)(unsigned)opaque_s((int)(off >> 20)) << 20)); }
__device__ __forceinline__ bf16* wsb(const Frame& F, size_t off) { return (bf16*)(F.ws + ((size_t)(unsigned)opaque_s((int)(off >> 20)) << 20)); }
enum { I_X = 0, I_C, I_CTX, I_CCTX, I_WADA, I_BADA, I_NORMW, I_GU1, I_D1, I_GU2, I_D2, I_WIN, I_WOUT, I_RDEC, I_RNW, I_SINK, I_CONVW, I_CONVB, I_ALOG, I_DTB, I_DSKIP, I_SNW };

struct TrItem { const float* W; bf16* WT; int K, N, drow0, k0, n0; };
__device__ __forceinline__ void tr_load(const TrItem& t, f32x4 (&v)[16], int lane) {
    const int c4 = 4 * (lane & 15), kq = lane >> 4; const bool okc = t.n0 + c4 < t.N;
#pragma unroll
    for (int i = 0; i < 16; ++i) { v[i] = (f32x4){0.f, 0.f, 0.f, 0.f}; if (okc) v[i] = *(const f32x4*)(t.W + (size_t)(t.k0 + 4 * i + kq) * t.N + t.n0 + c4); }
}
__device__ __forceinline__ void tr_finish(const TrItem& t, const f32x4 (&v)[16], LAS float* scr, int lane) {
    const int c4 = 4 * (lane & 15), kq = lane >> 4;
#pragma unroll
    for (int i = 0; i < 16; ++i) { LAS float* d = scr + (4 * i + kq) * 65 + c4; d[0] = v[i].x; d[1] = v[i].y; d[2] = v[i].z; d[3] = v[i].w; }
    asm volatile("s_waitcnt lgkmcnt(0)" ::: "memory");
    const int c = lane & 7;
#pragma unroll
    for (int j = 0; j < 8; ++j) { const int n = (lane >> 3) + 8 * j; const LAS float* s = scr + (8 * c) * 65 + n;
        v4u o; o.x = pk2(s[0 * 65], s[1 * 65]); o.y = pk2(s[2 * 65], s[3 * 65]); o.z = pk2(s[4 * 65], s[5 * 65]); o.w = pk2(s[6 * 65], s[7 * 65]);
        if (t.n0 + n < t.N) *(v4u*)(t.WT + (size_t)(t.drow0 + n) * t.K + t.k0 + 8 * c) = o; }
    asm volatile("s_waitcnt lgkmcnt(0)" ::: "memory");
}
__device__ __forceinline__ void convert_set(Frame& F, int layer, bool second, int wg0, int part = 0) {
    const int tid = launder(F.tid), lane = tid & 63, wave = __builtin_amdgcn_readfirstlane(tid >> 6), bid = opaque_s(F.bid);
    if (bid < wg0) return;
    LAS float* scr = (LAS float*)(F.lds + wave * 16640);
    const int gw = (bid - wg0) * NWAVES + wave, NGW = (F.G - wg0) * NWAVES;
    constexpr int I_GU = (D / 64) * (NGU / 64), I_DN = (DFF / 64) * (D / 64), I_IN = (D / 64) * ((INC + 63) / 64), I_OUT = (D / 64) * (D / 64);
    const float* gu = inp(second ? I_GU2 : I_GU1) + (size_t)layer * D * NGU; const float* dn = inp(second ? I_D2 : I_D1) + (size_t)layer * DFF * D;
    const float* sq = second ? inp(I_WOUT) + (size_t)layer * D * D : inp(I_WIN) + (size_t)layer * D * INC;
    bf16* const pGU = wsb(F, second ? WS_WGU2 : WS_WGU1); bf16* const pDN = wsb(F, second ? WS_WD2 : WS_WD1); bf16* const pSQ = wsb(F, second ? WS_WOUT : WS_WIN);
    const int nsq = second ? I_OUT : I_IN, nsqb = second ? D / 64 : (INC + 63) / 64, Nsq = second ? D : INC;
    const int it0 = part == 2 || part == 5 ? I_GU : part == 4 ? I_GU / 2 : part == 6 ? I_GU + I_DN : 0;
    const int it1 = part == 1 || part == 4 ? I_GU : part == 3 ? I_GU / 2 : part == 5 ? I_GU + I_DN : I_GU + I_DN + nsq;
#define TR_DESCRIBE(it_, t_) do { int r_ = (it_); \
        if (r_ < I_GU) { const int kb = r_ / (NGU / 64), nb = r_ % (NGU / 64), n0 = 64 * nb, half = n0 >= DFF ? 1 : 0, c0 = n0 - half * DFF;     \
            t_.W = gu; t_.WT = pGU; t_.K = D; t_.N = NGU; t_.drow0 = 256 * (c0 >> 7) + 128 * half + (c0 & 127); t_.k0 = 64 * kb; t_.n0 = n0; } \
        else if (r_ < I_GU + I_DN) { r_ -= I_GU; const int kb = r_ / (D / 64), nb = r_ % (D / 64); t_.W = dn; t_.WT = pDN; t_.K = DFF; t_.N = D; t_.drow0 = 64 * nb; t_.k0 = 64 * kb; t_.n0 = 64 * nb; } \
        else { r_ -= I_GU + I_DN; const int kb = r_ / nsqb, nb = r_ % nsqb; t_.W = sq; t_.WT = pSQ; t_.K = D; t_.N = Nsq; t_.drow0 = 64 * nb; t_.k0 = 64 * kb; t_.n0 = 64 * nb; } } while (0)
    TrItem tc, tn; f32x4 vc[16], vn[16];
    int it = it0 + gw;
    if (it < it1) { TR_DESCRIBE(it, tc); tr_load(tc, vc, lane); }
    for (; it < it1; it += NGW) {
        const bool more = it + NGW < it1;
        if (more) { TR_DESCRIBE(it + NGW, tn); tr_load(tn, vn, lane); }
        tr_finish(tc, vc, scr, lane);
        if (more) { tc = tn;
#pragma unroll
            for (int i = 0; i < 16; ++i) vc[i] = vn[i]; }
    }
#undef TR_DESCRIBE
    __syncthreads();
}
__device__ __forceinline__ void ph_convert_weights(Frame& F, int layer) { convert_set(F, layer, false, 0); convert_set(F, layer, true, 0); }
__device__ __forceinline__ void ph_adaln_partial(Frame& F) {
    const int tid = launder(F.tid), lane = tid & 63, wave = __builtin_amdgcn_readfirstlane(tid >> 6), bid = opaque_s(F.bid); (void)lane; (void)wave; (void)bid;
    float* const pMODP = wsf(F, WS_MODP);    const float* const iC = inp(I_C);    const float* const iCCTX = inp(I_CCTX);    const float* const iWADA = inp(I_WADA);
    LAS float* s = (LAS float*)F.lds;
    for (int i = tid; i < 5 * D; i += NTHR) { const int v = i / D, k = i % D; const float c = (v < 4) ? iC[v * D + k] : iCCTX[k]; s[i] = c / (1.0f + expf(-c)); }
    __syncthreads();
    const int gw = bid * NWAVES + wave, NGW = F.G * NWAVES;
    constexpr int NBLK = NMODC / 256;
    for (int u = gw; u < 2 * NBLK * 16; u += NGW) {
        const int layer = u / (NBLK * 16), r = u % (NBLK * 16), ks = r % 16, nb = r / 16, n0 = nb * 256 + 4 * lane;
        const float* W = iWADA + (size_t)layer * D * NMODC + (size_t)(ks * 128) * NMODC + n0;
        f32x4 a0 = {0.f, 0.f, 0.f, 0.f}, a1 = a0, a2 = a0, a3 = a0, a4 = a0;
#pragma unroll 8
        for (int kk = 0; kk < 128; ++kk) { const f32x4 w = *(const f32x4*)(W + (size_t)kk * NMODC); const int k = ks * 128 + kk;
            a0 += w * s[k]; a1 += w * s[D + k]; a2 += w * s[2 * D + k]; a3 += w * s[3 * D + k]; a4 += w * s[4 * D + k]; }
        float* o = pMODP + ((size_t)(layer * 16 + ks) * 5) * NMODC + n0;
        *(f32x4*)(o) = a0; *(f32x4*)(o + NMODC) = a1; *(f32x4*)(o + 2 * NMODC) = a2; *(f32x4*)(o + 3 * NMODC) = a3; *(f32x4*)(o + 4 * NMODC) = a4;
    }
    __syncthreads();
}
__device__ __forceinline__ void ph_mod_reduce(Frame& F) {
    const int tid = launder(F.tid), lane = tid & 63, wave = __builtin_amdgcn_readfirstlane(tid >> 6), bid = opaque_s(F.bid); (void)lane; (void)wave; (void)bid;
    float* const pMOD = wsf(F, WS_MOD);    float* const pMODP = wsf(F, WS_MODP);    const float* const iBADA = inp(I_BADA);    const float* const iNW = inp(I_NORMW);
    for (int i = bid * NTHR + tid; i < 2 * 5 * NMODC; i += F.G * NTHR) {
        const int layer = i / (5 * NMODC), rem = i % (5 * NMODC), v = rem / NMODC, n = rem % NMODC;
        float a = iBADA[layer * NMODC + n];
#pragma unroll
        for (int ks = 0; ks < 16; ++ks) a += pMODP[((size_t)(layer * 16 + ks) * 5 + v) * NMODC + n];
        const int ch = n / D, col = n % D, sub = ch / 3, kind = ch % 3; const float* nwl = iNW + (size_t)layer * 6 * D;
        if (kind == 1) a = (1.0f + a) * nwl[(2 * sub) * D + col];
        else if (kind == 2) a = a * (sub == 1 ? 1.0f : 0.5f) * nwl[(2 * sub + 1) * D + col];
        pMOD[i] = a;
    }
}

template <bool XINB, bool XOUTB> __device__ __forceinline__ void ph_rows(Frame& F, int nrows, const void* xin_l, const void* xin_c, void* xout_l, void* xout_c, const bf16* Y, const bf16* Ypart,
                                        const float* modA, int gi, const float* wpost, float resw, bf16* Aout, const float* modB, int si, const float* wpre) {
    const int tid = launder(F.tid), lane = tid & 63, wave = __builtin_amdgcn_readfirstlane(tid >> 6), bid = opaque_s(F.bid);
    const int gw = bid * NWAVES + wave, NGW = F.G * NWAVES;
    typedef unsigned long long u64;
    f32x4 xf_c[8], xf_n[8]; u64 xb_c[8], xb_n[8], yb_c[8], yb_n[8];
#define ROWS_LOAD(rw, xf, xb, yb) do { const int rw_ = (rw); const bool lat_ = rw_ < ML; \
        if (XINB) { const bf16* xr_ = lat_ ? (const bf16*)xin_l + (size_t)rw_ * D : (const bf16*)xin_c + (size_t)(rw_ - ML) * D; _Pragma("unroll") for (int j = 0; j < 8; ++j) xb[j] = *(const u64*)(xr_ + 4 * lane + 256 * j); } \
        else { const float* xr_ = lat_ ? (const float*)xin_l + (size_t)rw_ * D : (const float*)xin_c + (size_t)(rw_ - ML) * D; _Pragma("unroll") for (int j = 0; j < 8; ++j) xf[j] = *(const f32x4*)(xr_ + 4 * lane + 256 * j); } \
        if (Y && (lat_ || !Ypart)) { _Pragma("unroll") for (int j = 0; j < 8; ++j) yb[j] = *(const u64*)(Y + (size_t)rw_ * D + 4 * lane + 256 * j); } } while (0)
#pragma unroll
    for (int j = 0; j < 8; ++j) { xf_c[j] = xf_n[j] = (f32x4){0.f, 0.f, 0.f, 0.f}; xb_c[j] = xb_n[j] = yb_c[j] = yb_n[j] = 0ull; }
    if (gw < nrows) ROWS_LOAD(gw, xf_c, xb_c, yb_c);
    for (int row = gw; row < nrows; row += NGW) {
        const bool lat = row < ML; const int v = lat ? (row >> 12) : 4;
        if (row + NGW < nrows) ROWS_LOAD(row + NGW, xf_n, xb_n, yb_n);
        f32x4 x[8];
#pragma unroll
        for (int j = 0; j < 8; ++j) { if (XINB) { const unsigned x0 = (unsigned)xb_c[j], x1 = (unsigned)(xb_c[j] >> 32); x[j] = (f32x4){bflo(x0), bfhi(x0), bflo(x1), bfhi(x1)}; } else x[j] = xf_c[j]; }
        if (Y) {
            f32x4 y[8]; float ss = 0.f;
            if (!lat && Ypart) {
#pragma unroll
                for (int j = 0; j < 8; ++j) { f32x4 a = {0.f, 0.f, 0.f, 0.f};
#pragma unroll
                    for (int sp = 0; sp < KSPLIT; ++sp) { const u64 yw = *(const u64*)(Ypart + ((size_t)sp * MC + (row - ML)) * D + 4 * lane + 256 * j); const unsigned y0 = (unsigned)yw, y1 = (unsigned)(yw >> 32);
                        a += (f32x4){bflo(y0), bfhi(y0), bflo(y1), bfhi(y1)}; }
                    y[j] = a; }
            } else {
#pragma unroll
                for (int j = 0; j < 8; ++j) { const unsigned y0 = (unsigned)yb_c[j], y1 = (unsigned)(yb_c[j] >> 32); y[j] = (f32x4){bflo(y0), bfhi(y0), bflo(y1), bfhi(y1)}; }
            }
#pragma unroll
            for (int j = 0; j < 8; ++j) { ss += (y[j].x * y[j].x + y[j].y * y[j].y) + (y[j].z * y[j].z + y[j].w * y[j].w); }
            const float rs = rsq(wave_sum(ss) * (1.0f / D) + EPS);
            const float* gp = modA + (size_t)v * NMODC + gi * D;
#pragma unroll
            for (int j = 0; j < 8; ++j) { const int c = 4 * lane + 256 * j; const f32x4 g = *(const f32x4*)(gp + c); x[j] += g * (y[j] * rs); }
        }
        if (xout_l) {
            if (XOUTB) { bf16* xo = lat ? (bf16*)xout_l + (size_t)row * D : (bf16*)xout_c + (size_t)(row - ML) * D;
#pragma unroll
                for (int j = 0; j < 8; ++j) *(u64*)(xo + 4 * lane + 256 * j) = (u64)pk2(x[j].x, x[j].y) | ((u64)pk2(x[j].z, x[j].w) << 32);
            } else { float* xo = lat ? (float*)xout_l + (size_t)row * D : (float*)xout_c + (size_t)(row - ML) * D;
#pragma unroll
                for (int j = 0; j < 8; ++j) *(f32x4*)(xo + 4 * lane + 256 * j) = x[j]; } }
        if (Aout) {
            float ss = 0.f;
#pragma unroll
            for (int j = 0; j < 8; ++j) ss += (x[j].x * x[j].x + x[j].y * x[j].y) + (x[j].z * x[j].z + x[j].w * x[j].w);
            const float rs2 = rsq(wave_sum(ss) * (1.0f / D) + EPS);
            const float* shp = modB + (size_t)v * NMODC + si * D; const float* scp = shp + D; bf16* ao = Aout + (size_t)row * D;
#pragma unroll
            for (int j = 0; j < 8; ++j) { const int c = 4 * lane + 256 * j; const f32x4 sh = *(const f32x4*)(shp + c), sc = *(const f32x4*)(scp + c);
                const f32x4 h = (x[j] * rs2) * sc + sh;
                *(u64*)(ao + c) = (u64)pk2(h.x, h.y) | ((u64)pk2(h.z, h.w) << 32); }
        }
#pragma unroll
        for (int j = 0; j < 8; ++j) { xf_c[j] = xf_n[j]; xb_c[j] = xb_n[j]; yb_c[j] = yb_n[j]; }
    }
#undef ROWS_LOAD
}


__device__ __forceinline__ void ph_dt_tasks(Frame& F, int layer) {
    const int tid = launder(F.tid), lane = tid & 63, wave = __builtin_amdgcn_readfirstlane(tid >> 6), bid = opaque_s(F.bid);
    float* const pDT = wsf(F, WS_DT); const bf16* const pA2 = wsb(F, WS_A); const bf16* const pWdt = wsb(F, WS_WIN) + (size_t)PC_DT * D;
    LAS f32x4* red = (LAS f32x4*)(F.lds + AUX_OFF);
    const int r = lane & 15, g = lane >> 4, kq = wave & 3; const float b0 = inp(I_DTB)[layer * 32 + r], b1 = inp(I_DTB)[layer * 32 + 16 + r];
    for (int it = bid; it < M / 32; it += F.G) {
        const int row0 = 32 * it + 16 * (wave >> 2);
        const bf16* ap = pA2 + (size_t)(row0 + r) * D + kq * 512 + 8 * g; const bf16* wp = pWdt + (size_t)r * D + kq * 512 + 8 * g;
        bf16x8 av[16];
#pragma unroll
        for (int ks = 0; ks < 16; ++ks) av[ks] = *(const bf16x8*)(ap + 32 * ks);
        f32x4 a0 = {0.f, 0.f, 0.f, 0.f}, a1 = a0;
#pragma unroll
        for (int ks = 0; ks < 16; ++ks) { const bf16x8 w0_ = *(const bf16x8*)(wp + 32 * ks), w1_ = *(const bf16x8*)(wp + (size_t)16 * D + 32 * ks);
            a0 = __builtin_amdgcn_mfma_f32_16x16x32_bf16(av[ks], w0_, a0, 0, 0, 0); a1 = __builtin_amdgcn_mfma_f32_16x16x32_bf16(av[ks], w1_, a1, 0, 0, 0); }
        red[(wave * 2 + 0) * 64 + lane] = a0; red[(wave * 2 + 1) * 64 + lane] = a1;
        __syncthreads();
        if (kq == 0) {
#pragma unroll
            for (int k = 1; k < 4; ++k) { a0 += red[((wave + k) * 2 + 0) * 64 + lane]; a1 += red[((wave + k) * 2 + 1) * 64 + lane]; }
#pragma unroll
            for (int q = 0; q < 4; ++q) { float* o = pDT + (size_t)(row0 + 4 * g + q) * 32 + r; const float x0 = a0[q] + b0, x1 = a1[q] + b1;
                o[0] = fmaxf(x0, 0.f) + log1pf(__expf(-fabsf(x0))); o[16] = fmaxf(x1, 0.f) + log1pf(__expf(-fabsf(x1))); }
        }
        __syncthreads();
    }
}
__device__ __forceinline__ void ph_prep(Frame& F, int layer) {
    const int tid = launder(F.tid), lane = tid & 63, wave = __builtin_amdgcn_readfirstlane(tid >> 6), bid = opaque_s(F.bid);
    const bf16* const pP = wsb(F, WS_PH); bf16* const pAQ = wsb(F, WS_AQ); bf16* const pAK = wsb(F, WS_AK); bf16* const pSX = wsb(F, WS_SX); bf16* const pSB = wsb(F, WS_SB); bf16* const pSC = wsb(F, WS_SC);
    const int gw = bid * NWAVES + wave, NGW = F.G * NWAVES;
    const float* cw = inp(I_CONVW) + (size_t)layer * 3 * 1536; const float* cb = inp(I_CONVB) + (size_t)layer * 1536;
    LAS float* cosT = (LAS float*)F.lds; LAS float* sinT = cosT + 2048;
    for (int i = tid; i < 2048; i += NTHR) { const float ang = (float)(i >> 5) * powf(10000.0f, -(float)(2 * (i & 31)) / 64.0f); float sn, cs; sincosf(ang, &sn, &cs); cosT[i] = cs; sinT[i] = sn; }
    f32x4 w0[3][2], w1[3][2], w2[3][2], wb[3][2];
#pragma unroll
    for (int r = 0; r < 3; ++r)
#pragma unroll
        for (int hf = 0; hf < 2; ++hf) { const int c = 8 * lane + 512 * r + 4 * hf; w0[r][hf] = *(const f32x4*)(cw + c); w1[r][hf] = *(const f32x4*)(cw + 1536 + c); w2[r][hf] = *(const f32x4*)(cw + 3072 + c); wb[r][hf] = *(const f32x4*)(cb + c); }
    __syncthreads();
    const int ch16 = lane & 15, fb = 8 * (ch16 & 3); const bool second = (ch16 & 4) != 0, colpart = (ch16 & 8) != 0;
    v4u qc, kc, u0c[3], u1c[3], u2c[3], qn, kn, u0n[3], u1n[3], u2n[3];
#define PREP_LOAD(rw, q_, k_, u0_, u1_, u2_) do { const int rw_ = (rw); const bool lat_ = rw_ < ML; const int t_ = lat_ ? (rw_ & (T - 1)) : ((rw_ - ML) & (CL - 1)), tl_ = lat_ ? T : CL; \
        const bf16* pr_ = pP + (size_t)rw_ * INP; q_ = *(const v4u*)(pr_ + PC_AQ + 8 * lane); k_ = *(const v4u*)(pr_ + PC_AK + 8 * (lane & 31)); \
        _Pragma("unroll") for (int r = 0; r < 3; ++r) { const int ch = 8 * lane + 512 * r; u1_[r] = *(const v4u*)(pr_ + PC_XBC + ch); u0_[r] = (v4u){0u, 0u, 0u, 0u}; u2_[r] = (v4u){0u, 0u, 0u, 0u}; \
            if (t_ > 0) u0_[r] = *(const v4u*)(pr_ - INP + PC_XBC + ch); if (t_ < tl_ - 1) u2_[r] = *(const v4u*)(pr_ + INP + PC_XBC + ch); } } while (0)
    qn = kn = (v4u){0u, 0u, 0u, 0u};
#pragma unroll
    for (int r = 0; r < 3; ++r) u0n[r] = u1n[r] = u2n[r] = (v4u){0u, 0u, 0u, 0u};
    if (gw < M) PREP_LOAD(gw, qc, kc, u0c, u1c, u2c);
    for (int row = gw; row < M; row += NGW) {
        const bool lat = row < ML; const int t = lat ? (row & (T - 1)) : ((row - ML) & (CL - 1));
        if (row + NGW < M) PREP_LOAD(row + NGW, qn, kn, u0n, u1n, u2n);
        f32x4 cs0 = {1.f, 1.f, 1.f, 1.f}, cs1 = cs0, sn0 = {0.f, 0.f, 0.f, 0.f}, sn1 = sn0;
        if (lat) { const int pos = colpart ? (t & 63) : (t >> 6); cs0 = *(const LAS f32x4*)(cosT + pos * 32 + fb); cs1 = *(const LAS f32x4*)(cosT + pos * 32 + fb + 4); sn0 = *(const LAS f32x4*)(sinT + pos * 32 + fb); sn1 = *(const LAS f32x4*)(sinT + pos * 32 + fb + 4);
            if (!second) { sn0 = -sn0; sn1 = -sn1; } }
        v4u qo, ko;
#pragma unroll
        for (int e = 0; e < 4; ++e) { const unsigned pq = (unsigned)__shfl_xor((int)qc[e], 4), pk = (unsigned)__shfl_xor((int)kc[e], 4);
            const float c0 = e < 2 ? cs0[2 * e] : cs1[2 * e - 4], c1 = e < 2 ? cs0[2 * e + 1] : cs1[2 * e - 3], s0 = e < 2 ? sn0[2 * e] : sn1[2 * e - 4], s1 = e < 2 ? sn0[2 * e + 1] : sn1[2 * e - 3];
            qo[e] = pk2(bflo(qc[e]) * c0 + bflo(pq) * s0, bfhi(qc[e]) * c1 + bfhi(pq) * s1); ko[e] = pk2(bflo(kc[e]) * c0 + bflo(pk) * s0, bfhi(kc[e]) * c1 + bfhi(pk) * s1); }
        *(v4u*)(pAQ + (size_t)row * 512 + 8 * lane) = qo;
        if (lane < 32) *(v4u*)(pAK + (size_t)row * 256 + 8 * lane) = ko;
#pragma unroll
        for (int r = 0; r < 3; ++r) {
            const int ch = 8 * lane + 512 * r;
            unsigned ow[4];
#pragma unroll
            for (int e2 = 0; e2 < 4; ++e2) { const int hf = e2 >> 1, k0 = 2 * (e2 & 1);
                const float ylo = w0[r][hf][k0] * bflo(u0c[r][e2]) + w1[r][hf][k0] * bflo(u1c[r][e2]) + w2[r][hf][k0] * bflo(u2c[r][e2]) + wb[r][hf][k0];
                const float yhi = w0[r][hf][k0 + 1] * bfhi(u0c[r][e2]) + w1[r][hf][k0 + 1] * bfhi(u1c[r][e2]) + w2[r][hf][k0 + 1] * bfhi(u2c[r][e2]) + wb[r][hf][k0 + 1];
                ow[e2] = pk2(silu(ylo), silu(yhi)); }
            const v4u o = {ow[0], ow[1], ow[2], ow[3]};
            if (ch < 1024) *(v4u*)(pSX + (size_t)row * 1024 + ch) = o;
            else if (ch < 1280) *(v4u*)(pSB + (size_t)row * 256 + (ch - 1024)) = o;
            else *(v4u*)(pSC + (size_t)row * 256 + (ch - 1280)) = o;
        }
        qc = qn; kc = kn;
#pragma unroll
        for (int r = 0; r < 3; ++r) { u0c[r] = u0n[r]; u1c[r] = u1n[r]; u2c[r] = u2n[r]; }
    }
#undef PREP_LOAD
    __syncthreads();
}

__device__ __forceinline__ int swz(int r, int c16) { return r * TS + (c16 << 4); }
__device__ __forceinline__ int swz_el(int r, int col) { return r * TS + (col << 1); }
template <int NT> __device__ __forceinline__ void mma_1xN(f32x4 (&acc)[NT], ldsp At, int arow0, ldsp Bt, int brow0, int lane) {
    const int r = lane & 15, g = lane >> 4;
#pragma unroll
    for (int ks = 0; ks < 4; ++ks) {
        const bf16x8 a = *(const LAS bf16x8*)(At + swz(arow0 + r, 4 * ks + g));
#pragma unroll
        for (int nt = 0; nt < NT; ++nt) {
            const bf16x8 b = *(const LAS bf16x8*)(Bt + swz(brow0 + 16 * nt + r, 4 * ks + g));
            acc[nt] = __builtin_amdgcn_mfma_f32_16x16x32_bf16(a, b, acc[nt], 0, 0, 0);
        }
        __builtin_amdgcn_sched_barrier(0);
    }
}
template <int NT> __device__ __forceinline__ void zero_acc(f32x4 (&acc)[NT]) {
#pragma unroll
    for (int i = 0; i < NT; ++i) acc[i] = (f32x4){0.f, 0.f, 0.f, 0.f};
}
__device__ __forceinline__ void stage_direct(ldsp tile, const bf16* g, int ld, int rows, int tid) {
    for (int c = tid; c < rows * 16; c += NTHR) { const int r = c >> 4, ch = c & 15; *(LAS v4u*)(tile + swz(r, ch)) = *(const v4u*)(g + (size_t)r * ld + ch * 8); }
}
__device__ __forceinline__ void stage_direct_f32(ldsp tile, const float* g, int ld, int rows, int tid) {
    for (int c = tid; c < rows * 16; c += NTHR) { const int r = c >> 4, ch = c & 15; const f32x4 a = *(const f32x4*)(g + (size_t)r * ld + ch * 8), b = *(const f32x4*)(g + (size_t)r * ld + ch * 8 + 4);
        *(LAS v4u*)(tile + swz(r, ch)) = (v4u){pk2(a.x, a.y), pk2(a.z, a.w), pk2(b.x, b.y), pk2(b.z, b.w)}; }
}
__device__ __forceinline__ void stage_tr(ldsp tile, const bf16* g, int ld, int ncols, const LAS float* rs, int tid) {
    const int nch = ncols >> 3;
    for (int c = tid; c < 128 * nch; c += NTHR) { const int r = c & 127, ch = c >> 7; const v4u v = *(const v4u*)(g + (size_t)r * ld + ch * 8); const float sc = rs ? rs[r] : 1.0f;
#pragma unroll
        for (int i = 0; i < 4; ++i) { const float lo = bflo(v[i]) * sc, hi = bfhi(v[i]) * sc;
            *(LAS bf16*)(tile + swz_el(ch * 8 + 2 * i, r)) = (bf16)f2bf(lo); *(LAS bf16*)(tile + swz_el(ch * 8 + 2 * i + 1, r)) = (bf16)f2bf(hi); } }
}

typedef short s16x4 __attribute__((ext_vector_type(4)));
constexpr int TSR = 272;
constexpr int TST = 288;
constexpr int TSX = 544;
__device__ __forceinline__ bf16x8 row_frag(ldsp t, int ts, int row0, int ks, int lane) { return *(const LAS bf16x8*)(t + (row0 + (lane & 15)) * ts + ((4 * ks + (lane >> 4)) << 4)); }
__device__ __forceinline__ bf16x8 tr_frag(ldsp t, int ts, int k0, int c0, int lane) {
    ldsp a = t + (k0 + 4 * (lane >> 4) + ((lane >> 2) & 3)) * ts + (c0 + 4 * (lane & 3)) * 2;
    const s16x4 lo = __builtin_amdgcn_ds_read_tr16_b64_v4i16((LAS s16x4*)a), hi = __builtin_amdgcn_ds_read_tr16_b64_v4i16((LAS s16x4*)(a + 16 * ts));
    return (bf16x8){lo[0], lo[1], lo[2], lo[3], hi[0], hi[1], hi[2], hi[3]};
}
__device__ __forceinline__ bf16x8 acc_frag(f32x4 lo, f32x4 hi) { const v4u w = {cvtpk(lo[0], lo[1]), cvtpk(lo[2], lo[3]), cvtpk(hi[0], hi[1]), cvtpk(hi[2], hi[3])}; return __builtin_bit_cast(bf16x8, w); }
__device__ __forceinline__ bf16x8 scale_frag(bf16x8 a, const LAS float* w, int k0, int lane) {
    const f32x4 wl = *(const LAS f32x4*)(w + k0 + 4 * (lane >> 4)), wh = *(const LAS f32x4*)(w + k0 + 16 + 4 * (lane >> 4)); const v4u x = __builtin_bit_cast(v4u, a);
    const v4u o = {cvtpk(bflo(x[0]) * wl[0], bfhi(x[0]) * wl[1]), cvtpk(bflo(x[1]) * wl[2], bfhi(x[1]) * wl[3]), cvtpk(bflo(x[2]) * wh[0], bfhi(x[2]) * wh[1]), cvtpk(bflo(x[3]) * wh[2], bfhi(x[3]) * wh[3])};
    return __builtin_bit_cast(bf16x8, o);
}
#define MFMA16(a, b, c) __builtin_amdgcn_mfma_f32_16x16x32_bf16(a, b, c, 0, 0, 0)
#define SCHED_FENCE() __builtin_amdgcn_sched_barrier(0)
template <int MT> __device__ __forceinline__ void mma_xt(f32x4 (&acc)[MT], ldsp t, int ts, const bf16x8 (&own)[4], int lane) {
    bf16x8 a[MT];
#pragma unroll
    for (int mt = 0; mt < MT; ++mt) a[mt] = row_frag(t, ts, 16 * mt, 0, lane);
#pragma unroll
    for (int ks = 0; ks < 4; ++ks) { bf16x8 an[MT];
        if (ks < 3) {
#pragma unroll
            for (int mt = 0; mt < MT; ++mt) an[mt] = row_frag(t, ts, 16 * mt, ks + 1, lane); }
#pragma unroll
        for (int mt = 0; mt < MT; ++mt) acc[mt] = MFMA16(a[mt], own[ks], acc[mt]);
        SCHED_FENCE();
        if (ks < 3) {
#pragma unroll
            for (int mt = 0; mt < MT; ++mt) a[mt] = an[mt]; }
    }
}
template <int NT, bool SWAP = false> __device__ __forceinline__ void mma_at(f32x4 (&acc)[NT], const bf16x8 (&afr)[4], ldsp t, int ts, int c0, int lane) {
    bf16x8 b[NT];
#pragma unroll
    for (int nt = 0; nt < NT; ++nt) b[nt] = tr_frag(t, ts, 0, c0 + 16 * nt, lane);
#pragma unroll
    for (int ks = 0; ks < 4; ++ks) { bf16x8 bn[NT];
        if (ks < 3) {
#pragma unroll
            for (int nt = 0; nt < NT; ++nt) bn[nt] = tr_frag(t, ts, 32 * (ks + 1), c0 + 16 * nt, lane); }
#pragma unroll
        for (int nt = 0; nt < NT; ++nt) acc[nt] = SWAP ? MFMA16(b[nt], afr[ks], acc[nt]) : MFMA16(afr[ks], b[nt], acc[nt]);
        SCHED_FENCE();
        if (ks < 3) {
#pragma unroll
            for (int nt = 0; nt < NT; ++nt) b[nt] = bn[nt]; }
    }
}
template <int ROWS, int COLS> struct Stage { static constexpr int CPR = COLS / 8, N = ROWS * CPR / NTHR; v4u v[N];
    __device__ __forceinline__ void load(const bf16* g, int ld, int tid) {
#pragma unroll
        for (int i = 0; i < N; ++i) { const int c = tid + NTHR * i, r = c / CPR, ch = c % CPR; v[i] = *(const v4u*)(g + (size_t)r * ld + ch * 8); } }
    __device__ __forceinline__ void store(ldsp tile, int ts, int tid) const {
#pragma unroll
        for (int i = 0; i < N; ++i) { const int c = tid + NTHR * i, r = c / CPR, ch = c % CPR; *(LAS v4u*)(tile + r * ts + (ch << 4)) = v[i]; } }
};

__device__ __forceinline__ void m2_ret_unit(Frame& F, int layer, int cr, int h, bool need_y) {
    const int tid = launder(F.tid), lane = tid & 63, w = __builtin_amdgcn_readfirstlane(tid >> 6), r = lane & 15, g = lane >> 4;
    const bf16* Pm = wsb(F, WS_PH) + (size_t)cr * 128 * INP; bf16* const pYR = wsb(F, WS_YR); bf16* const pRS = wsb(F, WS_RS);
    ldsp TK = F.lds, TV = F.lds + 128 * TSR;
    LAS float* aux = (LAS float*)(F.lds + AUX_OFF);
    LAS float* ef = aux; LAS float* eb = aux + 128; LAS float* nf = aux + 256; LAS float* nb = aux + 384; LAS float* wf = aux + 512; LAS float* wb = aux + 640;
    const float scale = 0.08838834764831845f;
    Stage<128, 128> sk, sv; sk.load(Pm + PC_RK + h * 128, INP, tid); sv.load(Pm + PC_RV + h * 128, INP, tid);
    bf16x8 qf[4];
#pragma unroll
    for (int ks = 0; ks < 4; ++ks) qf[ks] = *(const bf16x8*)(Pm + (size_t)(16 * w + r) * INP + PC_RQ + h * 128 + 32 * ks + 8 * g);
    const float lgf = -fabsf(inp(I_RDEC)[layer * 8 + h]), lgb = -fabsf(inp(I_RDEC)[layer * 8 + 4 + h]);
    __syncthreads();
    sk.store(TK, TSR, tid); sv.store(TV, TST, tid);
    if (tid < 128) { const float t = (float)tid; ef[tid] = __expf(lgf * t); nf[tid] = __expf(-lgf * t); eb[tid] = __expf(lgb * t); nb[tid] = __expf(-lgb * t); wf[tid] = __expf(lgf * (127.f - t)); wb[tid] = __expf(lgb * t); }
    __syncthreads();
    f32x4 s[8]; zero_acc(s); mma_xt<8>(s, TK, TSR, qf, lane);
    { const int i = 16 * w + r; const float efi = ef[i] * scale, nbi = nb[i] * scale;
#pragma unroll
      for (int mt = 0; mt < 8; ++mt) { const int j0 = 16 * mt + 4 * g; const f32x4 nfj = *(const LAS f32x4*)(nf + j0), ebj = *(const LAS f32x4*)(eb + j0);
#pragma unroll
          for (int q = 0; q < 4; ++q) { const int j = j0 + q; const float dec = (i >= j ? efi * nfj[q] : 0.f) + (i <= j ? nbi * ebj[q] : 0.f); s[mt][q] *= dec; } } }
    bf16x8 pa[4];
#pragma unroll
    for (int ks = 0; ks < 4; ++ks) pa[ks] = acc_frag(s[2 * ks], s[2 * ks + 1]);
    if (need_y) { f32x4 y[8]; zero_acc(y); mma_at<8, true>(y, pa, TV, TST, 0, lane);
#pragma unroll
        for (int nt = 0; nt < 8; ++nt) *(unsigned long long*)(pYR + (size_t)(cr * 128 + 16 * w + r) * 512 + h * 128 + 16 * nt + 4 * g) = (unsigned long long)cvtpk(y[nt][0], y[nt][1]) | ((unsigned long long)cvtpk(y[nt][2], y[nt][3]) << 32); }
#pragma unroll
    for (int dir = 0; dir < 2; ++dir) { bf16x8 va[4];
#pragma unroll
        for (int ks = 0; ks < 4; ++ks) va[ks] = scale_frag(tr_frag(TV, TST, 32 * ks, 16 * w, lane), dir ? wb : wf, 32 * ks, lane);
        f32x4 u[8]; zero_acc(u); mma_at<8, true>(u, va, TK, TSR, 0, lane);
        bf16* dst = pRS + ((size_t)(cr * 4 + h) * 2 + dir) * 16384 + (16 * w + r) * 128 + 4 * g;
#pragma unroll
        for (int nt = 0; nt < 8; ++nt) *(unsigned long long*)(dst + 16 * nt) = (unsigned long long)cvtpk(u[nt][0], u[nt][1]) | ((unsigned long long)cvtpk(u[nt][2], u[nt][3]) << 32); }
}
__device__ __forceinline__ void m2_ssd_unit(Frame& F, int layer, int cr, int grp, int hq, bool need_y) {
    const int tid = launder(F.tid), lane = tid & 63, w = __builtin_amdgcn_readfirstlane(tid >> 6), r = lane & 15, g = lane >> 4, m0 = cr * 128, h0 = grp * 8 + hq * 4;
    const bf16* const pSX = wsb(F, WS_SX); const bf16* const pSB = wsb(F, WS_SB); const bf16* const pSC = wsb(F, WS_SC); const float* const pDT = wsf(F, WS_DT);
    float* const pCUMF = wsf(F, WS_CUMF); float* const pRCUMB = wsf(F, WS_RCUMB); float* const pSDEC = wsf(F, WS_SDEC); bf16* const pYS = wsb(F, WS_YS); bf16* const pSS = wsb(F, WS_SS);
    ldsp TB = F.lds, TX = F.lds + 128 * TSR;
    LAS float* aux = (LAS float*)(F.lds + AUX_OFF);
    Stage<128, 128> sb; Stage<128, 256> sx; sb.load(pSB + (size_t)m0 * 256 + grp * 128, 256, tid); sx.load(pSX + (size_t)m0 * 1024 + h0 * 64, 1024, tid);
    bf16x8 cf[4];
#pragma unroll
    for (int ks = 0; ks < 4; ++ks) cf[ks] = *(const bf16x8*)(pSC + (size_t)(m0 + 16 * w + r) * 256 + grp * 128 + 32 * ks + 8 * g);
    const int chh = w >> 1, cdir = w & 1, ch_ = h0 + chh;
    const float alog_ = inp(I_ALOG)[layer * 32 + cdir * 16 + ch_], d0 = pDT[(size_t)(m0 + lane) * 32 + cdir * 16 + ch_], d1 = pDT[(size_t)(m0 + 64 + lane) * 32 + cdir * 16 + ch_];
    __syncthreads();
    sb.store(TB, TSR, tid); sx.store(TX, TSX, tid);
    {
      const int hh = chh, dir = cdir, h = ch_; const float a = -__expf(alog_);
      float p0 = d0 * a, p1 = d1 * a; const float l0 = p0, l1 = p1;
#pragma unroll
      for (int o = 1; o < 64; o <<= 1) { const float t0 = __shfl_up(p0, o), t1 = __shfl_up(p1, o); if (lane >= o) { p0 += t0; p1 += t1; } }
      const float tot0 = __shfl(p0, 63), tot = tot0 + __shfl(p1, 63); p1 += tot0;
      float c0, c1, w0, w1;
      if (dir == 0) { c0 = p0; c1 = p1; w0 = d0 * __expf(tot - p0); w1 = d1 * __expf(tot - p1); }
      else { c0 = tot - p0 + l0; c1 = tot - p1 + l1; w0 = d0 * __expf(tot - c0); w1 = d1 * __expf(tot - c1); }
      LAS float* base = aux + (hh * 2 + dir) * 384;
      const float L2E = 1.44269504089f;
      base[lane] = c0 * L2E; base[64 + lane] = c1 * L2E; base[128 + lane] = d0; base[192 + lane] = d1; base[256 + lane] = w0; base[320 + lane] = w1;
      float* cg = dir ? pRCUMB : pCUMF; cg[(size_t)(m0 + lane) * 16 + h] = c0 * L2E; cg[(size_t)(m0 + 64 + lane) * 16 + h] = c1 * L2E;
      if (lane == 0) pSDEC[(size_t)(cr * 16 + h) * 2 + dir] = __expf(tot);
    }
    __syncthreads();
    f32x4 cb[8]; zero_acc(cb); mma_xt<8>(cb, TB, TSR, cf, lane);
    for (int hh = 0; hh < 4; ++hh) {
        const int h = h0 + hh, l = 16 * w + r;
        const LAS float* cumf = aux + (hh * 2) * 384; const LAS float* dtf = cumf + 128; const LAS float* wf = cumf + 256;
        const LAS float* rcum = aux + (hh * 2 + 1) * 384; const LAS float* dtb = rcum + 128; const LAS float* wb = rcum + 256;
        const float cfl = cumf[l], rcl = rcum[l];
        f32x4 m[8];
#pragma unroll
        for (int mt = 0; mt < 8; ++mt) { const int s0 = 16 * mt + 4 * g;
            if (mt < w) { const f32x4 cs = *(const LAS f32x4*)(cumf + s0), ds = *(const LAS f32x4*)(dtf + s0);
#pragma unroll
                for (int q = 0; q < 4; ++q) m[mt][q] = cb[mt][q] * (__builtin_amdgcn_exp2f(cfl - cs[q]) * ds[q]);
            } else if (mt > w) { const f32x4 rs = *(const LAS f32x4*)(rcum + s0), es = *(const LAS f32x4*)(dtb + s0);
#pragma unroll
                for (int q = 0; q < 4; ++q) m[mt][q] = cb[mt][q] * (__builtin_amdgcn_exp2f(rcl - rs[q]) * es[q]);
            } else { const f32x4 cs = *(const LAS f32x4*)(cumf + s0), ds = *(const LAS f32x4*)(dtf + s0), rs = *(const LAS f32x4*)(rcum + s0), es = *(const LAS f32x4*)(dtb + s0);
#pragma unroll
                for (int q = 0; q < 4; ++q) { const int s = s0 + q; const float mf = (l >= s) ? __builtin_amdgcn_exp2f(cfl - cs[q]) * ds[q] : 0.f, mb = (l <= s) ? __builtin_amdgcn_exp2f(rcl - rs[q]) * es[q] : 0.f; m[mt][q] = cb[mt][q] * (mf + mb); } } }
        bf16x8 pa[4];
#pragma unroll
        for (int ks = 0; ks < 4; ++ks) pa[ks] = acc_frag(m[2 * ks], m[2 * ks + 1]);
        if (need_y) { f32x4 y[4]; zero_acc(y); mma_at<4, true>(y, pa, TX, TSX, hh * 64, lane);
#pragma unroll
            for (int nt = 0; nt < 4; ++nt) *(unsigned long long*)(pYS + (size_t)(m0 + 16 * w + r) * 1024 + h * 64 + 16 * nt + 4 * g) = (unsigned long long)cvtpk(y[nt][0], y[nt][1]) | ((unsigned long long)cvtpk(y[nt][2], y[nt][3]) << 32); }
#pragma unroll
        for (int dir = 0; dir < 2; ++dir) { bf16x8 xa[4];
#pragma unroll
            for (int ks = 0; ks < 4; ++ks) xa[ks] = scale_frag(tr_frag(TX, TSX, 32 * ks, hh * 64 + 16 * (w & 3), lane), dir ? wb : wf, 32 * ks, lane);
            f32x4 u[4]; zero_acc(u); mma_at<4, true>(u, xa, TB, TSR, 64 * (w >> 2), lane);
            bf16* dst = pSS + ((size_t)(cr * 16 + h) * 2 + dir) * 8192 + (16 * (w & 3) + r) * 128 + 64 * (w >> 2) + 4 * g;
#pragma unroll
            for (int nt = 0; nt < 4; ++nt) *(unsigned long long*)(dst + 16 * nt) = (unsigned long long)cvtpk(u[nt][0], u[nt][1]) | ((unsigned long long)cvtpk(u[nt][2], u[nt][3]) << 32); }
    }
}
__device__ __forceinline__ void m2_att_unit(Frame& F, int layer, int b, int qb, int qh, bool is_ctx) {
    const int tid = launder(F.tid), lane = tid & 63, w = __builtin_amdgcn_readfirstlane(tid >> 6), r = lane & 15, g = lane >> 4, kvh = qh >> 1;
    const bf16* const pAQ = wsb(F, WS_AQ); const bf16* const pAK = wsb(F, WS_AK); const bf16* const pP = wsb(F, WS_PH); bf16* const pA = wsb(F, WS_A);
    const int qrow0 = is_ctx ? (ML + b * CL + qb * 128) : (b * T + qb * 128);
    constexpr int KVB = 128 * TSR + 128 * TST;
    const float scale = 0.08838834764831845f;
    const int nleft = (!is_ctx && qb > 0) ? 1 : 0, nright = (!is_ctx && qb < T / 128 - 1) ? 1 : 0, nt_ = is_ctx ? 2 : 3 + nleft + nright, crow = ML + b * CL;
#define TILE_INFO(ti, row, mode) do { int t_ = (ti); row = crow + t_ * 128; mode = 0; \
        if (!is_ctx) { if (t_ == 0) row = qrow0; else if (nleft && t_ == 1) { row = qrow0 - 128; mode = 1; } else if (nright && t_ == 1 + nleft) { row = qrow0 + 128; mode = 2; } else row = crow + (t_ - 1 - nleft - nright) * 128; } } while (0)
    bf16x8 qf[4];
#pragma unroll
    for (int ks = 0; ks < 4; ++ks) qf[ks] = *(const bf16x8*)(pAQ + (size_t)(qrow0 + 16 * w + r) * 512 + qh * 128 + 32 * ks + 8 * g);
    float mrun = -1e30f, lrun = 0.f; f32x4 o[8]; zero_acc(o);
    v4u kr[4], vr[4];
    const int srow = tid >> 4, sch = tid & 15;
    { int row0_, mode0_; TILE_INFO(0, row0_, mode0_); (void)mode0_; const bf16* kg = pAK + (size_t)(row0_ + srow) * 256 + kvh * 128 + sch * 8; const bf16* vg = pP + (size_t)(row0_ + srow) * INP + PC_AV + kvh * 128 + sch * 8;
#pragma unroll
      for (int k = 0; k < 4; ++k) { kr[k] = *(const v4u*)(kg + (size_t)(32 * k) * 256); vr[k] = *(const v4u*)(vg + (size_t)(32 * k) * INP); } }
    __syncthreads();
#pragma unroll
    for (int k = 0; k < 4; ++k) { *(LAS v4u*)(F.lds + (srow + 32 * k) * TSR + (sch << 4)) = kr[k]; *(LAS v4u*)(F.lds + 128 * TSR + (srow + 32 * k) * TST + (sch << 4)) = vr[k]; }
    __syncthreads();
    for (int ti = 0; ti < nt_; ++ti) {
        ldsp TK = F.lds + (ti & 1) * KVB, TV = TK + 128 * TSR;
        int mode, row_cur; TILE_INFO(ti, row_cur, mode); (void)row_cur;
        if (ti + 1 < nt_) { int tr_, mode_n; TILE_INFO(ti + 1, tr_, mode_n); (void)mode_n; const bf16* kg = pAK + (size_t)(tr_ + srow) * 256 + kvh * 128 + sch * 8; const bf16* vg = pP + (size_t)(tr_ + srow) * INP + PC_AV + kvh * 128 + sch * 8;
#pragma unroll
            for (int k = 0; k < 4; ++k) { kr[k] = *(const v4u*)(kg + (size_t)(32 * k) * 256); vr[k] = *(const v4u*)(vg + (size_t)(32 * k) * INP); } }
        f32x4 s[8]; zero_acc(s); mma_xt<8>(s, TK, TSR, qf, lane);
        const int i = 16 * w + r; float mx = -1e30f;
#pragma unroll
        for (int mt = 0; mt < 8; ++mt)
#pragma unroll
            for (int q = 0; q < 4; ++q) { const int j = 16 * mt + 4 * g + q; const bool valid = (mode == 0) || (mode == 1 ? (j >= i) : (j <= i)); const float v = valid ? s[mt][q] * scale : -INFINITY; s[mt][q] = v; mx = fmaxf(mx, v); }
        mx = fmaxf(mx, __shfl_xor(mx, 16)); mx = fmaxf(mx, __shfl_xor(mx, 32));
        const float mnew = fmaxf(mrun, mx), alpha = __expf(mrun - mnew); float rsum = 0.f;
#pragma unroll
        for (int mt = 0; mt < 8; ++mt)
#pragma unroll
            for (int q = 0; q < 4; ++q) { const float p = __expf(s[mt][q] - mnew); s[mt][q] = p; rsum += p; }
        rsum += __shfl_xor(rsum, 16); rsum += __shfl_xor(rsum, 32);
        lrun = lrun * alpha + rsum; mrun = mnew;
        bf16x8 pa[4];
#pragma unroll
        for (int ks = 0; ks < 4; ++ks) pa[ks] = acc_frag(s[2 * ks], s[2 * ks + 1]);
#pragma unroll
        for (int nt = 0; nt < 8; ++nt) o[nt] = o[nt] * alpha;
        mma_at<8, true>(o, pa, TV, TST, 0, lane);
        if (ti + 1 < nt_) { ldsp NK = F.lds + ((ti + 1) & 1) * KVB, NV = NK + 128 * TSR;
#pragma unroll
            for (int k = 0; k < 4; ++k) { *(LAS v4u*)(NK + (srow + 32 * k) * TSR + (sch << 4)) = kr[k]; *(LAS v4u*)(NV + (srow + 32 * k) * TST + (sch << 4)) = vr[k]; } }
        __syncthreads();
    }
    const float sk = inp(I_SINK)[layer * 4 + qh];
    const float mfin = fmaxf(mrun, sk), afin = __expf(mrun - mfin), lfin = lrun * afin + __expf(sk - mfin), fq_ = afin / lfin;
#pragma unroll
    for (int nt = 0; nt < 8; ++nt) { const f32x4 ov = o[nt] * fq_;
        *(unsigned long long*)(pA + (size_t)(qrow0 + 16 * w + r) * D + 512 + qh * 128 + 16 * nt + 4 * g) = (unsigned long long)cvtpk(ov[0], ov[1]) | ((unsigned long long)cvtpk(ov[2], ov[3]) << 32); }
#undef TILE_INFO
}
__device__ __forceinline__ void ph_m2(Frame& F, int layer, bool ctx_out, int which = 7) {
    const int tid = launder(F.tid), lane = tid & 63, wave = __builtin_amdgcn_readfirstlane(tid >> 6), bid = opaque_s(F.bid); (void)lane; (void)wave; (void)bid;
    const int natt = 512 + (ctx_out ? 32 : 0);
    const int vb = (F.G & 7) == 0 ? (bid & 7) * (F.G >> 3) + (bid >> 3) : bid;
    if (which & 1) for (int u = vb; u < natt; u += F.G) {
        if (u < 512) m2_att_unit(F, layer, u >> 7, (u >> 2) & 31, u & 3, false);
        else { const int v = u - 512; m2_att_unit(F, layer, v >> 3, (v >> 2) & 1, v & 3, true); }
    }
    if (which & 2) for (int u = (vb + 224) % F.G; u < NCR * 4; u += F.G) { const int cr = u >> 2; m2_ssd_unit(F, layer, cr, (u >> 1) & 1, u & 1, ctx_out || cr < 128); }
    if (which & 4) for (int u = (vb + 192) % F.G; u < NCR * 4; u += F.G) { const int cr = u >> 2; m2_ret_unit(F, layer, cr, u & 3, ctx_out || cr < 128); }
    __syncthreads();
}

__device__ __forceinline__ int chain_cr(int b, int dir, int step) {
    if (step < 2) return 128 + b * 2 + (dir ? 1 - step : step);
    return b * 32 + (dir ? 33 - step : step - 2);
}
__device__ __forceinline__ void ph_scan(Frame& F, int layer) {
    const int tid = launder(F.tid), bid = opaque_s(F.bid);
    const bf16* const pRS = wsb(F, WS_RS); const bf16* const pSS = wsb(F, WS_SS); const float* const pSDEC = wsf(F, WS_SDEC); const float* const iRDEC = inp(I_RDEC);
    bf16* const pRSB = wsb(F, WS_RSB); bf16* const pSSB = wsb(F, WS_SSB);
    const int gt = bid * NTHR + tid, NT_ = F.G * NTHR;
    for (int it = gt; it < 65536 + 131072; it += NT_) {
        const bool ret = it < 65536; const int j = ret ? it : it - 65536;
        int e8, x, dir, h, b; if (ret) { e8 = j & 2047; x = j >> 11; dir = x & 1; h = (x >> 1) & 3; b = x >> 3; } else { e8 = j & 1023; x = j >> 10; dir = x & 1; h = (x >> 1) & 15; b = x >> 5; }
        const bf16* src = ret ? pRS : pSS; bf16* dstb = ret ? pRSB : pSSB; const int nh = ret ? 4 : 16, tsz = ret ? 16384 : 8192;
        const float rdec = ret ? __expf(-fabsf(iRDEC[layer * 8 + dir * 4 + h]) * 128.0f) : 0.f;
        float s[8];
#pragma unroll
        for (int k = 0; k < 8; ++k) s[k] = 0.f;
#pragma unroll
        for (int b0 = 0; b0 < 34; b0 += 12) { constexpr int NBMAX = 12; v4u u[NBMAX]; float dc[NBMAX]; size_t of[NBMAX];
#pragma unroll
            for (int i = 0; i < NBMAX; ++i) if (b0 + i < 34) { const int cr = chain_cr(b, dir, b0 + i); of[i] = ((size_t)(cr * nh + h) * 2 + dir) * tsz + e8 * 8; u[i] = *(const v4u*)(src + of[i]); dc[i] = ret ? rdec : pSDEC[(size_t)(cr * 16 + h) * 2 + dir]; }
#pragma unroll
            for (int i = 0; i < NBMAX; ++i) if (b0 + i < 34) {
                *(v4u*)(dstb + of[i]) = (v4u){pk2(s[0], s[1]), pk2(s[2], s[3]), pk2(s[4], s[5]), pk2(s[6], s[7])};
#pragma unroll
                for (int k = 0; k < 4; ++k) { s[2 * k] = s[2 * k] * dc[i] + bflo(u[i][k]); s[2 * k + 1] = s[2 * k + 1] * dc[i] + bfhi(u[i][k]); } } }
    }
}


__device__ __forceinline__ void m4_ret_unit(Frame& F, int layer, int cr, int h) {
    const int tid = launder(F.tid), lane = tid & 63, w = __builtin_amdgcn_readfirstlane(tid >> 6), r = lane & 15, g = lane >> 4, i = 16 * w + r;
    const bf16* const pYR = wsb(F, WS_YR); const bf16* const pRSB = wsb(F, WS_RSB); bf16* const pA = wsb(F, WS_A); const bf16* const pP = wsb(F, WS_PH);
    const size_t m = (size_t)cr * 128 + i;
    const float scale = 0.08838834764831845f;
    ldsp T0 = F.lds, T1 = F.lds + 128 * TSR;
    Stage<128, 128> s0, s1; s0.load(pRSB + ((size_t)(cr * 4 + h) * 2 + 0) * 16384, 128, tid); s1.load(pRSB + ((size_t)(cr * 4 + h) * 2 + 1) * 16384, 128, tid);
    bf16x8 qf[4];
#pragma unroll
    for (int ks = 0; ks < 4; ++ks) qf[ks] = *(const bf16x8*)(pP + m * INP + PC_RQ + h * 128 + 32 * ks + 8 * g);
    unsigned long long yq[8], gq[8];
#pragma unroll
    for (int mt = 0; mt < 8; ++mt) { yq[mt] = *(const unsigned long long*)(pYR + m * 512 + h * 128 + 16 * mt + 4 * g); gq[mt] = *(const unsigned long long*)(pP + m * INP + PC_RG + h * 128 + 16 * mt + 4 * g); }
    const float lgf = -fabsf(inp(I_RDEC)[layer * 8 + h]), lgb = -fabsf(inp(I_RDEC)[layer * 8 + 4 + h]);
    __syncthreads();
    s0.store(T0, TSR, tid); s1.store(T1, TSR, tid);
    __syncthreads();
    f32x4 af[8], ab[8]; zero_acc(af); zero_acc(ab);
    mma_xt<8>(af, T0, TSR, qf, lane); mma_xt<8>(ab, T1, TSR, qf, lane);
    const float qfac = __expf(lgf * (float)(i + 1)) * scale, qbac = __expf(lgb * (float)(128 - i)) * scale;
    f32x4 y[8]; float sm = 0.f;
#pragma unroll
    for (int mt = 0; mt < 8; ++mt) { const unsigned long long yw = yq[mt]; const unsigned y0 = (unsigned)yw, y1 = (unsigned)(yw >> 32);
        y[mt] = (f32x4){bflo(y0), bfhi(y0), bflo(y1), bfhi(y1)} + af[mt] * qfac + ab[mt] * qbac; sm += (y[mt][0] + y[mt][1]) + (y[mt][2] + y[mt][3]); }
    sm += __shfl_xor(sm, 16); sm += __shfl_xor(sm, 32);
    const float mu = sm * (1.0f / 128.0f); float vs = 0.f;
#pragma unroll
    for (int mt = 0; mt < 8; ++mt) { y[mt] = y[mt] - mu; vs += (y[mt][0] * y[mt][0] + y[mt][1] * y[mt][1]) + (y[mt][2] * y[mt][2] + y[mt][3] * y[mt][3]); }
    vs += __shfl_xor(vs, 16); vs += __shfl_xor(vs, 32);
    const float rstd = rsq(vs * (1.0f / 128.0f) + EPS);
    const float* nw = inp(I_RNW) + layer * 512 + h * 128;
#pragma unroll
    for (int mt = 0; mt < 8; ++mt) { const int e = 16 * mt + 4 * g; const f32x4 wv = *(const f32x4*)(nw + e);
        const unsigned long long gt = gq[mt]; const unsigned g0 = (unsigned)gt, g1 = (unsigned)(gt >> 32);
        const f32x4 o = y[mt] * rstd * wv;
        *(unsigned long long*)(pA + m * D + h * 128 + e) = (unsigned long long)pk2(o[0] * silu(bflo(g0)), o[1] * silu(bfhi(g0))) | ((unsigned long long)pk2(o[2] * silu(bflo(g1)), o[3] * silu(bfhi(g1))) << 32); }
}
__device__ __forceinline__ void m4_ssd_unit(Frame& F, int layer, int cr, int flags = 7) {
    const int tid = launder(F.tid), lane = tid & 63, w = __builtin_amdgcn_readfirstlane(tid >> 6), r = lane & 15, g = lane >> 4;
    const float* const pCUMF = wsf(F, WS_CUMF); const float* const pRCUMB = wsf(F, WS_RCUMB); const bf16* const pYS = wsb(F, WS_YS); const bf16* const pSSB = wsb(F, WS_SSB);
    bf16* const pA = wsb(F, WS_A); const bf16* const pP = wsb(F, WS_PH); const bf16* const pSX = wsb(F, WS_SX); const bf16* const pSC = wsb(F, WS_SC);
    const float* const nw = inp(I_SNW) + layer * 1024; const float* const dskp = inp(I_DSKIP) + layer * 16;
    const size_t m = (size_t)cr * 128 + 16 * w + r;
    typedef unsigned long long u64;
    constexpr int HB = 4 * 64 * TSR;
    v4u sr[8];
    const bf16* sbase = pSSB + (size_t)(cr * 16) * 2 * 8192 + (size_t)tid * 8;
#define M4_RHO(p) (16 * (2 * ((p) >> 5) + (((p) >> 2) & 1)) + 4 * (((p) >> 3) & 3) + ((p) & 3))
#define M4_COL(mt) (32 * ((mt) >> 1) + 8 * g + 4 * ((mt) & 1))
#define M4_STAGE_LD(step) _Pragma("unroll") for (int k = 0; k < 8; ++k) sr[k] = *(const v4u*)(sbase + (size_t)(step) * 32768 + (size_t)k * 4096)
#define M4_STAGE_ST(buf) _Pragma("unroll") for (int k = 0; k < 8; ++k) { const int c = tid + 512 * k; *(LAS v4u*)(F.lds + (buf) * HB + (c >> 10) * (64 * TSR) + M4_RHO((c >> 4) & 63) * TSR + ((c & 15) << 4)) = sr[k]; }
    u64 yq[2][4], xq[2][4], zq[2][4]; float cfq[2], cbq[2], dq[2];
#define M4_EPI_LD(step) _Pragma("unroll") for (int j = 0; j < 2; ++j) { const int hh_ = 2 * (step) + j; \
        _Pragma("unroll") for (int mt = 0; mt < 4; ++mt) { const int c = hh_ * 64 + M4_COL(mt); yq[j][mt] = *(const u64*)(pYS + m * 1024 + c); xq[j][mt] = *(const u64*)(pSX + m * 1024 + c); \
            zq[j][mt] = *(const u64*)(pP + m * INP + PC_Z + c); } \
        cfq[j] = pCUMF[m * 16 + hh_]; cbq[j] = pRCUMB[m * 16 + hh_]; dq[j] = dskp[hh_]; }
    const int s0 = cr & 7;
    M4_STAGE_LD(s0); M4_EPI_LD(s0);
    __syncthreads();
    M4_STAGE_ST(0);
    __syncthreads();
    bf16x8 cf[4]; float ssq = 0.f;
    for (int s = 0; s < 8; ++s) { const int sp = (s + s0) & 7, spn = (s + 1 + s0) & 7;
        if (s == 0 || (sp & 3) == 0) {
#pragma unroll
            for (int ks = 0; ks < 4; ++ks) cf[ks] = *(const bf16x8*)(pSC + m * 256 + (sp >> 2) * 128 + 32 * ks + 8 * g); }
        if (s < 7) { M4_STAGE_LD(spn); }
        ldsp T = F.lds + (s & 1) * HB;
        f32x4 acc[2][2][4];
#pragma unroll
        for (int j = 0; j < 2; ++j)
#pragma unroll
            for (int dir = 0; dir < 2; ++dir) { zero_acc(acc[j][dir]); if (flags & 1) mma_xt<4>(acc[j][dir], T + (2 * j + dir) * (64 * TSR), TSR, cf, lane); }
        if (flags & 2)
#pragma unroll
        for (int j = 0; j < 2; ++j) { const float ef = __builtin_amdgcn_exp2f(cfq[j]), eb = __builtin_amdgcn_exp2f(cbq[j]), dsk = dq[j];
#pragma unroll
            for (int mt = 0; mt < 4; ++mt) { const int c = (2 * sp + j) * 64 + M4_COL(mt);
                const unsigned x0 = (unsigned)xq[j][mt], x1 = (unsigned)(xq[j][mt] >> 32), z0 = (unsigned)zq[j][mt], z1 = (unsigned)(zq[j][mt] >> 32), y0 = (unsigned)yq[j][mt], y1 = (unsigned)(yq[j][mt] >> 32);
                f32x4 y = (f32x4){bflo(y0), bfhi(y0), bflo(y1), bfhi(y1)} + acc[j][0][mt] * ef + acc[j][1][mt] * eb;
                y[0] = (y[0] + dsk * bflo(x0)) * silu(bflo(z0)); y[1] = (y[1] + dsk * bfhi(x0)) * silu(bfhi(z0)); y[2] = (y[2] + dsk * bflo(x1)) * silu(bflo(z1)); y[3] = (y[3] + dsk * bfhi(x1)) * silu(bfhi(z1));
                ssq += (y[0] * y[0] + y[1] * y[1]) + (y[2] * y[2] + y[3] * y[3]);
                *(u64*)(pA + m * D + 1024 + c) = (u64)pk2(y[0], y[1]) | ((u64)pk2(y[2], y[3]) << 32); } }
        if (s < 7) { M4_EPI_LD(spn); M4_STAGE_ST((s + 1) & 1); }
        __syncthreads();
    }
#undef M4_RHO
#undef M4_STAGE_LD
#undef M4_STAGE_ST
#undef M4_EPI_LD
    ssq += __shfl_xor(ssq, 16); ssq += __shfl_xor(ssq, 32);
    const float rs = rsq(ssq * (1.0f / 1024.0f) + EPS);
    if (flags & 4)
#pragma unroll
    for (int bq = 0; bq < 4; ++bq) { u64 v[16]; f32x4 nv[16];
#pragma unroll
        for (int k = 0; k < 16; ++k) { const int c = (4 * bq + (k >> 2)) * 64 + M4_COL(k & 3); v[k] = *(const u64*)(pA + m * D + 1024 + c); nv[k] = *(const f32x4*)(nw + c); }
#pragma unroll
        for (int k = 0; k < 16; ++k) { const unsigned v0 = (unsigned)v[k], v1 = (unsigned)(v[k] >> 32); const f32x4 sc = nv[k] * rs;
            *(u64*)(pA + m * D + 1024 + (4 * bq + (k >> 2)) * 64 + M4_COL(k & 3)) = (u64)pk2(bflo(v0) * sc[0], bfhi(v0) * sc[1]) | ((u64)pk2(bflo(v1) * sc[2], bfhi(v1) * sc[3]) << 32); } }
#undef M4_COL
}
__device__ __forceinline__ void ph_m4(Frame& F, int layer, bool ctx_out, int which = 3) {
    const int bid = opaque_s(F.bid);
    const int ncr = ctx_out ? NCR : 128;
    if (bid < ncr) { if (which & 1) {
#ifdef PROBE_M4FLAGS
        for (int rep_ = 0; rep_ < 4; ++rep_) m4_ssd_unit(F, layer, bid, opaque_s(PROBE_M4FLAGS));
#endif
        m4_ssd_unit(F, layer, bid); } }
    else if (which & 2) for (int u = bid - ncr; u < ncr * 4; u += F.G - ncr) m4_ret_unit(F, layer, u >> 2, u & 3);
    __syncthreads();
    if (ctx_out && which == 3) convert_set(F, layer + 1, false, ncr, 1);
}

constexpr int PH_PER_LAYER = 13, PH_TOTAL = 3 + NLAYER * PH_PER_LAYER;
__global__ void __launch_bounds__(NTHR, 2) fwd_kernel(Args args) {
    extern __shared__ __attribute__((aligned(16))) unsigned char lds_raw[];
    Frame F;
    F.lds = (ldsp)lds_raw; F.MISC = (volatile LAS unsigned*)(F.lds + MISC_OFF);
    F.tid = threadIdx.x; F.lane = F.tid & 63; F.wave = __builtin_amdgcn_readfirstlane(F.tid >> 6); F.G = gridDim.x; F.bid = blockIdx.x;
    F.out = args.out; unsigned char* ws = args.ws; F.ws = ws;
    for (int u = F.tid; u < (LDS_BYTES - MISC_OFF) / 4; u += NTHR) ((LAS unsigned*)(F.lds + MISC_OFF))[u] = 0u;
    __syncthreads();
    const int lo = args.ph_lo, hi = args.ph_hi;
    XcdBarrier bar; bar.bar = (unsigned*)(ws + WS_CTL) + CW_BAR; bar.x = 0; bar.st = nullptr;
    if (hi - lo > 1) bar = xcd_barrier_post((unsigned*)(ws + WS_CTL) + CW_BAR, F.MISC + 8);
#define IN(k) ((unsigned)(opaque_s(k) - lo) < (unsigned)(hi - lo))
#if defined(PROBE_REP) && (PROBE_REP & 8)
#define PROBE_ROWS(x) x __syncthreads();
#else
#define PROBE_ROWS(x)
#endif
#if defined(PROBE_SPIN)
    unsigned long long tprev_ = __builtin_amdgcn_s_memrealtime();
#define SEAM(k) do { if (IN(k) && IN((k) + 1)) xcd_barrier(bar); \
        if (((unsigned long long)(PROBE_SPIN) >> (k)) & 1ull) { const unsigned long long t1_ = __builtin_amdgcn_s_memrealtime(); \
            while (__builtin_amdgcn_s_memrealtime() - t1_ < t1_ - tprev_) __builtin_amdgcn_s_sleep(16); __syncthreads(); } \
        tprev_ = __builtin_amdgcn_s_memrealtime(); } while (0)
#else
#define SEAM(k) do { if (IN(k) && IN((k) + 1)) xcd_barrier(bar); } while (0)
#endif

    if (IN(0)) { ph_adaln_partial(F); convert_set(F, 0, false, 0);
    }
    SEAM(0);
    if (IN(1)) ph_mod_reduce(F);
    SEAM(1);
    if (IN(2)) ph_rows<false, false>(F, M, inp(I_X), inp(I_CTX), nullptr, nullptr, nullptr, nullptr, nullptr, 0, nullptr, 0.f, wsb(F, WS_A), wsf(F, WS_MOD), 0, inp(I_NORMW));
    SEAM(2);
    for (int layer = 0; layer < NLAYER; ++layer) {
        const int pb = 3 + layer * PH_PER_LAYER; const bool last = layer == NLAYER - 1; const int Mrows = last ? ML : M;
#define modL (wsf(F, WS_MOD) + (size_t)layer * 5 * NMODC)
#define nw (inp(I_NORMW) + (size_t)layer * 6 * D)
        if (IN(pb + 0)) { pg8::Gemm gm{wsb(F, WS_A), wsb(F, WS_WGU1), D, D}; pg8::StaticOrder S; S.init(M, NGU, D, F.G, opaque_s(F.bid)); pg8::EpiSwiGLU E{wsb(F, WS_PH), DFF};
            pg8::gemm_phase<pg8::EpiSwiGLU, pg8::StaticOrder, true, true>(F.lds + RING_OFF, gm, S, E);
#if defined(PROBE_REP) && (PROBE_REP & 4)
            __syncthreads(); pg8::gemm_phase<pg8::EpiSwiGLU, pg8::StaticOrder, true, true>(F.lds + RING_OFF, gm, S, E);
#endif
        }
        if (IN(pb + 0)) convert_set(F, layer, true, (M / 256) * (NGU / 256) % F.G, 3);
        SEAM(pb + 0);
        if (IN(pb + 1)) { pg8::Gemm gm{wsb(F, WS_PH), wsb(F, WS_WD1), DFF, DFF}; pg8::StaticOrder S; S.init(ML, D, DFF, F.G, opaque_s(F.bid), MC, KSPLIT); pg8::EpiYbf16 E{wsb(F, WS_Y), D, wsb(F, WS_YP), ML, MC};
            pg8::gemm_phase<pg8::EpiYbf16, pg8::StaticOrder, true, true>(F.lds + RING_OFF, gm, S, E);
#if defined(PROBE_REP) && (PROBE_REP & 128)
            __syncthreads(); pg8::gemm_phase<pg8::EpiYbf16, pg8::StaticOrder, true, true>(F.lds + RING_OFF, gm, S, E);
#endif
        }
        if (IN(pb + 1)) convert_set(F, layer, true, (MC / 256) * (D / 256) * KSPLIT, 2);
        SEAM(pb + 1);
        if (IN(pb + 2)) { bf16* xb = wsb(F, WS_XB);
            if (layer == 0) ph_rows<false, true>(F, M, inp(I_X), inp(I_CTX), xb, xb + (size_t)ML * D, wsb(F, WS_Y), wsb(F, WS_YP), modL, 2, nw + D, 0.5f, wsb(F, WS_A), modL, 3, nw + 2 * D);
            else ph_rows<true, true>(F, M, xb, xb + (size_t)ML * D, xb, xb + (size_t)ML * D, wsb(F, WS_Y), wsb(F, WS_YP), modL, 2, nw + D, 0.5f, wsb(F, WS_A), modL, 3, nw + 2 * D); }
        SEAM(pb + 2);
        if (IN(pb + 3)) { pg8::Gemm gm{wsb(F, WS_A), wsb(F, WS_WIN), D, D}; pg8::StaticOrder S; S.init(M, INP, D, F.G, opaque_s(F.bid)); pg8::EpiProj E{wsb(F, WS_PH), INP};
            pg8::gemm_phase<pg8::EpiProj, pg8::StaticOrder, true, true>(F.lds + RING_OFF, gm, S, E);
#if defined(PROBE_REP) && (PROBE_REP & 256)
            __syncthreads(); pg8::gemm_phase<pg8::EpiProj, pg8::StaticOrder, true, true>(F.lds + RING_OFF, gm, S, E);
#endif
        }
        if (IN(pb + 3)) convert_set(F, layer, true, (M / 256) * (INP / 256) % F.G, 4);
        SEAM(pb + 3);
        if (IN(pb + 4)) { ph_dt_tasks(F, layer); ph_prep(F, layer);
#if defined(PROBE_REP) && (PROBE_REP & 1)
            ph_prep(F, layer);
#endif
        }
        SEAM(pb + 4);
        if (IN(pb + 5)) { ph_m2(F, layer, !last);
#if defined(PROBE_REP) && (PROBE_REP & 2)
            for (int rep_ = 0; rep_ < 4; ++rep_) ph_m2(F, layer, !last, PROBE_WHICH);
#endif
        }
        SEAM(pb + 5);
        if (IN(pb + 6)) {
#if defined(PROBE_REP) && (PROBE_REP & 32)
            ph_scan(F, layer); __syncthreads();
#endif
            ph_scan(F, layer); }
        SEAM(pb + 6);
        if (IN(pb + 7)) {
#if defined(PROBE_REP) && (PROBE_REP & 64)
            for (int rep_ = 0; rep_ < 4; ++rep_) { ph_m4(F, layer, !last, PROBE_WHICH); __syncthreads(); }
#endif
            ph_m4(F, layer, !last); }
        SEAM(pb + 7);
        if (IN(pb + 8)) { pg8::Gemm gm{wsb(F, WS_A), wsb(F, WS_WOUT), D, D}; pg8::StaticOrder S; S.init(ML, D, D, F.G, opaque_s(F.bid), last ? 0 : MC, KSPLIT); pg8::EpiYbf16 E{wsb(F, WS_Y), D, wsb(F, WS_YP), ML, MC};
            pg8::gemm_phase<pg8::EpiYbf16, pg8::StaticOrder, true, true>(F.lds + RING_OFF, gm, S, E); }
        SEAM(pb + 8);
        if (IN(pb + 9)) ph_rows<true, true>(F, Mrows, wsb(F, WS_XB), wsb(F, WS_XB) + (size_t)ML * D, wsb(F, WS_XB), wsb(F, WS_XB) + (size_t)ML * D, wsb(F, WS_Y), wsb(F, WS_YP), modL, 5, nw + 3 * D, 1.0f, wsb(F, WS_A), modL, 6, nw + 4 * D);
        SEAM(pb + 9);
        if (IN(pb + 10)) { pg8::Gemm gm{wsb(F, WS_A), wsb(F, WS_WGU2), D, D}; pg8::StaticOrder S; S.init(Mrows, NGU, D, F.G, opaque_s(F.bid)); pg8::EpiSwiGLU E{wsb(F, WS_PH), DFF};
            pg8::gemm_phase<pg8::EpiSwiGLU, pg8::StaticOrder, true, true>(F.lds + RING_OFF, gm, S, E); }
        if (IN(pb + 10) && !last) convert_set(F, layer + 1, false, (M / 256) * (NGU / 256) % F.G, 5);
        SEAM(pb + 10);
        if (IN(pb + 11)) { pg8::Gemm gm{wsb(F, WS_PH), wsb(F, WS_WD2), DFF, DFF}; pg8::StaticOrder S; S.init(ML, D, DFF, F.G, opaque_s(F.bid), last ? 0 : MC, KSPLIT); pg8::EpiYbf16 E{wsb(F, WS_Y), D, wsb(F, WS_YP), ML, MC};
            pg8::gemm_phase<pg8::EpiYbf16, pg8::StaticOrder, true, true>(F.lds + RING_OFF, gm, S, E); }
        if (IN(pb + 11) && !last) convert_set(F, layer + 1, false, (MC / 256) * (D / 256) * KSPLIT, 6);
        SEAM(pb + 11);
        if (IN(pb + 12)) {
            if (!last) { ph_rows<true, true>(F, M, wsb(F, WS_XB), wsb(F, WS_XB) + (size_t)ML * D, wsb(F, WS_XB), wsb(F, WS_XB) + (size_t)ML * D, wsb(F, WS_Y), wsb(F, WS_YP), modL, 8, nw + 5 * D, 0.5f, wsb(F, WS_A), modL + 5 * NMODC, 0, nw + 6 * D);
            }
            else ph_rows<true, false>(F, ML, wsb(F, WS_XB), wsb(F, WS_XB) + (size_t)ML * D, F.out, nullptr, wsb(F, WS_Y), nullptr, modL, 8, nw + 5 * D, 0.5f, nullptr, nullptr, 0, nullptr);
        }
        SEAM(pb + 12);
    }
#undef modL
#undef nw
#undef IN
#undef SEAM
}

#ifndef MK_SINGLE
#define MK_SINGLE 1
#endif
extern "C" void kernel_launch(void* const* d_in, const int* in_sizes, int n_in, void* d_out, int out_size, void* d_ws, size_t ws_size, hipStream_t stream) {
    static int grid = 0;
    if (grid == 0) {
        if (n_in != 22 || in_sizes[0] != ML * D || out_size != ML * D || ws_size < WS_END) { fprintf(stderr, "kernel_launch: unexpected shapes (n_in %d, in0 %d, out %d, ws %zu < %zu?); nothing launched\n", n_in, n_in > 0 ? in_sizes[0] : -1, out_size, ws_size, (size_t)WS_END); grid = -1; return; }
        int dev = 0, cus = 0, per_cu = 0;
        if (hipGetDevice(&dev) != hipSuccess || hipDeviceGetAttribute(&cus, hipDeviceAttributeMultiprocessorCount, dev) != hipSuccess) { grid = -1; return; }
        if (hipFuncSetAttribute((const void*)fwd_kernel, hipFuncAttributeMaxDynamicSharedMemorySize, LDS_BYTES) != hipSuccess) { fprintf(stderr, "kernel_launch: hipFuncSetAttribute failed\n"); grid = -1; return; }
        if (hipOccupancyMaxActiveBlocksPerMultiprocessor(&per_cu, (const void*)fwd_kernel, NTHR, LDS_BYTES) != hipSuccess || per_cu < 1) fprintf(stderr, "kernel_launch: occupancy query reports %d\n", per_cu);
        (void)hipGetLastError();
        grid = cus;
    }
    if (grid < 0) return;
    (void)hipMemsetAsync((char*)d_ws + WS_CTL, 0, CTL_ZERO_BYTES, stream);
    Args a{};
    for (int i = 0; i < 22; ++i) a.in[i] = (const float*)d_in[i];
    a.out = (float*)d_out; a.ws = (unsigned char*)d_ws;
#if MK_SINGLE
    a.ph_lo = 0; a.ph_hi = PH_TOTAL;
    hipLaunchKernelGGL(fwd_kernel, dim3(grid), dim3(NTHR), LDS_BYTES, stream, a);
#else
    for (int p = 0; p < PH_TOTAL; ++p) { a.ph_lo = p; a.ph_hi = p + 1; hipLaunchKernelGGL(fwd_kernel, dim3(grid), dim3(NTHR), LDS_BYTES, stream, a); }
#endif
}
```

```cpp
#include <hip/hip_runtime.h>
#include <cstdio>
#include <cstdint>
#include <cmath>
namespace pg8 {
#define PG8_LAS __attribute__((address_space(3)))
typedef unsigned short bf16_t;
typedef short bf16x8 __attribute__((ext_vector_type(8)));
typedef float f32x4 __attribute__((ext_vector_type(4)));
typedef unsigned u32x4 __attribute__((ext_vector_type(4)));
constexpr int BM = 256, BK = 64, HALF = 128, HTB = HALF * BK * 2  , STAGE_BYTES = 8 * HTB, NXCD = 8, WGM = 4;

#ifndef PG8_SWZ128
#define PG8_SWZ128 0
#endif
#if PG8_SWZ128
__host__ __device__ __forceinline__ int lds_sw(int r) { return (r & 7) ^ ((r >> 3) & 1); }
__host__ __device__ __forceinline__ int lds_byte(int r, int c) { return (r >> 3) * 1024 + (r & 7) * 128 + ((((c >> 3) ^ lds_sw(r)) & 7) << 4) + (c & 7) * 2; }
__host__ __device__ __forceinline__ void stage_rc(int b, int& R, int& C) { R = (b >> 10) * 8 + ((b >> 7) & 7); C = ((((b >> 4) & 7) ^ lds_sw(R)) << 3) + ((b & 15) >> 1); }
#else
__host__ __device__ __forceinline__ int lds_byte(int r, int c) { const int st = (r >> 4) * 2 + (c >> 5), rr = r & 15, cc = c & 31, ob = rr * 64 + cc * 2; return st * 1024 + (ob ^ (((ob >> 9) & 1) << 5)); }
__host__ __device__ __forceinline__ void stage_rc(int b, int& R, int& C) { const int st = b / 1024, sb = b % 1024, swz = sb ^ (((sb >> 9) & 1) << 5); R = (st >> 1) * 16 + swz / 64; C = (st & 1) * 32 + (swz % 64) / 2; }
#endif
__host__ __device__ __forceinline__ int perm32(int rho) { const int n = rho >> 4, i = rho & 15; return 8 * (i >> 2) + 4 * n + (i & 3); }

struct Unit { int pm, pn, kt0, nt, part; };
struct Gemm { const bf16_t* A; const bf16_t* Bt; int lda, K; };

struct StaticOrder {
    int nM, nN, nwg, G, c, ntk, nMt, S;
    __host__ __device__ void init(int Mfull, int N, int K, int G_, int c_, int Mtail = 0, int S_ = 1) { nM = Mfull / BM; nN = N / BM; nwg = nM * nN; G = G_; c = c_; ntk = K / BK; nMt = Mtail / BM; S = S_; }
    __host__ __device__ bool next(int i, Unit& u) const {
        const long L = (long)i * G + c; int pm, pn, kt0 = 0, nt = ntk, part = -1;
        if (L >= nwg) { const int t = (int)(L - nwg); if (t >= nMt * nN * S) return false;
            const int s = t % S, q = t / S; pn = q % nN; pm = nM + q / nN; nt = ntk / S; kt0 = s * nt; part = s; }
        else { int wgid = (int)L; { const int q = nwg / NXCD, r = nwg % NXCD, xcd = wgid % NXCD, off = wgid / NXCD; wgid = (xcd < r ? xcd * (q + 1) : r * (q + 1) + (xcd - r) * q) + off; }
            const int nig = WGM * nN, gid = wgid / nig, fm = gid * WGM, gsz = (nM - fm) < WGM ? (nM - fm) : WGM;
            pm = fm + ((wgid % nig) % gsz); pn = (wgid % nig) / gsz; }
        u.pm = pm; u.pn = pn; u.kt0 = kt0; u.nt = nt; u.part = part; return true;
    }
    __device__ __forceinline__ void a_ready(const Unit&) const {}
    __device__ __forceinline__ void done(const Unit&) const {}
};


__device__ __forceinline__ unsigned cvt_pk_bf16(float lo, float hi) { unsigned r; asm volatile("v_cvt_pk_bf16_f32 %0, %1, %2" : "=v"(r) : "v"(lo), "v"(hi)); return r; }
__device__ __forceinline__ float silu_f(float x) { return x * __builtin_amdgcn_rcpf(1.0f + __builtin_amdgcn_exp2f(x * -1.44269504089f)); }

struct EpiF32 {
    static constexpr bool PERM = false, AFTER_DRAIN = false;
    float* C; int ldc; float* Cpart; int tail_row0, tail_rows;
    __device__ __forceinline__ void operator()(const f32x4 (&acc)[2][2][4][2], const Unit& u, int wr, int wc, int fr, int fq) const {
        int row0 = u.pm * BM + wr * 64 + fr; const int col0 = u.pn * BM + wc * 32 + 4 * fq; float* base = C;
        if (u.part >= 0) { row0 -= tail_row0; base = Cpart + (size_t)u.part * tail_rows * ldc; }
#pragma unroll
        for (int ai = 0; ai < 2; ++ai)
#pragma unroll
            for (int m = 0; m < 4; ++m) { float* rowp = base + (size_t)(row0 + ai * HALF + m * 16) * ldc + col0;
#pragma unroll
                for (int bj = 0; bj < 2; ++bj)
#pragma unroll
                    for (int n = 0; n < 2; ++n) *(f32x4*)(rowp + bj * HALF + n * 16) = acc[ai][bj][m][n]; }
    }
};
struct EpiYbf16 {
    static constexpr bool PERM = true, AFTER_DRAIN = false;
    bf16_t* C; int ldc; bf16_t* Cpart; int tail_row0, tail_rows;
    __device__ __forceinline__ void operator()(const f32x4 (&acc)[2][2][4][2], const Unit& u, int wr, int wc, int fr, int fq) const {
        int row0 = u.pm * BM + wr * 64 + fr; const int col0 = u.pn * BM + wc * 32 + 8 * fq; bf16_t* base = C;
        if (u.part >= 0) { row0 -= tail_row0; base = Cpart + (size_t)u.part * tail_rows * ldc; }
#pragma unroll
        for (int ai = 0; ai < 2; ++ai)
#pragma unroll
            for (int m = 0; m < 4; ++m) { bf16_t* rowp = base + (size_t)(row0 + ai * HALF + m * 16) * ldc + col0;
#pragma unroll
                for (int bj = 0; bj < 2; ++bj) { const f32x4 v0 = acc[ai][bj][m][0], v1 = acc[ai][bj][m][1];
                    u32x4 w; w.x = cvt_pk_bf16(v0[0], v0[1]); w.y = cvt_pk_bf16(v0[2], v0[3]); w.z = cvt_pk_bf16(v1[0], v1[1]); w.w = cvt_pk_bf16(v1[2], v1[3]);
                    *(u32x4*)(rowp + bj * HALF) = w; } }
    }
};
struct EpiSwiGLU {
    static constexpr bool PERM = true, AFTER_DRAIN = false;
    bf16_t* O; int ldc;
    __device__ __forceinline__ void operator()(const f32x4 (&acc)[2][2][4][2], const Unit& u, int wr, int wc, int fr, int fq) const {
        const int row0 = u.pm * BM + wr * 64 + fr, col0 = u.pn * HALF + wc * 32 + 8 * fq;
#pragma unroll
        for (int ai = 0; ai < 2; ++ai)
#pragma unroll
            for (int m = 0; m < 4; ++m) { bf16_t* rowp = O + (size_t)(row0 + ai * HALF + m * 16) * ldc + col0;
                const f32x4 g0 = acc[ai][0][m][0], g1 = acc[ai][0][m][1], u0 = acc[ai][1][m][0], u1 = acc[ai][1][m][1];
                u32x4 w; w.x = cvt_pk_bf16(silu_f(g0[0]) * u0[0], silu_f(g0[1]) * u0[1]); w.y = cvt_pk_bf16(silu_f(g0[2]) * u0[2], silu_f(g0[3]) * u0[3]);
                w.z = cvt_pk_bf16(silu_f(g1[0]) * u1[0], silu_f(g1[1]) * u1[1]); w.w = cvt_pk_bf16(silu_f(g1[2]) * u1[2], silu_f(g1[3]) * u1[3]);
                *(u32x4*)rowp = w; }
    }
};
struct EpiProj {
    static constexpr bool PERM = true, AFTER_DRAIN = false;
    bf16_t* O; int ldc;
    __device__ __forceinline__ void operator()(const f32x4 (&acc)[2][2][4][2], const Unit& u, int wr, int wc, int fr, int fq) const {
        const int row0 = u.pm * BM + wr * 64 + fr, col0 = u.pn * BM + wc * 32 + 8 * fq;
#pragma unroll
        for (int ai = 0; ai < 2; ++ai)
#pragma unroll
            for (int m = 0; m < 4; ++m) { const int row = row0 + ai * HALF + m * 16; bf16_t* rowp = O + (size_t)row * ldc + col0;
#pragma unroll
                for (int bj = 0; bj < 2; ++bj) { const f32x4 v0 = acc[ai][bj][m][0], v1 = acc[ai][bj][m][1];
                    u32x4 w; w.x = cvt_pk_bf16(v0[0], v0[1]); w.y = cvt_pk_bf16(v0[2], v0[3]); w.z = cvt_pk_bf16(v1[0], v1[1]); w.w = cvt_pk_bf16(v1[2], v1[3]);
                    *(u32x4*)(rowp + bj * HALF) = w; } }
    }
};

template <class Epi, class Sched, bool ALIGN_EPI = false, bool SP2 = false>
__device__ __forceinline__ void gemm_phase(PG8_LAS unsigned char* lds, const Gemm g, const Sched& S, const Epi& E) {
    int tid_ = threadIdx.x; asm volatile("" : "+v"(tid_)); const int tid = tid_, wid = __builtin_amdgcn_readfirstlane(tid >> 6), lane = tid & 63, wr = wid >> 2, wc = wid & 3, fr = lane & 15, fq = lane >> 4;
    const int K = g.K, lda = g.lda;
    unsigned voffA[2], voffB[2];
#pragma unroll
    for (int i = 0; i < 2; ++i) { int R, C; stage_rc(tid * 16 + i * 8192, R, C); const int Rb = Epi::PERM ? ((R & ~31) + perm32(R & 31)) : R;
        voffA[i] = (unsigned)(R * lda + C) * 2u; voffB[i] = (unsigned)(Rb * K + C) * 2u; }
    const size_t kstep = (size_t)(BK * 2);
    const size_t hstepB = (size_t)HALF * K * 2, hstepA = (size_t)HALF * lda * 2;
    const size_t tstepB = 2 * hstepB, tstepA = 2 * hstepA;
    const unsigned ldsw = (unsigned)wid * 1024u;
    const int aoffk[2] = {lds_byte(wr * 64 + fr, fq * 8), lds_byte(wr * 64 + fr, 32 + fq * 8)}, boffk[2] = {lds_byte(wc * 32 + fr, fq * 8), lds_byte(wc * 32 + fr, 32 + fq * 8)};
#define PG8_SA(b, h) (((b) * 2 + (h)) * HTB)
#define PG8_SB(b, h) ((4 + (b) * 2 + (h)) * HTB)
#define PG8_STAGE(bufoff, gbase, voff) do { _Pragma("unroll") for (int _i = 0; _i < 2; ++_i) \
        __builtin_amdgcn_global_load_lds((const unsigned*)((const char*)(gbase) + (voff)[_i]), (PG8_LAS unsigned*)(lds + (bufoff) + ldsw + _i * 8192), 16, 0, 0); } while (0)
#define PG8_LDA(dst, b, h) do { _Pragma("unroll") for (int m = 0; m < 4; ++m) _Pragma("unroll") for (int k = 0; k < 2; ++k) dst[m][k] = *(const PG8_LAS bf16x8*)(lds + PG8_SA(b, h) + aoffk[k] + m * 2048); } while (0)
#define PG8_LDB(dst, b, h) do { _Pragma("unroll") for (int n = 0; n < 2; ++n) _Pragma("unroll") for (int k = 0; k < 2; ++k) dst[n][k] = *(const PG8_LAS bf16x8*)(lds + PG8_SB(b, h) + boffk[k] + n * 2048); } while (0)
#define PG8_MMA(ai, bj, At, Bt) do { __builtin_amdgcn_s_setprio(1); _Pragma("unroll") for (int m = 0; m < 4; ++m) _Pragma("unroll") for (int n = 0; n < 2; ++n) _Pragma("unroll") for (int k = 0; k < 2; ++k) \
        acc[ai][bj][m][n] = __builtin_amdgcn_mfma_f32_16x16x32_bf16(Bt[n][k], At[m][k], acc[ai][bj][m][n], 0, 0, 0); __builtin_amdgcn_s_setprio(0); } while (0)
#define PG8_WAIT_V(n) asm volatile("s_waitcnt vmcnt(" #n ")" ::: "memory")
#define PG8_WAIT_L(n) asm volatile("s_waitcnt lgkmcnt(" #n ")" ::: "memory")
#define PG8_BAR __builtin_amdgcn_s_barrier()
#define PG8_SCHED __builtin_amdgcn_sched_barrier(0)
    Unit cur, nxt; int ui = 0;
    if (!S.next(0, cur)) return;
    f32x4 acc[2][2][4][2];
#pragma unroll
    for (int a = 0; a < 2; ++a)
#pragma unroll
        for (int b = 0; b < 2; ++b)
#pragma unroll
            for (int m = 0; m < 4; ++m)
#pragma unroll
                for (int n = 0; n < 2; ++n) acc[a][b][m][n] = (f32x4){0.f, 0.f, 0.f, 0.f};
    bf16x8 At[4][2], B0[2][2], B1[2][2];
    const char* cA = (const char*)g.A + (size_t)cur.pm * tstepA + (size_t)cur.kt0 * kstep; const char* cB = (const char*)g.Bt + (size_t)cur.pn * tstepB + (size_t)cur.kt0 * kstep;
    S.a_ready(cur);
    if constexpr (SP2) {
        PG8_STAGE(PG8_SB(0, 0), cB, voffB); PG8_STAGE(PG8_SB(0, 1), cB + hstepB, voffB); PG8_STAGE(PG8_SA(0, 0), cA, voffA); PG8_STAGE(PG8_SA(0, 1), cA + hstepA, voffA);
        if (wr == 1) PG8_BAR;
        PG8_WAIT_V(2); PG8_BAR;
        PG8_STAGE(PG8_SB(1, 0), cB + kstep, voffB); PG8_STAGE(PG8_SA(1, 0), cA + kstep, voffA); PG8_STAGE(PG8_SB(1, 1), cB + hstepB + kstep, voffB);
        PG8_WAIT_V(6); PG8_BAR;
    } else {
        PG8_STAGE(PG8_SB(0, 0), cB, voffB); PG8_STAGE(PG8_SA(0, 0), cA, voffA); PG8_STAGE(PG8_SB(0, 1), cB + hstepB, voffB); PG8_STAGE(PG8_SA(0, 1), cA + hstepA, voffA);
        if (wr == 1) PG8_BAR;
        PG8_WAIT_V(4); PG8_BAR;
        PG8_STAGE(PG8_SB(1, 0), cB + kstep, voffB); PG8_STAGE(PG8_SA(1, 0), cA + kstep, voffA); PG8_STAGE(PG8_SB(1, 1), cB + hstepB + kstep, voffB);
        PG8_WAIT_V(6); PG8_BAR;
    }
    for (;;) {
        const bool has_next = S.next(ui + 1, nxt);
        const char* nA = has_next ? (const char*)g.A + (size_t)nxt.pm * tstepA + (size_t)nxt.kt0 * kstep : cA; const char* nB = has_next ? (const char*)g.Bt + (size_t)nxt.pn * tstepB + (size_t)nxt.kt0 * kstep : cB;
        const int nt = cur.nt;
        for (int t = 0; t < nt; t += 2) {
            const bool last = (t == nt - 2);
            const char* a1 = cA + (size_t)(t + 1) * kstep;
            const char* a2 = last ? nA : cA + (size_t)(t + 2) * kstep; const char* b2 = last ? nB : cB + (size_t)(t + 2) * kstep;
            const char* a3 = a2 + kstep; const char* b3 = b2 + kstep;
            if (last && has_next) S.a_ready(nxt);
            if constexpr (SP2) {
            PG8_LDB(B0, 0, 0); PG8_LDB(B1, 0, 1); PG8_SCHED; PG8_LDA(At, 0, 0); PG8_STAGE(PG8_SA(1, 1), a1 + hstepA, voffA);
            PG8_WAIT_V(8); PG8_WAIT_L(0); PG8_BAR; PG8_MMA(0, 0, At, B0); PG8_MMA(0, 1, At, B1); PG8_BAR; PG8_SCHED;
            PG8_LDA(At, 0, 1); PG8_STAGE(PG8_SB(0, 0), b2, voffB); PG8_STAGE(PG8_SB(0, 1), b2 + hstepB, voffB); PG8_STAGE(PG8_SA(0, 0), a2, voffA);
            PG8_WAIT_V(8); PG8_WAIT_L(0); PG8_BAR; PG8_MMA(1, 0, At, B0); PG8_MMA(1, 1, At, B1); PG8_BAR; PG8_SCHED;
            PG8_LDB(B0, 1, 0); PG8_LDB(B1, 1, 1); PG8_SCHED; PG8_LDA(At, 1, 0); PG8_STAGE(PG8_SA(0, 1), a2 + hstepA, voffA);
            PG8_WAIT_V(8); PG8_WAIT_L(0); PG8_BAR; PG8_MMA(0, 0, At, B0); PG8_MMA(0, 1, At, B1); PG8_BAR; PG8_SCHED;
            PG8_LDA(At, 1, 1); PG8_STAGE(PG8_SB(1, 0), b3, voffB); PG8_STAGE(PG8_SB(1, 1), b3 + hstepB, voffB); PG8_STAGE(PG8_SA(1, 0), a3, voffA);
            PG8_WAIT_V(8); PG8_WAIT_L(0); PG8_BAR; PG8_MMA(1, 0, At, B0); PG8_MMA(1, 1, At, B1); PG8_BAR; PG8_SCHED;
            } else {
            PG8_LDB(B0, 0, 0); PG8_SCHED; PG8_LDA(At, 0, 0); PG8_STAGE(PG8_SA(1, 1), a1 + hstepA, voffA);
            PG8_WAIT_L(8); PG8_BAR; PG8_WAIT_L(0); PG8_MMA(0, 0, At, B0); PG8_BAR; PG8_SCHED;
            PG8_LDB(B1, 0, 1); PG8_STAGE(PG8_SB(0, 0), b2, voffB);
            PG8_BAR; PG8_WAIT_L(0); PG8_MMA(0, 1, At, B1); PG8_BAR;
            PG8_LDA(At, 0, 1); PG8_STAGE(PG8_SA(0, 0), a2, voffA);
            PG8_BAR; PG8_WAIT_L(0); PG8_MMA(1, 0, At, B0); PG8_BAR; PG8_SCHED;
            PG8_STAGE(PG8_SB(0, 1), b2 + hstepB, voffB);
            PG8_WAIT_V(6); PG8_BAR; PG8_MMA(1, 1, At, B1); PG8_BAR;
            PG8_LDB(B0, 1, 0); PG8_SCHED; PG8_LDA(At, 1, 0); PG8_STAGE(PG8_SA(0, 1), a2 + hstepA, voffA);
            PG8_WAIT_L(8); PG8_BAR; PG8_WAIT_L(0); PG8_MMA(0, 0, At, B0); PG8_BAR; PG8_SCHED;
            PG8_LDB(B1, 1, 1); PG8_STAGE(PG8_SB(1, 0), b3, voffB);
            PG8_BAR; PG8_WAIT_L(0); PG8_MMA(0, 1, At, B1); PG8_BAR;
            PG8_LDA(At, 1, 1); PG8_STAGE(PG8_SA(1, 0), a3, voffA);
            PG8_BAR; PG8_WAIT_L(0); PG8_MMA(1, 0, At, B0); PG8_BAR; PG8_SCHED;
            PG8_STAGE(PG8_SB(1, 1), b3 + hstepB, voffB);
            PG8_WAIT_V(6); PG8_BAR; PG8_MMA(1, 1, At, B1); PG8_BAR;
            }
        }
        if constexpr (ALIGN_EPI) { if (wr == 0) PG8_BAR; }
        if constexpr (!Epi::AFTER_DRAIN) { E(acc, cur, wr, wc, fr, fq); S.done(cur); }
        if (!has_next) break;
#pragma unroll
        for (int a = 0; a < 2; ++a)
#pragma unroll
            for (int b = 0; b < 2; ++b)
#pragma unroll
                for (int m = 0; m < 4; ++m)
#pragma unroll
                    for (int n = 0; n < 2; ++n) acc[a][b][m][n] = (f32x4){0.f, 0.f, 0.f, 0.f};
        cur = nxt; cA = nA; cB = nB; ++ui;
        if constexpr (ALIGN_EPI) { if (wr == 1) PG8_BAR; }
    }
    PG8_WAIT_V(0);
    if constexpr (!ALIGN_EPI) { if (wr == 0) PG8_BAR; }
    PG8_BAR;
    if constexpr (Epi::AFTER_DRAIN) { E.fused(acc, cur, wr, wc, fr, fq, lds, wid, lane); S.done(cur); }
#undef PG8_SA
#undef PG8_SB
#undef PG8_STAGE
#undef PG8_LDA
#undef PG8_LDB
#undef PG8_MMA
#undef PG8_WAIT_V
#undef PG8_WAIT_L
#undef PG8_BAR
#undef PG8_SCHED
}
}

constexpr int D = 2048, NB = 4, T = 4096, CL = 256, ML = NB * T, MC = NB * CL, M = ML + MC;
constexpr int DFF = 5632, NGU = 2 * DFF, INC = 5664, INP = 5632, NMODC = 9 * D;
constexpr int NCR = M / 128;
constexpr int NLAYER = 2, KSPLIT = 4;
constexpr float EPS = 1e-6f;
constexpr int NWAVES = 8, NTHR = 512;
constexpr int PC_RQ = 0, PC_RK = 512, PC_RV = 1024, PC_RG = 1536, PC_AQ = 2048, PC_AK = 2560, PC_AV = 2816, PC_Z = 3072, PC_XBC = 4096, PC_DT = 5632;

constexpr size_t MiB = 1u << 20;
constexpr size_t WS_CTL = 0, CTL_ZERO_BYTES = 1 * MiB;
constexpr size_t WS_MOD = 1 * MiB;
constexpr size_t WS_MODP = 2 * MiB;
constexpr size_t WS_WGU1 = 14 * MiB, WS_WD1 = 58 * MiB, WS_WGU2 = 80 * MiB, WS_WD2 = 124 * MiB, WS_WIN = 146 * MiB, WS_WOUT = 169 * MiB;
constexpr size_t WS_XC = 177 * MiB;
constexpr size_t WS_A = 185 * MiB;
constexpr size_t WS_PH = 253 * MiB;
constexpr size_t WS_Y = 449 * MiB;
constexpr size_t WS_XB = 517 * MiB;
constexpr size_t WS_DTRAW = 585 * MiB, WS_DT = 588 * MiB, WS_CUMF = 591 * MiB, WS_RCUMB = 593 * MiB;
constexpr size_t WS_AQ = 595 * MiB, WS_AK = 612 * MiB, WS_SX = 621 * MiB, WS_SB = 655 * MiB, WS_SC = 664 * MiB;
constexpr size_t WS_YR = 673 * MiB, WS_YS = 707 * MiB;
constexpr size_t WS_RS = 775 * MiB;
constexpr size_t WS_SS = 843 * MiB;
constexpr size_t WS_SDEC = 979 * MiB;
constexpr size_t WS_YP = 980 * MiB;
constexpr size_t WS_RSB = 1012 * MiB, WS_SSB = 1046 * MiB;
constexpr size_t WS_END = 1114 * MiB;
static_assert(WS_MODP + (size_t)2 * 16 * 5 * NMODC * 4 <= WS_WGU1 && WS_WGU1 + (size_t)NGU * D * 2 <= WS_WD1 && WS_WD1 + (size_t)D * DFF * 2 <= WS_WGU2 && WS_WIN + (size_t)INC * D * 2 <= WS_WOUT && WS_WOUT + (size_t)D * D * 2 <= WS_XC, "ws map 1");
static_assert(WS_XC + (size_t)MC * D * 4 <= WS_A && WS_A + (size_t)M * D * 2 <= WS_PH && WS_PH + (size_t)M * INP * 2 <= WS_Y && WS_Y + (size_t)M * D * 4 <= WS_DTRAW, "ws map 2");
static_assert(WS_DTRAW + (size_t)M * 32 * 4 <= WS_DT && WS_DT + (size_t)M * 32 * 4 <= WS_CUMF && WS_CUMF + (size_t)M * 16 * 4 <= WS_RCUMB && WS_RCUMB + (size_t)M * 16 * 4 <= WS_AQ, "ws map 3");
static_assert(WS_AQ + (size_t)M * 512 * 2 <= WS_AK && WS_AK + (size_t)M * 256 * 2 <= WS_SX && WS_SX + (size_t)M * 1024 * 2 <= WS_SB && WS_SB + (size_t)M * 256 * 2 <= WS_SC && WS_SC + (size_t)M * 256 * 2 <= WS_YR, "ws map 4");
static_assert(WS_YR + (size_t)M * 512 * 4 <= WS_YS && WS_YS + (size_t)M * 1024 * 4 <= WS_RS && WS_RS + (size_t)NCR * 8 * 16384 * 4 <= WS_SS && WS_SS + (size_t)NCR * 32 * 8192 * 4 <= WS_SDEC, "ws map 5");
constexpr int CW_BAR = 4096;

constexpr int RING_OFF = 0, RING_BYTES = 131072;
constexpr int TS = 272, TILE = 128 * TS, HTILE = 64 * TS;
constexpr int AUX_OFF = 143360;
constexpr int MISC_OFF = AUX_OFF + 16384;
constexpr int LDS_BYTES = MISC_OFF + 256;
static_assert(AUX_OFF >= RING_BYTES && AUX_OFF >= 4 * TILE && LDS_BYTES <= 163840, "LDS map");

#define GAS __attribute__((address_space(1)))
#define LAS __attribute__((address_space(3)))
typedef unsigned short bf16;
typedef unsigned v4u __attribute__((ext_vector_type(4)));
typedef float f32x4 __attribute__((ext_vector_type(4)));
typedef short bf16x8 __attribute__((ext_vector_type(8)));
typedef LAS unsigned char* ldsp;
__device__ __forceinline__ unsigned f2bf(float f) { unsigned u = __builtin_bit_cast(unsigned, f); return (u + 0x7fffu + ((u >> 16) & 1u)) >> 16; }
__device__ __forceinline__ unsigned cvtpk(float lo, float hi) { unsigned r; asm("v_cvt_pk_bf16_f32 %0, %1, %2" : "=v"(r) : "v"(lo), "v"(hi)); return r; }
__device__ __forceinline__ unsigned pk2(float lo, float hi) { return cvtpk(lo, hi); }
__device__ __forceinline__ float bf2f(unsigned b) { return __builtin_bit_cast(float, b << 16); }
__device__ __forceinline__ float bflo(unsigned w) { return __builtin_bit_cast(float, w << 16); }
__device__ __forceinline__ float bfhi(unsigned w) { return __builtin_bit_cast(float, w & 0xffff0000u); }
__device__ __forceinline__ float silu(float x) { return x * __builtin_amdgcn_rcpf(1.0f + __builtin_amdgcn_exp2f(x * -1.44269504089f)); }
__device__ __forceinline__ float rsq(float x) { return __builtin_amdgcn_rsqf(x); }
__device__ __forceinline__ float wave_sum(float v) {
#pragma unroll
    for (int o = 1; o < 64; o <<= 1) v += __shfl_xor(v, o);
    return v;
}
__device__ __forceinline__ float sum16(float v) { v += __shfl_xor(v, 1); v += __shfl_xor(v, 2); v += __shfl_xor(v, 4); v += __shfl_xor(v, 8); return v; }
__device__ __forceinline__ float max16(float v) { v = fmaxf(v, __shfl_xor(v, 1)); v = fmaxf(v, __shfl_xor(v, 2)); v = fmaxf(v, __shfl_xor(v, 4)); v = fmaxf(v, __shfl_xor(v, 8)); return v; }

__device__ __forceinline__ int launder(int x) { asm volatile("" : "+v"(x)); return x; }
__device__ __forceinline__ int opaque_s(int x) { asm volatile("" : "+s"(x)); return x; }
#define XB_TMO      128
#define XB_XCNT(j)  (256  + 64 * (j))
#define XB_XSUB(j)  (1280 + 64 * (j))
#define XB_XGEN(j)  (2304 + 64 * (j))
#define XB_TOP      3328
#define XB_TOPGEN   3392
#define XCD_BAR_WORDS 3456
#define XB_SPIN_CAP (1u << 18)

__device__ __forceinline__ unsigned xb_ld(unsigned* p)              { return __hip_atomic_load(p, __ATOMIC_RELAXED, __HIP_MEMORY_SCOPE_AGENT); }
__device__ __forceinline__ unsigned xb_add(unsigned* p, unsigned v) { return __hip_atomic_fetch_add(p, v, __ATOMIC_RELAXED, __HIP_MEMORY_SCOPE_AGENT); }
__device__ __forceinline__ unsigned xb_xcc_id() { return (unsigned)__builtin_amdgcn_s_getreg((3 << 11) | 20) & 0xFu; }
#define XB_SPIN(cond, bar) do { unsigned _sp = 0; while (cond) { __builtin_amdgcn_s_sleep(1); \
    if ((++_sp & 255u) == 0u) { if (xb_ld(&(bar)[XB_TMO])) break; if (_sp > XB_SPIN_CAP) { atomicAdd(&(bar)[XB_TMO], 1u); break; } } } } while (0)

struct XcdBarrier {
    unsigned* bar; unsigned x;
    volatile LAS unsigned* st;
};

__device__ __forceinline__ XcdBarrier xcd_barrier_post(unsigned* bar, volatile LAS unsigned* st) {
    XcdBarrier b; b.bar = bar; b.x = xb_xcc_id(); b.st = st;
    if (threadIdx.x == 0) (void)xb_add(&bar[XB_XCNT(b.x)], 1u);
    return b;
}
__device__ __forceinline__ void xcd_barrier_complete(unsigned* bar, unsigned x, unsigned& nloc, unsigned& nx) {
    const unsigned G = gridDim.x * gridDim.y * gridDim.z;
    unsigned sum, cnt, mine, sp = 0u;
    for (;;) {
        sum = 0u; cnt = 0u; mine = 0u;
#pragma unroll
        for (unsigned j = 0; j < 16; ++j) { const unsigned c = xb_ld(&bar[XB_XCNT(j)]); sum += c; cnt += (c > 0u) ? 1u : 0u; mine = (j == x) ? c : mine; }
        if (sum == G) break;
        __builtin_amdgcn_s_sleep(1);
        if ((++sp & 255u) == 0u) { if (xb_ld(&bar[XB_TMO])) break; if (sp > XB_SPIN_CAP) { atomicAdd(&bar[XB_TMO], 1u); break; } }
    }
    nloc = mine > 0u ? mine : 1u; nx = cnt > 0u ? cnt : 1u;
}

__device__ __forceinline__ void xcd_barrier(const XcdBarrier& b) {
    asm volatile("s_waitcnt vmcnt(0)" ::: "memory");
    __syncthreads();
    if (threadIdx.x == 0) {
        unsigned* bar = b.bar;
        __builtin_amdgcn_s_waitcnt(0);
        unsigned nloc = b.st[0], nx = b.st[1];
        if (nloc == 0u) { unsigned xo = b.x; asm volatile("" : "+s"(xo)); xcd_barrier_complete(bar, xo, nloc, nx); b.st[0] = nloc; b.st[1] = nx; }
        const unsigned old = xb_add(&bar[XB_XSUB(b.x)], 1u);
        const unsigned gen = old / nloc;
        if (old + 1u == (gen + 1u) * nloc) {
            __builtin_amdgcn_fence(__ATOMIC_RELEASE, "agent");
            asm volatile("s_waitcnt vmcnt(0)" ::: "memory");
            const unsigned og = xb_add(&bar[XB_TOP], 1u);
            const unsigned tg = og / nx;
            if (og + 1u == (tg + 1u) * nx) xb_add(&bar[XB_TOPGEN], 1u);
            else XB_SPIN(xb_ld(&bar[XB_TOPGEN]) == tg, bar);
            __builtin_amdgcn_fence(__ATOMIC_ACQUIRE, "agent");
            xb_add(&bar[XB_XGEN(b.x)], 1u);
            asm volatile("s_waitcnt vmcnt(0)" ::: "memory");
        } else {
            XB_SPIN(xb_ld(&bar[XB_XGEN(b.x)]) == gen, bar);
            __builtin_amdgcn_fence(__ATOMIC_ACQUIRE, "agent");
            asm volatile("s_waitcnt vmcnt(0)" ::: "memory");
        }
    }
    __syncthreads();
}

struct Args { const float* in[22]; float* out; unsigned char* ws; int ph_lo, ph_hi; };
struct Frame {
    ldsp lds;
    volatile LAS unsigned* MISC;
    int tid, lane, wave, G, bid;
    float* out;
    unsigned char* ws;
};
__device__ __forceinline__ const float* inp(int i) { const __attribute__((address_space(4))) Args* ka = (const __attribute__((address_space(4))) Args*)__builtin_amdgcn_kernarg_segment_ptr(); return ka->in[opaque_s(i)]; }
__device__ __forceinline__ float* wsf(const Frame& F, size_t off) { return (float*)(F.ws + ((size_t)(unsigned)opaque_s((int)(off >> 20)) << 20)); }
__device__ __forceinline__ bf16* wsb(const Frame& F, size_t off) { return (bf16*)(F.ws + ((size_t)(unsigned)opaque_s((int)(off >> 20)) << 20)); }
enum { I_X = 0, I_C, I_CTX, I_CCTX, I_WADA, I_BADA, I_NORMW, I_GU1, I_D1, I_GU2, I_D2, I_WIN, I_WOUT, I_RDEC, I_RNW, I_SINK, I_CONVW, I_CONVB, I_ALOG, I_DTB, I_DSKIP, I_SNW };

struct TrItem { const float* W; bf16* WT; int K, N, drow0, k0, n0; };
__device__ __forceinline__ void tr_load(const TrItem& t, f32x4 (&v)[16], int lane) {
    const int c4 = 4 * (lane & 15), kq = lane >> 4; const bool okc = t.n0 + c4 < t.N;
#pragma unroll
    for (int i = 0; i < 16; ++i) { v[i] = (f32x4){0.f, 0.f, 0.f, 0.f}; if (okc) v[i] = *(const f32x4*)(t.W + (size_t)(t.k0 + 4 * i + kq) * t.N + t.n0 + c4); }
}
__device__ __forceinline__ void tr_finish(const TrItem& t, const f32x4 (&v)[16], LAS float* scr, int lane) {
    const int c4 = 4 * (lane & 15), kq = lane >> 4;
#pragma unroll
    for (int i = 0; i < 16; ++i) { LAS float* d = scr + (4 * i + kq) * 65 + c4; d[0] = v[i].x; d[1] = v[i].y; d[2] = v[i].z; d[3] = v[i].w; }
    asm volatile("s_waitcnt lgkmcnt(0)" ::: "memory");
    const int c = lane & 7;
#pragma unroll
    for (int j = 0; j < 8; ++j) { const int n = (lane >> 3) + 8 * j; const LAS float* s = scr + (8 * c) * 65 + n;
        v4u o; o.x = pk2(s[0 * 65], s[1 * 65]); o.y = pk2(s[2 * 65], s[3 * 65]); o.z = pk2(s[4 * 65], s[5 * 65]); o.w = pk2(s[6 * 65], s[7 * 65]);
        if (t.n0 + n < t.N) *(v4u*)(t.WT + (size_t)(t.drow0 + n) * t.K + t.k0 + 8 * c) = o; }
    asm volatile("s_waitcnt lgkmcnt(0)" ::: "memory");
}
__device__ __forceinline__ void convert_set(Frame& F, int layer, bool second, int wg0, int part = 0) {
    const int tid = launder(F.tid), lane = tid & 63, wave = __builtin_amdgcn_readfirstlane(tid >> 6), bid = opaque_s(F.bid);
    if (bid < wg0) return;
    LAS float* scr = (LAS float*)(F.lds + wave * 16640);
    const int gw = (bid - wg0) * NWAVES + wave, NGW = (F.G - wg0) * NWAVES;
    constexpr int I_GU = (D / 64) * (NGU / 64), I_DN = (DFF / 64) * (D / 64), I_IN = (D / 64) * ((INC + 63) / 64), I_OUT = (D / 64) * (D / 64);
    const float* gu = inp(second ? I_GU2 : I_GU1) + (size_t)layer * D * NGU; const float* dn = inp(second ? I_D2 : I_D1) + (size_t)layer * DFF * D;
    const float* sq = second ? inp(I_WOUT) + (size_t)layer * D * D : inp(I_WIN) + (size_t)layer * D * INC;
    bf16* const pGU = wsb(F, second ? WS_WGU2 : WS_WGU1); bf16* const pDN = wsb(F, second ? WS_WD2 : WS_WD1); bf16* const pSQ = wsb(F, second ? WS_WOUT : WS_WIN);
    const int nsq = second ? I_OUT : I_IN, nsqb = second ? D / 64 : (INC + 63) / 64, Nsq = second ? D : INC;
    const int it0 = part == 2 || part == 5 ? I_GU : part == 4 ? I_GU / 2 : part == 6 ? I_GU + I_DN : 0;
    const int it1 = part == 1 || part == 4 ? I_GU : part == 3 ? I_GU / 2 : part == 5 ? I_GU + I_DN : I_GU + I_DN + nsq;
#define TR_DESCRIBE(it_, t_) do { int r_ = (it_); \
        if (r_ < I_GU) { const int kb = r_ / (NGU / 64), nb = r_ % (NGU / 64), n0 = 64 * nb, half = n0 >= DFF ? 1 : 0, c0 = n0 - half * DFF;     \
            t_.W = gu; t_.WT = pGU; t_.K = D; t_.N = NGU; t_.drow0 = 256 * (c0 >> 7) + 128 * half + (c0 & 127); t_.k0 = 64 * kb; t_.n0 = n0; } \
        else if (r_ < I_GU + I_DN) { r_ -= I_GU; const int kb = r_ / (D / 64), nb = r_ % (D / 64); t_.W = dn; t_.WT = pDN; t_.K = DFF; t_.N = D; t_.drow0 = 64 * nb; t_.k0 = 64 * kb; t_.n0 = 64 * nb; } \
        else { r_ -= I_GU + I_DN; const int kb = r_ / nsqb, nb = r_ % nsqb; t_.W = sq; t_.WT = pSQ; t_.K = D; t_.N = Nsq; t_.drow0 = 64 * nb; t_.k0 = 64 * kb; t_.n0 = 64 * nb; } } while (0)
    TrItem tc, tn; f32x4 vc[16], vn[16];
    int it = it0 + gw;
    if (it < it1) { TR_DESCRIBE(it, tc); tr_load(tc, vc, lane); }
    for (; it < it1; it += NGW) {
        const bool more = it + NGW < it1;
        if (more) { TR_DESCRIBE(it + NGW, tn); tr_load(tn, vn, lane); }
        tr_finish(tc, vc, scr, lane);
        if (more) { tc = tn;
#pragma unroll
            for (int i = 0; i < 16; ++i) vc[i] = vn[i]; }
    }
#undef TR_DESCRIBE
    __syncthreads();
}
__device__ __forceinline__ void ph_convert_weights(Frame& F, int layer) { convert_set(F, layer, false, 0); convert_set(F, layer, true, 0); }
__device__ __forceinline__ void ph_adaln_partial(Frame& F) {
    const int tid = launder(F.tid), lane = tid & 63, wave = __builtin_amdgcn_readfirstlane(tid >> 6), bid = opaque_s(F.bid); (void)lane; (void)wave; (void)bid;
    float* const pMODP = wsf(F, WS_MODP);    const float* const iC = inp(I_C);    const float* const iCCTX = inp(I_CCTX);    const float* const iWADA = inp(I_WADA);
    LAS float* s = (LAS float*)F.lds;
    for (int i = tid; i < 5 * D; i += NTHR) { const int v = i / D, k = i % D; const float c = (v < 4) ? iC[v * D + k] : iCCTX[k]; s[i] = c / (1.0f + expf(-c)); }
    __syncthreads();
    const int gw = bid * NWAVES + wave, NGW = F.G * NWAVES;
    constexpr int NBLK = NMODC / 256;
    for (int u = gw; u < 2 * NBLK * 16; u += NGW) {
        const int layer = u / (NBLK * 16), r = u % (NBLK * 16), ks = r % 16, nb = r / 16, n0 = nb * 256 + 4 * lane;
        const float* W = iWADA + (size_t)layer * D * NMODC + (size_t)(ks * 128) * NMODC + n0;
        f32x4 a0 = {0.f, 0.f, 0.f, 0.f}, a1 = a0, a2 = a0, a3 = a0, a4 = a0;
#pragma unroll 8
        for (int kk = 0; kk < 128; ++kk) { const f32x4 w = *(const f32x4*)(W + (size_t)kk * NMODC); const int k = ks * 128 + kk;
            a0 += w * s[k]; a1 += w * s[D + k]; a2 += w * s[2 * D + k]; a3 += w * s[3 * D + k]; a4 += w * s[4 * D + k]; }
        float* o = pMODP + ((size_t)(layer * 16 + ks) * 5) * NMODC + n0;
        *(f32x4*)(o) = a0; *(f32x4*)(o + NMODC) = a1; *(f32x4*)(o + 2 * NMODC) = a2; *(f32x4*)(o + 3 * NMODC) = a3; *(f32x4*)(o + 4 * NMODC) = a4;
    }
    __syncthreads();
}
__device__ __forceinline__ void ph_mod_reduce(Frame& F) {
    const int tid = launder(F.tid), lane = tid & 63, wave = __builtin_amdgcn_readfirstlane(tid >> 6), bid = opaque_s(F.bid); (void)lane; (void)wave; (void)bid;
    float* const pMOD = wsf(F, WS_MOD);    float* const pMODP = wsf(F, WS_MODP);    const float* const iBADA = inp(I_BADA);    const float* const iNW = inp(I_NORMW);
    for (int i = bid * NTHR + tid; i < 2 * 5 * NMODC; i += F.G * NTHR) {
        const int layer = i / (5 * NMODC), rem = i % (5 * NMODC), v = rem / NMODC, n = rem % NMODC;
        float a = iBADA[layer * NMODC + n];
#pragma unroll
        for (int ks = 0; ks < 16; ++ks) a += pMODP[((size_t)(layer * 16 + ks) * 5 + v) * NMODC + n];
        const int ch = n / D, col = n % D, sub = ch / 3, kind = ch % 3; const float* nwl = iNW + (size_t)layer * 6 * D;
        if (kind == 1) a = (1.0f + a) * nwl[(2 * sub) * D + col];
        else if (kind == 2) a = a * (sub == 1 ? 1.0f : 0.5f) * nwl[(2 * sub + 1) * D + col];
        pMOD[i] = a;
    }
}

template <bool XINB, bool XOUTB> __device__ __forceinline__ void ph_rows(Frame& F, int nrows, const void* xin_l, const void* xin_c, void* xout_l, void* xout_c, const bf16* Y, const bf16* Ypart,
                                        const float* modA, int gi, const float* wpost, float resw, bf16* Aout, const float* modB, int si, const float* wpre) {
    const int tid = launder(F.tid), lane = tid & 63, wave = __builtin_amdgcn_readfirstlane(tid >> 6), bid = opaque_s(F.bid);
    const int gw = bid * NWAVES + wave, NGW = F.G * NWAVES;
    typedef unsigned long long u64;
    f32x4 xf_c[8], xf_n[8]; u64 xb_c[8], xb_n[8], yb_c[8], yb_n[8];
#define ROWS_LOAD(rw, xf, xb, yb) do { const int rw_ = (rw); const bool lat_ = rw_ < ML; \
        if (XINB) { const bf16* xr_ = lat_ ? (const bf16*)xin_l + (size_t)rw_ * D : (const bf16*)xin_c + (size_t)(rw_ - ML) * D; _Pragma("unroll") for (int j = 0; j < 8; ++j) xb[j] = *(const u64*)(xr_ + 4 * lane + 256 * j); } \
        else { const float* xr_ = lat_ ? (const float*)xin_l + (size_t)rw_ * D : (const float*)xin_c + (size_t)(rw_ - ML) * D; _Pragma("unroll") for (int j = 0; j < 8; ++j) xf[j] = *(const f32x4*)(xr_ + 4 * lane + 256 * j); } \
        if (Y && (lat_ || !Ypart)) { _Pragma("unroll") for (int j = 0; j < 8; ++j) yb[j] = *(const u64*)(Y + (size_t)rw_ * D + 4 * lane + 256 * j); } } while (0)
#pragma unroll
    for (int j = 0; j < 8; ++j) { xf_c[j] = xf_n[j] = (f32x4){0.f, 0.f, 0.f, 0.f}; xb_c[j] = xb_n[j] = yb_c[j] = yb_n[j] = 0ull; }
    if (gw < nrows) ROWS_LOAD(gw, xf_c, xb_c, yb_c);
    for (int row = gw; row < nrows; row += NGW) {
        const bool lat = row < ML; const int v = lat ? (row >> 12) : 4;
        if (row + NGW < nrows) ROWS_LOAD(row + NGW, xf_n, xb_n, yb_n);
        f32x4 x[8];
#pragma unroll
        for (int j = 0; j < 8; ++j) { if (XINB) { const unsigned x0 = (unsigned)xb_c[j], x1 = (unsigned)(xb_c[j] >> 32); x[j] = (f32x4){bflo(x0), bfhi(x0), bflo(x1), bfhi(x1)}; } else x[j] = xf_c[j]; }
        if (Y) {
            f32x4 y[8]; float ss = 0.f;
            if (!lat && Ypart) {
#pragma unroll
                for (int j = 0; j < 8; ++j) { f32x4 a = {0.f, 0.f, 0.f, 0.f};
#pragma unroll
                    for (int sp = 0; sp < KSPLIT; ++sp) { const u64 yw = *(const u64*)(Ypart + ((size_t)sp * MC + (row - ML)) * D + 4 * lane + 256 * j); const unsigned y0 = (unsigned)yw, y1 = (unsigned)(yw >> 32);
                        a += (f32x4){bflo(y0), bfhi(y0), bflo(y1), bfhi(y1)}; }
                    y[j] = a; }
            } else {
#pragma unroll
                for (int j = 0; j < 8; ++j) { const unsigned y0 = (unsigned)yb_c[j], y1 = (unsigned)(yb_c[j] >> 32); y[j] = (f32x4){bflo(y0), bfhi(y0), bflo(y1), bfhi(y1)}; }
            }
#pragma unroll
            for (int j = 0; j < 8; ++j) { ss += (y[j].x * y[j].x + y[j].y * y[j].y) + (y[j].z * y[j].z + y[j].w * y[j].w); }
            const float rs = rsq(wave_sum(ss) * (1.0f / D) + EPS);
            const float* gp = modA + (size_t)v * NMODC + gi * D;
#pragma unroll
            for (int j = 0; j < 8; ++j) { const int c = 4 * lane + 256 * j; const f32x4 g = *(const f32x4*)(gp + c); x[j] += g * (y[j] * rs); }
        }
        if (xout_l) {
            if (XOUTB) { bf16* xo = lat ? (bf16*)xout_l + (size_t)row * D : (bf16*)xout_c + (size_t)(row - ML) * D;
#pragma unroll
                for (int j = 0; j < 8; ++j) *(u64*)(xo + 4 * lane + 256 * j) = (u64)pk2(x[j].x, x[j].y) | ((u64)pk2(x[j].z, x[j].w) << 32);
            } else { float* xo = lat ? (float*)xout_l + (size_t)row * D : (float*)xout_c + (size_t)(row - ML) * D;
#pragma unroll
                for (int j = 0; j < 8; ++j) *(f32x4*)(xo + 4 * lane + 256 * j) = x[j]; } }
        if (Aout) {
            float ss = 0.f;
#pragma unroll
            for (int j = 0; j < 8; ++j) ss += (x[j].x * x[j].x + x[j].y * x[j].y) + (x[j].z * x[j].z + x[j].w * x[j].w);
            const float rs2 = rsq(wave_sum(ss) * (1.0f / D) + EPS);
            const float* shp = modB + (size_t)v * NMODC + si * D; const float* scp = shp + D; bf16* ao = Aout + (size_t)row * D;
#pragma unroll
            for (int j = 0; j < 8; ++j) { const int c = 4 * lane + 256 * j; const f32x4 sh = *(const f32x4*)(shp + c), sc = *(const f32x4*)(scp + c);
                const f32x4 h = (x[j] * rs2) * sc + sh;
                *(u64*)(ao + c) = (u64)pk2(h.x, h.y) | ((u64)pk2(h.z, h.w) << 32); }
        }
#pragma unroll
        for (int j = 0; j < 8; ++j) { xf_c[j] = xf_n[j]; xb_c[j] = xb_n[j]; yb_c[j] = yb_n[j]; }
    }
#undef ROWS_LOAD
}


__device__ __forceinline__ void ph_dt_tasks(Frame& F, int layer) {
    const int tid = launder(F.tid), lane = tid & 63, wave = __builtin_amdgcn_readfirstlane(tid >> 6), bid = opaque_s(F.bid);
    float* const pDT = wsf(F, WS_DT); const bf16* const pA2 = wsb(F, WS_A); const bf16* const pWdt = wsb(F, WS_WIN) + (size_t)PC_DT * D;
    LAS f32x4* red = (LAS f32x4*)(F.lds + AUX_OFF);
    const int r = lane & 15, g = lane >> 4, kq = wave & 3; const float b0 = inp(I_DTB)[layer * 32 + r], b1 = inp(I_DTB)[layer * 32 + 16 + r];
    for (int it = bid; it < M / 32; it += F.G) {
        const int row0 = 32 * it + 16 * (wave >> 2);
        const bf16* ap = pA2 + (size_t)(row0 + r) * D + kq * 512 + 8 * g; const bf16* wp = pWdt + (size_t)r * D + kq * 512 + 8 * g;
        bf16x8 av[16];
#pragma unroll
        for (int ks = 0; ks < 16; ++ks) av[ks] = *(const bf16x8*)(ap + 32 * ks);
        f32x4 a0 = {0.f, 0.f, 0.f, 0.f}, a1 = a0;
#pragma unroll
        for (int ks = 0; ks < 16; ++ks) { const bf16x8 w0_ = *(const bf16x8*)(wp + 32 * ks), w1_ = *(const bf16x8*)(wp + (size_t)16 * D + 32 * ks);
            a0 = __builtin_amdgcn_mfma_f32_16x16x32_bf16(av[ks], w0_, a0, 0, 0, 0); a1 = __builtin_amdgcn_mfma_f32_16x16x32_bf16(av[ks], w1_, a1, 0, 0, 0); }
        red[(wave * 2 + 0) * 64 + lane] = a0; red[(wave * 2 + 1) * 64 + lane] = a1;
        __syncthreads();
        if (kq == 0) {
#pragma unroll
            for (int k = 1; k < 4; ++k) { a0 += red[((wave + k) * 2 + 0) * 64 + lane]; a1 += red[((wave + k) * 2 + 1) * 64 + lane]; }
#pragma unroll
            for (int q = 0; q < 4; ++q) { float* o = pDT + (size_t)(row0 + 4 * g + q) * 32 + r; const float x0 = a0[q] + b0, x1 = a1[q] + b1;
                o[0] = fmaxf(x0, 0.f) + log1pf(__expf(-fabsf(x0))); o[16] = fmaxf(x1, 0.f) + log1pf(__expf(-fabsf(x1))); }
        }
        __syncthreads();
    }
}
__device__ __forceinline__ void ph_prep(Frame& F, int layer) {
    const int tid = launder(F.tid), lane = tid & 63, wave = __builtin_amdgcn_readfirstlane(tid >> 6), bid = opaque_s(F.bid);
    const bf16* const pP = wsb(F, WS_PH); bf16* const pAQ = wsb(F, WS_AQ); bf16* const pAK = wsb(F, WS_AK); bf16* const pSX = wsb(F, WS_SX); bf16* const pSB = wsb(F, WS_SB); bf16* const pSC = wsb(F, WS_SC);
    const int gw = bid * NWAVES + wave, NGW = F.G * NWAVES;
    const float* cw = inp(I_CONVW) + (size_t)layer * 3 * 1536; const float* cb = inp(I_CONVB) + (size_t)layer * 1536;
    LAS float* cosT = (LAS float*)F.lds; LAS float* sinT = cosT + 2048;
    for (int i = tid; i < 2048; i += NTHR) { const float ang = (float)(i >> 5) * powf(10000.0f, -(float)(2 * (i & 31)) / 64.0f); float sn, cs; sincosf(ang, &sn, &cs); cosT[i] = cs; sinT[i] = sn; }
    f32x4 w0[3][2], w1[3][2], w2[3][2], wb[3][2];
#pragma unroll
    for (int r = 0; r < 3; ++r)
#pragma unroll
        for (int hf = 0; hf < 2; ++hf) { const int c = 8 * lane + 512 * r + 4 * hf; w0[r][hf] = *(const f32x4*)(cw + c); w1[r][hf] = *(const f32x4*)(cw + 1536 + c); w2[r][hf] = *(const f32x4*)(cw + 3072 + c); wb[r][hf] = *(const f32x4*)(cb + c); }
    __syncthreads();
    const int ch16 = lane & 15, fb = 8 * (ch16 & 3); const bool second = (ch16 & 4) != 0, colpart = (ch16 & 8) != 0;
    v4u qc, kc, u0c[3], u1c[3], u2c[3], qn, kn, u0n[3], u1n[3], u2n[3];
#define PREP_LOAD(rw, q_, k_, u0_, u1_, u2_) do { const int rw_ = (rw); const bool lat_ = rw_ < ML; const int t_ = lat_ ? (rw_ & (T - 1)) : ((rw_ - ML) & (CL - 1)), tl_ = lat_ ? T : CL; \
        const bf16* pr_ = pP + (size_t)rw_ * INP; q_ = *(const v4u*)(pr_ + PC_AQ + 8 * lane); k_ = *(const v4u*)(pr_ + PC_AK + 8 * (lane & 31)); \
        _Pragma("unroll") for (int r = 0; r < 3; ++r) { const int ch = 8 * lane + 512 * r; u1_[r] = *(const v4u*)(pr_ + PC_XBC + ch); u0_[r] = (v4u){0u, 0u, 0u, 0u}; u2_[r] = (v4u){0u, 0u, 0u, 0u}; \
            if (t_ > 0) u0_[r] = *(const v4u*)(pr_ - INP + PC_XBC + ch); if (t_ < tl_ - 1) u2_[r] = *(const v4u*)(pr_ + INP + PC_XBC + ch); } } while (0)
    qn = kn = (v4u){0u, 0u, 0u, 0u};
#pragma unroll
    for (int r = 0; r < 3; ++r) u0n[r] = u1n[r] = u2n[r] = (v4u){0u, 0u, 0u, 0u};
    if (gw < M) PREP_LOAD(gw, qc, kc, u0c, u1c, u2c);
    for (int row = gw; row < M; row += NGW) {
        const bool lat = row < ML; const int t = lat ? (row & (T - 1)) : ((row - ML) & (CL - 1));
        if (row + NGW < M) PREP_LOAD(row + NGW, qn, kn, u0n, u1n, u2n);
        f32x4 cs0 = {1.f, 1.f, 1.f, 1.f}, cs1 = cs0, sn0 = {0.f, 0.f, 0.f, 0.f}, sn1 = sn0;
        if (lat) { const int pos = colpart ? (t & 63) : (t >> 6); cs0 = *(const LAS f32x4*)(cosT + pos * 32 + fb); cs1 = *(const LAS f32x4*)(cosT + pos * 32 + fb + 4); sn0 = *(const LAS f32x4*)(sinT + pos * 32 + fb); sn1 = *(const LAS f32x4*)(sinT + pos * 32 + fb + 4);
            if (!second) { sn0 = -sn0; sn1 = -sn1; } }
        v4u qo, ko;
#pragma unroll
        for (int e = 0; e < 4; ++e) { const unsigned pq = (unsigned)__shfl_xor((int)qc[e], 4), pk = (unsigned)__shfl_xor((int)kc[e], 4);
            const float c0 = e < 2 ? cs0[2 * e] : cs1[2 * e - 4], c1 = e < 2 ? cs0[2 * e + 1] : cs1[2 * e - 3], s0 = e < 2 ? sn0[2 * e] : sn1[2 * e - 4], s1 = e < 2 ? sn0[2 * e + 1] : sn1[2 * e - 3];
            qo[e] = pk2(bflo(qc[e]) * c0 + bflo(pq) * s0, bfhi(qc[e]) * c1 + bfhi(pq) * s1); ko[e] = pk2(bflo(kc[e]) * c0 + bflo(pk) * s0, bfhi(kc[e]) * c1 + bfhi(pk) * s1); }
        *(v4u*)(pAQ + (size_t)row * 512 + 8 * lane) = qo;
        if (lane < 32) *(v4u*)(pAK + (size_t)row * 256 + 8 * lane) = ko;
#pragma unroll
        for (int r = 0; r < 3; ++r) {
            const int ch = 8 * lane + 512 * r;
            unsigned ow[4];
#pragma unroll
            for (int e2 = 0; e2 < 4; ++e2) { const int hf = e2 >> 1, k0 = 2 * (e2 & 1);
                const float ylo = w0[r][hf][k0] * bflo(u0c[r][e2]) + w1[r][hf][k0] * bflo(u1c[r][e2]) + w2[r][hf][k0] * bflo(u2c[r][e2]) + wb[r][hf][k0];
                const float yhi = w0[r][hf][k0 + 1] * bfhi(u0c[r][e2]) + w1[r][hf][k0 + 1] * bfhi(u1c[r][e2]) + w2[r][hf][k0 + 1] * bfhi(u2c[r][e2]) + wb[r][hf][k0 + 1];
                ow[e2] = pk2(silu(ylo), silu(yhi)); }
            const v4u o = {ow[0], ow[1], ow[2], ow[3]};
            if (ch < 1024) *(v4u*)(pSX + (size_t)row * 1024 + ch) = o;
            else if (ch < 1280) *(v4u*)(pSB + (size_t)row * 256 + (ch - 1024)) = o;
            else *(v4u*)(pSC + (size_t)row * 256 + (ch - 1280)) = o;
        }
        qc = qn; kc = kn;
#pragma unroll
        for (int r = 0; r < 3; ++r) { u0c[r] = u0n[r]; u1c[r] = u1n[r]; u2c[r] = u2n[r]; }
    }
#undef PREP_LOAD
    __syncthreads();
}

__device__ __forceinline__ int swz(int r, int c16) { return r * TS + (c16 << 4); }
__device__ __forceinline__ int swz_el(int r, int col) { return r * TS + (col << 1); }
template <int NT> __device__ __forceinline__ void mma_1xN(f32x4 (&acc)[NT], ldsp At, int arow0, ldsp Bt, int brow0, int lane) {
    const int r = lane & 15, g = lane >> 4;
#pragma unroll
    for (int ks = 0; ks < 4; ++ks) {
        const bf16x8 a = *(const LAS bf16x8*)(At + swz(arow0 + r, 4 * ks + g));
#pragma unroll
        for (int nt = 0; nt < NT; ++nt) {
            const bf16x8 b = *(const LAS bf16x8*)(Bt + swz(brow0 + 16 * nt + r, 4 * ks + g));
            acc[nt] = __builtin_amdgcn_mfma_f32_16x16x32_bf16(a, b, acc[nt], 0, 0, 0);
        }
        __builtin_amdgcn_sched_barrier(0);
    }
}
template <int NT> __device__ __forceinline__ void zero_acc(f32x4 (&acc)[NT]) {
#pragma unroll
    for (int i = 0; i < NT; ++i) acc[i] = (f32x4){0.f, 0.f, 0.f, 0.f};
}
__device__ __forceinline__ void stage_direct(ldsp tile, const bf16* g, int ld, int rows, int tid) {
    for (int c = tid; c < rows * 16; c += NTHR) { const int r = c >> 4, ch = c & 15; *(LAS v4u*)(tile + swz(r, ch)) = *(const v4u*)(g + (size_t)r * ld + ch * 8); }
}
__device__ __forceinline__ void stage_direct_f32(ldsp tile, const float* g, int ld, int rows, int tid) {
    for (int c = tid; c < rows * 16; c += NTHR) { const int r = c >> 4, ch = c & 15; const f32x4 a = *(const f32x4*)(g + (size_t)r * ld + ch * 8), b = *(const f32x4*)(g + (size_t)r * ld + ch * 8 + 4);
        *(LAS v4u*)(tile + swz(r, ch)) = (v4u){pk2(a.x, a.y), pk2(a.z, a.w), pk2(b.x, b.y), pk2(b.z, b.w)}; }
}
__device__ __forceinline__ void stage_tr(ldsp tile, const bf16* g, int ld, int ncols, const LAS float* rs, int tid) {
    const int nch = ncols >> 3;
    for (int c = tid; c < 128 * nch; c += NTHR) { const int r = c & 127, ch = c >> 7; const v4u v = *(const v4u*)(g + (size_t)r * ld + ch * 8); const float sc = rs ? rs[r] : 1.0f;
#pragma unroll
        for (int i = 0; i < 4; ++i) { const float lo = bflo(v[i]) * sc, hi = bfhi(v[i]) * sc;
            *(LAS bf16*)(tile + swz_el(ch * 8 + 2 * i, r)) = (bf16)f2bf(lo); *(LAS bf16*)(tile + swz_el(ch * 8 + 2 * i + 1, r)) = (bf16)f2bf(hi); } }
}

typedef short s16x4 __attribute__((ext_vector_type(4)));
constexpr int TSR = 272;
constexpr int TST = 288;
constexpr int TSX = 544;
__device__ __forceinline__ bf16x8 row_frag(ldsp t, int ts, int row0, int ks, int lane) { return *(const LAS bf16x8*)(t + (row0 + (lane & 15)) * ts + ((4 * ks + (lane >> 4)) << 4)); }
__device__ __forceinline__ bf16x8 tr_frag(ldsp t, int ts, int k0, int c0, int lane) {
    ldsp a = t + (k0 + 4 * (lane >> 4) + ((lane >> 2) & 3)) * ts + (c0 + 4 * (lane & 3)) * 2;
    const s16x4 lo = __builtin_amdgcn_ds_read_tr16_b64_v4i16((LAS s16x4*)a), hi = __builtin_amdgcn_ds_read_tr16_b64_v4i16((LAS s16x4*)(a + 16 * ts));
    return (bf16x8){lo[0], lo[1], lo[2], lo[3], hi[0], hi[1], hi[2], hi[3]};
}
__device__ __forceinline__ bf16x8 acc_frag(f32x4 lo, f32x4 hi) { const v4u w = {cvtpk(lo[0], lo[1]), cvtpk(lo[2], lo[3]), cvtpk(hi[0], hi[1]), cvtpk(hi[2], hi[3])}; return __builtin_bit_cast(bf16x8, w); }
__device__ __forceinline__ bf16x8 scale_frag(bf16x8 a, const LAS float* w, int k0, int lane) {
    const f32x4 wl = *(const LAS f32x4*)(w + k0 + 4 * (lane >> 4)), wh = *(const LAS f32x4*)(w + k0 + 16 + 4 * (lane >> 4)); const v4u x = __builtin_bit_cast(v4u, a);
    const v4u o = {cvtpk(bflo(x[0]) * wl[0], bfhi(x[0]) * wl[1]), cvtpk(bflo(x[1]) * wl[2], bfhi(x[1]) * wl[3]), cvtpk(bflo(x[2]) * wh[0], bfhi(x[2]) * wh[1]), cvtpk(bflo(x[3]) * wh[2], bfhi(x[3]) * wh[3])};
    return __builtin_bit_cast(bf16x8, o);
}
#define MFMA16(a, b, c) __builtin_amdgcn_mfma_f32_16x16x32_bf16(a, b, c, 0, 0, 0)
#define SCHED_FENCE() __builtin_amdgcn_sched_barrier(0)
template <int MT> __device__ __forceinline__ void mma_xt(f32x4 (&acc)[MT], ldsp t, int ts, const bf16x8 (&own)[4], int lane) {
    bf16x8 a[MT];
#pragma unroll
    for (int mt = 0; mt < MT; ++mt) a[mt] = row_frag(t, ts, 16 * mt, 0, lane);
#pragma unroll
    for (int ks = 0; ks < 4; ++ks) { bf16x8 an[MT];
        if (ks < 3) {
#pragma unroll
            for (int mt = 0; mt < MT; ++mt) an[mt] = row_frag(t, ts, 16 * mt, ks + 1, lane); }
#pragma unroll
        for (int mt = 0; mt < MT; ++mt) acc[mt] = MFMA16(a[mt], own[ks], acc[mt]);
        SCHED_FENCE();
        if (ks < 3) {
#pragma unroll
            for (int mt = 0; mt < MT; ++mt) a[mt] = an[mt]; }
    }
}
template <int NT, bool SWAP = false> __device__ __forceinline__ void mma_at(f32x4 (&acc)[NT], const bf16x8 (&afr)[4], ldsp t, int ts, int c0, int lane) {
    bf16x8 b[NT];
#pragma unroll
    for (int nt = 0; nt < NT; ++nt) b[nt] = tr_frag(t, ts, 0, c0 + 16 * nt, lane);
#pragma unroll
    for (int ks = 0; ks < 4; ++ks) { bf16x8 bn[NT];
        if (ks < 3) {
#pragma unroll
            for (int nt = 0; nt < NT; ++nt) bn[nt] = tr_frag(t, ts, 32 * (ks + 1), c0 + 16 * nt, lane); }
#pragma unroll
        for (int nt = 0; nt < NT; ++nt) acc[nt] = SWAP ? MFMA16(b[nt], afr[ks], acc[nt]) : MFMA16(afr[ks], b[nt], acc[nt]);
        SCHED_FENCE();
        if (ks < 3) {
#pragma unroll
            for (int nt = 0; nt < NT; ++nt) b[nt] = bn[nt]; }
    }
}
template <int ROWS, int COLS> struct Stage { static constexpr int CPR = COLS / 8, N = ROWS * CPR / NTHR; v4u v[N];
    __device__ __forceinline__ void load(const bf16* g, int ld, int tid) {
#pragma unroll
        for (int i = 0; i < N; ++i) { const int c = tid + NTHR * i, r = c / CPR, ch = c % CPR; v[i] = *(const v4u*)(g + (size_t)r * ld + ch * 8); } }
    __device__ __forceinline__ void store(ldsp tile, int ts, int tid) const {
#pragma unroll
        for (int i = 0; i < N; ++i) { const int c = tid + NTHR * i, r = c / CPR, ch = c % CPR; *(LAS v4u*)(tile + r * ts + (ch << 4)) = v[i]; } }
};

__device__ __forceinline__ void m2_ret_unit(Frame& F, int layer, int cr, int h, bool need_y) {
    const int tid = launder(F.tid), lane = tid & 63, w = __builtin_amdgcn_readfirstlane(tid >> 6), r = lane & 15, g = lane >> 4;
    const bf16* Pm = wsb(F, WS_PH) + (size_t)cr * 128 * INP; bf16* const pYR = wsb(F, WS_YR); bf16* const pRS = wsb(F, WS_RS);
    ldsp TK = F.lds, TV = F.lds + 128 * TSR;
    LAS float* aux = (LAS float*)(F.lds + AUX_OFF);
    LAS float* ef = aux; LAS float* eb = aux + 128; LAS float* nf = aux + 256; LAS float* nb = aux + 384; LAS float* wf = aux + 512; LAS float* wb = aux + 640;
    const float scale = 0.08838834764831845f;
    Stage<128, 128> sk, sv; sk.load(Pm + PC_RK + h * 128, INP, tid); sv.load(Pm + PC_RV + h * 128, INP, tid);
    bf16x8 qf[4];
#pragma unroll
    for (int ks = 0; ks < 4; ++ks) qf[ks] = *(const bf16x8*)(Pm + (size_t)(16 * w + r) * INP + PC_RQ + h * 128 + 32 * ks + 8 * g);
    const float lgf = -fabsf(inp(I_RDEC)[layer * 8 + h]), lgb = -fabsf(inp(I_RDEC)[layer * 8 + 4 + h]);
    __syncthreads();
    sk.store(TK, TSR, tid); sv.store(TV, TST, tid);
    if (tid < 128) { const float t = (float)tid; ef[tid] = __expf(lgf * t); nf[tid] = __expf(-lgf * t); eb[tid] = __expf(lgb * t); nb[tid] = __expf(-lgb * t); wf[tid] = __expf(lgf * (127.f - t)); wb[tid] = __expf(lgb * t); }
    __syncthreads();
    f32x4 s[8]; zero_acc(s); mma_xt<8>(s, TK, TSR, qf, lane);
    { const int i = 16 * w + r; const float efi = ef[i] * scale, nbi = nb[i] * scale;
#pragma unroll
      for (int mt = 0; mt < 8; ++mt) { const int j0 = 16 * mt + 4 * g; const f32x4 nfj = *(const LAS f32x4*)(nf + j0), ebj = *(const LAS f32x4*)(eb + j0);
#pragma unroll
          for (int q = 0; q < 4; ++q) { const int j = j0 + q; const float dec = (i >= j ? efi * nfj[q] : 0.f) + (i <= j ? nbi * ebj[q] : 0.f); s[mt][q] *= dec; } } }
    bf16x8 pa[4];
#pragma unroll
    for (int ks = 0; ks < 4; ++ks) pa[ks] = acc_frag(s[2 * ks], s[2 * ks + 1]);
    if (need_y) { f32x4 y[8]; zero_acc(y); mma_at<8, true>(y, pa, TV, TST, 0, lane);
#pragma unroll
        for (int nt = 0; nt < 8; ++nt) *(unsigned long long*)(pYR + (size_t)(cr * 128 + 16 * w + r) * 512 + h * 128 + 16 * nt + 4 * g) = (unsigned long long)cvtpk(y[nt][0], y[nt][1]) | ((unsigned long long)cvtpk(y[nt][2], y[nt][3]) << 32); }
#pragma unroll
    for (int dir = 0; dir < 2; ++dir) { bf16x8 va[4];
#pragma unroll
        for (int ks = 0; ks < 4; ++ks) va[ks] = scale_frag(tr_frag(TV, TST, 32 * ks, 16 * w, lane), dir ? wb : wf, 32 * ks, lane);
        f32x4 u[8]; zero_acc(u); mma_at<8, true>(u, va, TK, TSR, 0, lane);
        bf16* dst = pRS + ((size_t)(cr * 4 + h) * 2 + dir) * 16384 + (16 * w + r) * 128 + 4 * g;
#pragma unroll
        for (int nt = 0; nt < 8; ++nt) *(unsigned long long*)(dst + 16 * nt) = (unsigned long long)cvtpk(u[nt][0], u[nt][1]) | ((unsigned long long)cvtpk(u[nt][2], u[nt][3]) << 32); }
}
__device__ __forceinline__ void m2_ssd_unit(Frame& F, int layer, int cr, int grp, int hq, bool need_y) {
    const int tid = launder(F.tid), lane = tid & 63, w = __builtin_amdgcn_readfirstlane(tid >> 6), r = lane & 15, g = lane >> 4, m0 = cr * 128, h0 = grp * 8 + hq * 4;
    const bf16* const pSX = wsb(F, WS_SX); const bf16* const pSB = wsb(F, WS_SB); const bf16* const pSC = wsb(F, WS_SC); const float* const pDT = wsf(F, WS_DT);
    float* const pCUMF = wsf(F, WS_CUMF); float* const pRCUMB = wsf(F, WS_RCUMB); float* const pSDEC = wsf(F, WS_SDEC); bf16* const pYS = wsb(F, WS_YS); bf16* const pSS = wsb(F, WS_SS);
    ldsp TB = F.lds, TX = F.lds + 128 * TSR;
    LAS float* aux = (LAS float*)(F.lds + AUX_OFF);
    Stage<128, 128> sb; Stage<128, 256> sx; sb.load(pSB + (size_t)m0 * 256 + grp * 128, 256, tid); sx.load(pSX + (size_t)m0 * 1024 + h0 * 64, 1024, tid);
    bf16x8 cf[4];
#pragma unroll
    for (int ks = 0; ks < 4; ++ks) cf[ks] = *(const bf16x8*)(pSC + (size_t)(m0 + 16 * w + r) * 256 + grp * 128 + 32 * ks + 8 * g);
    const int chh = w >> 1, cdir = w & 1, ch_ = h0 + chh;
    const float alog_ = inp(I_ALOG)[layer * 32 + cdir * 16 + ch_], d0 = pDT[(size_t)(m0 + lane) * 32 + cdir * 16 + ch_], d1 = pDT[(size_t)(m0 + 64 + lane) * 32 + cdir * 16 + ch_];
    __syncthreads();
    sb.store(TB, TSR, tid); sx.store(TX, TSX, tid);
    {
      const int hh = chh, dir = cdir, h = ch_; const float a = -__expf(alog_);
      float p0 = d0 * a, p1 = d1 * a; const float l0 = p0, l1 = p1;
#pragma unroll
      for (int o = 1; o < 64; o <<= 1) { const float t0 = __shfl_up(p0, o), t1 = __shfl_up(p1, o); if (lane >= o) { p0 += t0; p1 += t1; } }
      const float tot0 = __shfl(p0, 63), tot = tot0 + __shfl(p1, 63); p1 += tot0;
      float c0, c1, w0, w1;
      if (dir == 0) { c0 = p0; c1 = p1; w0 = d0 * __expf(tot - p0); w1 = d1 * __expf(tot - p1); }
      else { c0 = tot - p0 + l0; c1 = tot - p1 + l1; w0 = d0 * __expf(tot - c0); w1 = d1 * __expf(tot - c1); }
      LAS float* base = aux + (hh * 2 + dir) * 384;
      const float L2E = 1.44269504089f;
      base[lane] = c0 * L2E; base[64 + lane] = c1 * L2E; base[128 + lane] = d0; base[192 + lane] = d1; base[256 + lane] = w0; base[320 + lane] = w1;
      float* cg = dir ? pRCUMB : pCUMF; cg[(size_t)(m0 + lane) * 16 + h] = c0 * L2E; cg[(size_t)(m0 + 64 + lane) * 16 + h] = c1 * L2E;
      if (lane == 0) pSDEC[(size_t)(cr * 16 + h) * 2 + dir] = __expf(tot);
    }
    __syncthreads();
    f32x4 cb[8]; zero_acc(cb); mma_xt<8>(cb, TB, TSR, cf, lane);
    for (int hh = 0; hh < 4; ++hh) {
        const int h = h0 + hh, l = 16 * w + r;
        const LAS float* cumf = aux + (hh * 2) * 384; const LAS float* dtf = cumf + 128; const LAS float* wf = cumf + 256;
        const LAS float* rcum = aux + (hh * 2 + 1) * 384; const LAS float* dtb = rcum + 128; const LAS float* wb = rcum + 256;
        const float cfl = cumf[l], rcl = rcum[l];
        f32x4 m[8];
#pragma unroll
        for (int mt = 0; mt < 8; ++mt) { const int s0 = 16 * mt + 4 * g;
            if (mt < w) { const f32x4 cs = *(const LAS f32x4*)(cumf + s0), ds = *(const LAS f32x4*)(dtf + s0);
#pragma unroll
                for (int q = 0; q < 4; ++q) m[mt][q] = cb[mt][q] * (__builtin_amdgcn_exp2f(cfl - cs[q]) * ds[q]);
            } else if (mt > w) { const f32x4 rs = *(const LAS f32x4*)(rcum + s0), es = *(const LAS f32x4*)(dtb + s0);
#pragma unroll
                for (int q = 0; q < 4; ++q) m[mt][q] = cb[mt][q] * (__builtin_amdgcn_exp2f(rcl - rs[q]) * es[q]);
            } else { const f32x4 cs = *(const LAS f32x4*)(cumf + s0), ds = *(const LAS f32x4*)(dtf + s0), rs = *(const LAS f32x4*)(rcum + s0), es = *(const LAS f32x4*)(dtb + s0);
#pragma unroll
                for (int q = 0; q < 4; ++q) { const int s = s0 + q; const float mf = (l >= s) ? __builtin_amdgcn_exp2f(cfl - cs[q]) * ds[q] : 0.f, mb = (l <= s) ? __builtin_amdgcn_exp2f(rcl - rs[q]) * es[q] : 0.f; m[mt][q] = cb[mt][q] * (mf + mb); } } }
        bf16x8 pa[4];
#pragma unroll
        for (int ks = 0; ks < 4; ++ks) pa[ks] = acc_frag(m[2 * ks], m[2 * ks + 1]);
        if (need_y) { f32x4 y[4]; zero_acc(y); mma_at<4, true>(y, pa, TX, TSX, hh * 64, lane);
#pragma unroll
            for (int nt = 0; nt < 4; ++nt) *(unsigned long long*)(pYS + (size_t)(m0 + 16 * w + r) * 1024 + h * 64 + 16 * nt + 4 * g) = (unsigned long long)cvtpk(y[nt][0], y[nt][1]) | ((unsigned long long)cvtpk(y[nt][2], y[nt][3]) << 32); }
#pragma unroll
        for (int dir = 0; dir < 2; ++dir) { bf16x8 xa[4];
#pragma unroll
            for (int ks = 0; ks < 4; ++ks) xa[ks] = scale_frag(tr_frag(TX, TSX, 32 * ks, hh * 64 + 16 * (w & 3), lane), dir ? wb : wf, 32 * ks, lane);
            f32x4 u[4]; zero_acc(u); mma_at<4, true>(u, xa, TB, TSR, 64 * (w >> 2), lane);
            bf16* dst = pSS + ((size_t)(cr * 16 + h) * 2 + dir) * 8192 + (16 * (w & 3) + r) * 128 + 64 * (w >> 2) + 4 * g;
#pragma unroll
            for (int nt = 0; nt < 4; ++nt) *(unsigned long long*)(dst + 16 * nt) = (unsigned long long)cvtpk(u[nt][0], u[nt][1]) | ((unsigned long long)cvtpk(u[nt][2], u[nt][3]) << 32); }
    }
}
__device__ __forceinline__ void m2_att_unit(Frame& F, int layer, int b, int qb, int qh, bool is_ctx) {
    const int tid = launder(F.tid), lane = tid & 63, w = __builtin_amdgcn_readfirstlane(tid >> 6), r = lane & 15, g = lane >> 4, kvh = qh >> 1;
    const bf16* const pAQ = wsb(F, WS_AQ); const bf16* const pAK = wsb(F, WS_AK); const bf16* const pP = wsb(F, WS_PH); bf16* const pA = wsb(F, WS_A);
    const int qrow0 = is_ctx ? (ML + b * CL + qb * 128) : (b * T + qb * 128);
    constexpr int KVB = 128 * TSR + 128 * TST;
    const float scale = 0.08838834764831845f;
    const int nleft = (!is_ctx && qb > 0) ? 1 : 0, nright = (!is_ctx && qb < T / 128 - 1) ? 1 : 0, nt_ = is_ctx ? 2 : 3 + nleft + nright, crow = ML + b * CL;
#define TILE_INFO(ti, row, mode) do { int t_ = (ti); row = crow + t_ * 128; mode = 0; \
        if (!is_ctx) { if (t_ == 0) row = qrow0; else if (nleft && t_ == 1) { row = qrow0 - 128; mode = 1; } else if (nright && t_ == 1 + nleft) { row = qrow0 + 128; mode = 2; } else row = crow + (t_ - 1 - nleft - nright) * 128; } } while (0)
    bf16x8 qf[4];
#pragma unroll
    for (int ks = 0; ks < 4; ++ks) qf[ks] = *(const bf16x8*)(pAQ + (size_t)(qrow0 + 16 * w + r) * 512 + qh * 128 + 32 * ks + 8 * g);
    float mrun = -1e30f, lrun = 0.f; f32x4 o[8]; zero_acc(o);
    v4u kr[4], vr[4];
    const int srow = tid >> 4, sch = tid & 15;
    { int row0_, mode0_; TILE_INFO(0, row0_, mode0_); (void)mode0_; const bf16* kg = pAK + (size_t)(row0_ + srow) * 256 + kvh * 128 + sch * 8; const bf16* vg = pP + (size_t)(row0_ + srow) * INP + PC_AV + kvh * 128 + sch * 8;
#pragma unroll
      for (int k = 0; k < 4; ++k) { kr[k] = *(const v4u*)(kg + (size_t)(32 * k) * 256); vr[k] = *(const v4u*)(vg + (size_t)(32 * k) * INP); } }
    __syncthreads();
#pragma unroll
    for (int k = 0; k < 4; ++k) { *(LAS v4u*)(F.lds + (srow + 32 * k) * TSR + (sch << 4)) = kr[k]; *(LAS v4u*)(F.lds + 128 * TSR + (srow + 32 * k) * TST + (sch << 4)) = vr[k]; }
    __syncthreads();
    for (int ti = 0; ti < nt_; ++ti) {
        ldsp TK = F.lds + (ti & 1) * KVB, TV = TK + 128 * TSR;
        int mode, row_cur; TILE_INFO(ti, row_cur, mode); (void)row_cur;
        if (ti + 1 < nt_) { int tr_, mode_n; TILE_INFO(ti + 1, tr_, mode_n); (void)mode_n; const bf16* kg = pAK + (size_t)(tr_ + srow) * 256 + kvh * 128 + sch * 8; const bf16* vg = pP + (size_t)(tr_ + srow) * INP + PC_AV + kvh * 128 + sch * 8;
#pragma unroll
            for (int k = 0; k < 4; ++k) { kr[k] = *(const v4u*)(kg + (size_t)(32 * k) * 256); vr[k] = *(const v4u*)(vg + (size_t)(32 * k) * INP); } }
        f32x4 s[8]; zero_acc(s); mma_xt<8>(s, TK, TSR, qf, lane);
        const int i = 16 * w + r; float mx = -1e30f;
#pragma unroll
        for (int mt = 0; mt < 8; ++mt)
#pragma unroll
            for (int q = 0; q < 4; ++q) { const int j = 16 * mt + 4 * g + q; const bool valid = (mode == 0) || (mode == 1 ? (j >= i) : (j <= i)); const float v = valid ? s[mt][q] * scale : -INFINITY; s[mt][q] = v; mx = fmaxf(mx, v); }
        mx = fmaxf(mx, __shfl_xor(mx, 16)); mx = fmaxf(mx, __shfl_xor(mx, 32));
        const float mnew = fmaxf(mrun, mx), alpha = __expf(mrun - mnew); float rsum = 0.f;
#pragma unroll
        for (int mt = 0; mt < 8; ++mt)
#pragma unroll
            for (int q = 0; q < 4; ++q) { const float p = __expf(s[mt][q] - mnew); s[mt][q] = p; rsum += p; }
        rsum += __shfl_xor(rsum, 16); rsum += __shfl_xor(rsum, 32);
        lrun = lrun * alpha + rsum; mrun = mnew;
        bf16x8 pa[4];
#pragma unroll
        for (int ks = 0; ks < 4; ++ks) pa[ks] = acc_frag(s[2 * ks], s[2 * ks + 1]);
#pragma unroll
        for (int nt = 0; nt < 8; ++nt) o[nt] = o[nt] * alpha;
        mma_at<8, true>(o, pa, TV, TST, 0, lane);
        if (ti + 1 < nt_) { ldsp NK = F.lds + ((ti + 1) & 1) * KVB, NV = NK + 128 * TSR;
#pragma unroll
            for (int k = 0; k < 4; ++k) { *(LAS v4u*)(NK + (srow + 32 * k) * TSR + (sch << 4)) = kr[k]; *(LAS v4u*)(NV + (srow + 32 * k) * TST + (sch << 4)) = vr[k]; } }
        __syncthreads();
    }
    const float sk = inp(I_SINK)[layer * 4 + qh];
    const float mfin = fmaxf(mrun, sk), afin = __expf(mrun - mfin), lfin = lrun * afin + __expf(sk - mfin), fq_ = afin / lfin;
#pragma unroll
    for (int nt = 0; nt < 8; ++nt) { const f32x4 ov = o[nt] * fq_;
        *(unsigned long long*)(pA + (size_t)(qrow0 + 16 * w + r) * D + 512 + qh * 128 + 16 * nt + 4 * g) = (unsigned long long)cvtpk(ov[0], ov[1]) | ((unsigned long long)cvtpk(ov[2], ov[3]) << 32); }
#undef TILE_INFO
}
__device__ __forceinline__ void ph_m2(Frame& F, int layer, bool ctx_out, int which = 7) {
    const int tid = launder(F.tid), lane = tid & 63, wave = __builtin_amdgcn_readfirstlane(tid >> 6), bid = opaque_s(F.bid); (void)lane; (void)wave; (void)bid;
    const int natt = 512 + (ctx_out ? 32 : 0);
    const int vb = (F.G & 7) == 0 ? (bid & 7) * (F.G >> 3) + (bid >> 3) : bid;
    if (which & 1) for (int u = vb; u < natt; u += F.G) {
        if (u < 512) m2_att_unit(F, layer, u >> 7, (u >> 2) & 31, u & 3, false);
        else { const int v = u - 512; m2_att_unit(F, layer, v >> 3, (v >> 2) & 1, v & 3, true); }
    }
    if (which & 2) for (int u = (vb + 224) % F.G; u < NCR * 4; u += F.G) { const int cr = u >> 2; m2_ssd_unit(F, layer, cr, (u >> 1) & 1, u & 1, ctx_out || cr < 128); }
    if (which & 4) for (int u = (vb + 192) % F.G; u < NCR * 4; u += F.G) { const int cr = u >> 2; m2_ret_unit(F, layer, cr, u & 3, ctx_out || cr < 128); }
    __syncthreads();
}

__device__ __forceinline__ int chain_cr(int b, int dir, int step) {
    if (step < 2) return 128 + b * 2 + (dir ? 1 - step : step);
    return b * 32 + (dir ? 33 - step : step - 2);
}
__device__ __forceinline__ void ph_scan(Frame& F, int layer) {
    const int tid = launder(F.tid), bid = opaque_s(F.bid);
    const bf16* const pRS = wsb(F, WS_RS); const bf16* const pSS = wsb(F, WS_SS); const float* const pSDEC = wsf(F, WS_SDEC); const float* const iRDEC = inp(I_RDEC);
    bf16* const pRSB = wsb(F, WS_RSB); bf16* const pSSB = wsb(F, WS_SSB);
    const int gt = bid * NTHR + tid, NT_ = F.G * NTHR;
    for (int it = gt; it < 65536 + 131072; it += NT_) {
        const bool ret = it < 65536; const int j = ret ? it : it - 65536;
        int e8, x, dir, h, b; if (ret) { e8 = j & 2047; x = j >> 11; dir = x & 1; h = (x >> 1) & 3; b = x >> 3; } else { e8 = j & 1023; x = j >> 10; dir = x & 1; h = (x >> 1) & 15; b = x >> 5; }
        const bf16* src = ret ? pRS : pSS; bf16* dstb = ret ? pRSB : pSSB; const int nh = ret ? 4 : 16, tsz = ret ? 16384 : 8192;
        const float rdec = ret ? __expf(-fabsf(iRDEC[layer * 8 + dir * 4 + h]) * 128.0f) : 0.f;
        float s[8];
#pragma unroll
        for (int k = 0; k < 8; ++k) s[k] = 0.f;
#pragma unroll
        for (int b0 = 0; b0 < 34; b0 += 12) { constexpr int NBMAX = 12; v4u u[NBMAX]; float dc[NBMAX]; size_t of[NBMAX];
#pragma unroll
            for (int i = 0; i < NBMAX; ++i) if (b0 + i < 34) { const int cr = chain_cr(b, dir, b0 + i); of[i] = ((size_t)(cr * nh + h) * 2 + dir) * tsz + e8 * 8; u[i] = *(const v4u*)(src + of[i]); dc[i] = ret ? rdec : pSDEC[(size_t)(cr * 16 + h) * 2 + dir]; }
#pragma unroll
            for (int i = 0; i < NBMAX; ++i) if (b0 + i < 34) {
                *(v4u*)(dstb + of[i]) = (v4u){pk2(s[0], s[1]), pk2(s[2], s[3]), pk2(s[4], s[5]), pk2(s[6], s[7])};
#pragma unroll
                for (int k = 0; k < 4; ++k) { s[2 * k] = s[2 * k] * dc[i] + bflo(u[i][k]); s[2 * k + 1] = s[2 * k + 1] * dc[i] + bfhi(u[i][k]); } } }
    }
}


__device__ __forceinline__ void m4_ret_unit(Frame& F, int layer, int cr, int h) {
    const int tid = launder(F.tid), lane = tid & 63, w = __builtin_amdgcn_readfirstlane(tid >> 6), r = lane & 15, g = lane >> 4, i = 16 * w + r;
    const bf16* const pYR = wsb(F, WS_YR); const bf16* const pRSB = wsb(F, WS_RSB); bf16* const pA = wsb(F, WS_A); const bf16* const pP = wsb(F, WS_PH);
    const size_t m = (size_t)cr * 128 + i;
    const float scale = 0.08838834764831845f;
    ldsp T0 = F.lds, T1 = F.lds + 128 * TSR;
    Stage<128, 128> s0, s1; s0.load(pRSB + ((size_t)(cr * 4 + h) * 2 + 0) * 16384, 128, tid); s1.load(pRSB + ((size_t)(cr * 4 + h) * 2 + 1) * 16384, 128, tid);
    bf16x8 qf[4];
#pragma unroll
    for (int ks = 0; ks < 4; ++ks) qf[ks] = *(const bf16x8*)(pP + m * INP + PC_RQ + h * 128 + 32 * ks + 8 * g);
    unsigned long long yq[8], gq[8];
#pragma unroll
    for (int mt = 0; mt < 8; ++mt) { yq[mt] = *(const unsigned long long*)(pYR + m * 512 + h * 128 + 16 * mt + 4 * g); gq[mt] = *(const unsigned long long*)(pP + m * INP + PC_RG + h * 128 + 16 * mt + 4 * g); }
    const float lgf = -fabsf(inp(I_RDEC)[layer * 8 + h]), lgb = -fabsf(inp(I_RDEC)[layer * 8 + 4 + h]);
    __syncthreads();
    s0.store(T0, TSR, tid); s1.store(T1, TSR, tid);
    __syncthreads();
    f32x4 af[8], ab[8]; zero_acc(af); zero_acc(ab);
    mma_xt<8>(af, T0, TSR, qf, lane); mma_xt<8>(ab, T1, TSR, qf, lane);
    const float qfac = __expf(lgf * (float)(i + 1)) * scale, qbac = __expf(lgb * (float)(128 - i)) * scale;
    f32x4 y[8]; float sm = 0.f;
#pragma unroll
    for (int mt = 0; mt < 8; ++mt) { const unsigned long long yw = yq[mt]; const unsigned y0 = (unsigned)yw, y1 = (unsigned)(yw >> 32);
        y[mt] = (f32x4){bflo(y0), bfhi(y0), bflo(y1), bfhi(y1)} + af[mt] * qfac + ab[mt] * qbac; sm += (y[mt][0] + y[mt][1]) + (y[mt][2] + y[mt][3]); }
    sm += __shfl_xor(sm, 16); sm += __shfl_xor(sm, 32);
    const float mu = sm * (1.0f / 128.0f); float vs = 0.f;
#pragma unroll
    for (int mt = 0; mt < 8; ++mt) { y[mt] = y[mt] - mu; vs += (y[mt][0] * y[mt][0] + y[mt][1] * y[mt][1]) + (y[mt][2] * y[mt][2] + y[mt][3] * y[mt][3]); }
    vs += __shfl_xor(vs, 16); vs += __shfl_xor(vs, 32);
    const float rstd = rsq(vs * (1.0f / 128.0f) + EPS);
    const float* nw = inp(I_RNW) + layer * 512 + h * 128;
#pragma unroll
    for (int mt = 0; mt < 8; ++mt) { const int e = 16 * mt + 4 * g; const f32x4 wv = *(const f32x4*)(nw + e);
        const unsigned long long gt = gq[mt]; const unsigned g0 = (unsigned)gt, g1 = (unsigned)(gt >> 32);
        const f32x4 o = y[mt] * rstd * wv;
        *(unsigned long long*)(pA + m * D + h * 128 + e) = (unsigned long long)pk2(o[0] * silu(bflo(g0)), o[1] * silu(bfhi(g0))) | ((unsigned long long)pk2(o[2] * silu(bflo(g1)), o[3] * silu(bfhi(g1))) << 32); }
}
__device__ __forceinline__ void m4_ssd_unit(Frame& F, int layer, int cr, int flags = 7) {
    const int tid = launder(F.tid), lane = tid & 63, w = __builtin_amdgcn_readfirstlane(tid >> 6), r = lane & 15, g = lane >> 4;
    const float* const pCUMF = wsf(F, WS_CUMF); const float* const pRCUMB = wsf(F, WS_RCUMB); const bf16* const pYS = wsb(F, WS_YS); const bf16* const pSSB = wsb(F, WS_SSB);
    bf16* const pA = wsb(F, WS_A); const bf16* const pP = wsb(F, WS_PH); const bf16* const pSX = wsb(F, WS_SX); const bf16* const pSC = wsb(F, WS_SC);
    const float* const nw = inp(I_SNW) + layer * 1024; const float* const dskp = inp(I_DSKIP) + layer * 16;
    const size_t m = (size_t)cr * 128 + 16 * w + r;
    typedef unsigned long long u64;
    constexpr int HB = 4 * 64 * TSR;
    v4u sr[8];
    const bf16* sbase = pSSB + (size_t)(cr * 16) * 2 * 8192 + (size_t)tid * 8;
#define M4_RHO(p) (16 * (2 * ((p) >> 5) + (((p) >> 2) & 1)) + 4 * (((p) >> 3) & 3) + ((p) & 3))
#define M4_COL(mt) (32 * ((mt) >> 1) + 8 * g + 4 * ((mt) & 1))
#define M4_STAGE_LD(step) _Pragma("unroll") for (int k = 0; k < 8; ++k) sr[k] = *(const v4u*)(sbase + (size_t)(step) * 32768 + (size_t)k * 4096)
#define M4_STAGE_ST(buf) _Pragma("unroll") for (int k = 0; k < 8; ++k) { const int c = tid + 512 * k; *(LAS v4u*)(F.lds + (buf) * HB + (c >> 10) * (64 * TSR) + M4_RHO((c >> 4) & 63) * TSR + ((c & 15) << 4)) = sr[k]; }
    u64 yq[2][4], xq[2][4], zq[2][4]; float cfq[2], cbq[2], dq[2];
#define M4_EPI_LD(step) _Pragma("unroll") for (int j = 0; j < 2; ++j) { const int hh_ = 2 * (step) + j; \
        _Pragma("unroll") for (int mt = 0; mt < 4; ++mt) { const int c = hh_ * 64 + M4_COL(mt); yq[j][mt] = *(const u64*)(pYS + m * 1024 + c); xq[j][mt] = *(const u64*)(pSX + m * 1024 + c); \
            zq[j][mt] = *(const u64*)(pP + m * INP + PC_Z + c); } \
        cfq[j] = pCUMF[m * 16 + hh_]; cbq[j] = pRCUMB[m * 16 + hh_]; dq[j] = dskp[hh_]; }
    const int s0 = cr & 7;
    M4_STAGE_LD(s0); M4_EPI_LD(s0);
    __syncthreads();
    M4_STAGE_ST(0);
    __syncthreads();
    bf16x8 cf[4]; float ssq = 0.f;
    for (int s = 0; s < 8; ++s) { const int sp = (s + s0) & 7, spn = (s + 1 + s0) & 7;
        if (s == 0 || (sp & 3) == 0) {
#pragma unroll
            for (int ks = 0; ks < 4; ++ks) cf[ks] = *(const bf16x8*)(pSC + m * 256 + (sp >> 2) * 128 + 32 * ks + 8 * g); }
        if (s < 7) { M4_STAGE_LD(spn); }
        ldsp T = F.lds + (s & 1) * HB;
        f32x4 acc[2][2][4];
#pragma unroll
        for (int j = 0; j < 2; ++j)
#pragma unroll
            for (int dir = 0; dir < 2; ++dir) { zero_acc(acc[j][dir]); if (flags & 1) mma_xt<4>(acc[j][dir], T + (2 * j + dir) * (64 * TSR), TSR, cf, lane); }
        if (flags & 2)
#pragma unroll
        for (int j = 0; j < 2; ++j) { const float ef = __builtin_amdgcn_exp2f(cfq[j]), eb = __builtin_amdgcn_exp2f(cbq[j]), dsk = dq[j];
#pragma unroll
            for (int mt = 0; mt < 4; ++mt) { const int c = (2 * sp + j) * 64 + M4_COL(mt);
                const unsigned x0 = (unsigned)xq[j][mt], x1 = (unsigned)(xq[j][mt] >> 32), z0 = (unsigned)zq[j][mt], z1 = (unsigned)(zq[j][mt] >> 32), y0 = (unsigned)yq[j][mt], y1 = (unsigned)(yq[j][mt] >> 32);
                f32x4 y = (f32x4){bflo(y0), bfhi(y0), bflo(y1), bfhi(y1)} + acc[j][0][mt] * ef + acc[j][1][mt] * eb;
                y[0] = (y[0] + dsk * bflo(x0)) * silu(bflo(z0)); y[1] = (y[1] + dsk * bfhi(x0)) * silu(bfhi(z0)); y[2] = (y[2] + dsk * bflo(x1)) * silu(bflo(z1)); y[3] = (y[3] + dsk * bfhi(x1)) * silu(bfhi(z1));
                ssq += (y[0] * y[0] + y[1] * y[1]) + (y[2] * y[2] + y[3] * y[3]);
                *(u64*)(pA + m * D + 1024 + c) = (u64)pk2(y[0], y[1]) | ((u64)pk2(y[2], y[3]) << 32); } }
        if (s < 7) { M4_EPI_LD(spn); M4_STAGE_ST((s + 1) & 1); }
        __syncthreads();
    }
#undef M4_RHO
#undef M4_STAGE_LD
#undef M4_STAGE_ST
#undef M4_EPI_LD
    ssq += __shfl_xor(ssq, 16); ssq += __shfl_xor(ssq, 32);
    const float rs = rsq(ssq * (1.0f / 1024.0f) + EPS);
    if (flags & 4)
#pragma unroll
    for (int bq = 0; bq < 4; ++bq) { u64 v[16]; f32x4 nv[16];
#pragma unroll
        for (int k = 0; k < 16; ++k) { const int c = (4 * bq + (k >> 2)) * 64 + M4_COL(k & 3); v[k] = *(const u64*)(pA + m * D + 1024 + c); nv[k] = *(const f32x4*)(nw + c); }
#pragma unroll
        for (int k = 0; k < 16; ++k) { const unsigned v0 = (unsigned)v[k], v1 = (unsigned)(v[k] >> 32); const f32x4 sc = nv[k] * rs;
            *(u64*)(pA + m * D + 1024 + (4 * bq + (k >> 2)) * 64 + M4_COL(k & 3)) = (u64)pk2(bflo(v0) * sc[0], bfhi(v0) * sc[1]) | ((u64)pk2(bflo(v1) * sc[2], bfhi(v1) * sc[3]) << 32); } }
#undef M4_COL
}
#if defined(PROBE_SEG)
#define SEG_BEGIN(id) unsigned long long segt0_##id = 0; if ((PROBE_SEG >> (id)) & 1) segt0_##id = __builtin_amdgcn_s_memrealtime();
#define SEG_END(id) if ((PROBE_SEG >> (id)) & 1) { __syncthreads(); const unsigned long long t1_ = __builtin_amdgcn_s_memrealtime(); while (__builtin_amdgcn_s_memrealtime() - t1_ < t1_ - segt0_##id) __builtin_amdgcn_s_sleep(16); __syncthreads(); }
#else
#define SEG_BEGIN(id)
#define SEG_END(id)
#endif
__device__ __forceinline__ void ph_m4(Frame& F, int layer, bool ctx_out, int which = 3) {
    const int bid = opaque_s(F.bid);
    const int ncr = ctx_out ? NCR : 128;
    if (bid < ncr) { if (which & 1) {
#ifdef PROBE_M4FLAGS
        for (int rep_ = 0; rep_ < 4; ++rep_) m4_ssd_unit(F, layer, bid, opaque_s(PROBE_M4FLAGS));
#endif
        SEG_BEGIN(0) m4_ssd_unit(F, layer, bid); SEG_END(0) } }
    else if (which & 2) { SEG_BEGIN(1) for (int u = bid - ncr; u < ncr * 4; u += F.G - ncr) m4_ret_unit(F, layer, u >> 2, u & 3); SEG_END(1) }
    __syncthreads();
    SEG_BEGIN(2)
    if (ctx_out && which == 3) convert_set(F, layer + 1, false, ncr, 1);
    SEG_END(2)
}

constexpr int PH_PER_LAYER = 13, PH_TOTAL = 3 + NLAYER * PH_PER_LAYER;
__global__ void __launch_bounds__(NTHR, 2) fwd_kernel(Args args) {
    extern __shared__ __attribute__((aligned(16))) unsigned char lds_raw[];
    Frame F;
    F.lds = (ldsp)lds_raw; F.MISC = (volatile LAS unsigned*)(F.lds + MISC_OFF);
    F.tid = threadIdx.x; F.lane = F.tid & 63; F.wave = __builtin_amdgcn_readfirstlane(F.tid >> 6); F.G = gridDim.x; F.bid = blockIdx.x;
    F.out = args.out; unsigned char* ws = args.ws; F.ws = ws;
    for (int u = F.tid; u < (LDS_BYTES - MISC_OFF) / 4; u += NTHR) ((LAS unsigned*)(F.lds + MISC_OFF))[u] = 0u;
    __syncthreads();
    const int lo = args.ph_lo, hi = args.ph_hi;
    XcdBarrier bar; bar.bar = (unsigned*)(ws + WS_CTL) + CW_BAR; bar.x = 0; bar.st = nullptr;
    if (hi - lo > 1) bar = xcd_barrier_post((unsigned*)(ws + WS_CTL) + CW_BAR, F.MISC + 8);
#define IN(k) ((unsigned)(opaque_s(k) - lo) < (unsigned)(hi - lo))
#if defined(PROBE_REP) && (PROBE_REP & 8)
#define PROBE_ROWS(x) x __syncthreads();
#else
#define PROBE_ROWS(x)
#endif
#if defined(PROBE_SPIN)
    unsigned long long tprev_ = __builtin_amdgcn_s_memrealtime();
#define SEAM(k) do { if (IN(k) && IN((k) + 1)) xcd_barrier(bar); \
        if (((unsigned long long)(PROBE_SPIN) >> (k)) & 1ull) { const unsigned long long t1_ = __builtin_amdgcn_s_memrealtime(); \
            while (__builtin_amdgcn_s_memrealtime() - t1_ < t1_ - tprev_) __builtin_amdgcn_s_sleep(16); __syncthreads(); } \
        tprev_ = __builtin_amdgcn_s_memrealtime(); } while (0)
#else
#define SEAM(k) do { if (IN(k) && IN((k) + 1)) xcd_barrier(bar); } while (0)
#endif

    if (IN(0)) { ph_adaln_partial(F); convert_set(F, 0, false, 0);
    }
    SEAM(0);
    if (IN(1)) ph_mod_reduce(F);
    SEAM(1);
    if (IN(2)) ph_rows<false, false>(F, M, inp(I_X), inp(I_CTX), nullptr, nullptr, nullptr, nullptr, nullptr, 0, nullptr, 0.f, wsb(F, WS_A), wsf(F, WS_MOD), 0, inp(I_NORMW));
    SEAM(2);
    for (int layer = 0; layer < NLAYER; ++layer) {
        const int pb = 3 + layer * PH_PER_LAYER; const bool last = layer == NLAYER - 1; const int Mrows = last ? ML : M;
#define modL (wsf(F, WS_MOD) + (size_t)layer * 5 * NMODC)
#define nw (inp(I_NORMW) + (size_t)layer * 6 * D)
        if (IN(pb + 0)) { pg8::Gemm gm{wsb(F, WS_A), wsb(F, WS_WGU1), D, D}; pg8::StaticOrder S; S.init(M, NGU, D, F.G, opaque_s(F.bid)); pg8::EpiSwiGLU E{wsb(F, WS_PH), DFF};
            pg8::gemm_phase<pg8::EpiSwiGLU, pg8::StaticOrder, true, true>(F.lds + RING_OFF, gm, S, E);
#if defined(PROBE_REP) && (PROBE_REP & 4)
            __syncthreads(); pg8::gemm_phase<pg8::EpiSwiGLU, pg8::StaticOrder, true, true>(F.lds + RING_OFF, gm, S, E);
#endif
        }
        if (IN(pb + 0)) convert_set(F, layer, true, (M / 256) * (NGU / 256) % F.G, 3);
        SEAM(pb + 0);
        if (IN(pb + 1)) { pg8::Gemm gm{wsb(F, WS_PH), wsb(F, WS_WD1), DFF, DFF}; pg8::StaticOrder S; S.init(ML, D, DFF, F.G, opaque_s(F.bid), MC, KSPLIT); pg8::EpiYbf16 E{wsb(F, WS_Y), D, wsb(F, WS_YP), ML, MC};
            pg8::gemm_phase<pg8::EpiYbf16, pg8::StaticOrder, true, true>(F.lds + RING_OFF, gm, S, E);
#if defined(PROBE_REP) && (PROBE_REP & 128)
            __syncthreads(); pg8::gemm_phase<pg8::EpiYbf16, pg8::StaticOrder, true, true>(F.lds + RING_OFF, gm, S, E);
#endif
        }
        if (IN(pb + 1)) convert_set(F, layer, true, (MC / 256) * (D / 256) * KSPLIT, 2);
        SEAM(pb + 1);
        if (IN(pb + 2)) { bf16* xb = wsb(F, WS_XB);
            if (layer == 0) ph_rows<false, true>(F, M, inp(I_X), inp(I_CTX), xb, xb + (size_t)ML * D, wsb(F, WS_Y), wsb(F, WS_YP), modL, 2, nw + D, 0.5f, wsb(F, WS_A), modL, 3, nw + 2 * D);
            else ph_rows<true, true>(F, M, xb, xb + (size_t)ML * D, xb, xb + (size_t)ML * D, wsb(F, WS_Y), wsb(F, WS_YP), modL, 2, nw + D, 0.5f, wsb(F, WS_A), modL, 3, nw + 2 * D); }
        SEAM(pb + 2);
        if (IN(pb + 3)) { pg8::Gemm gm{wsb(F, WS_A), wsb(F, WS_WIN), D, D}; pg8::StaticOrder S; S.init(M, INP, D, F.G, opaque_s(F.bid)); pg8::EpiProj E{wsb(F, WS_PH), INP};
            pg8::gemm_phase<pg8::EpiProj, pg8::StaticOrder, true, true>(F.lds + RING_OFF, gm, S, E);
#if defined(PROBE_REP) && (PROBE_REP & 256)
            __syncthreads(); pg8::gemm_phase<pg8::EpiProj, pg8::StaticOrder, true, true>(F.lds + RING_OFF, gm, S, E);
#endif
        }
        if (IN(pb + 3)) convert_set(F, layer, true, (M / 256) * (INP / 256) % F.G, 4);
        SEAM(pb + 3);
        if (IN(pb + 4)) { ph_dt_tasks(F, layer); ph_prep(F, layer);
#if defined(PROBE_REP) && (PROBE_REP & 1)
            ph_prep(F, layer);
#endif
        }
        SEAM(pb + 4);
        if (IN(pb + 5)) { ph_m2(F, layer, !last);
#if defined(PROBE_REP) && (PROBE_REP & 2)
            for (int rep_ = 0; rep_ < 4; ++rep_) ph_m2(F, layer, !last, PROBE_WHICH);
#endif
        }
        SEAM(pb + 5);
        if (IN(pb + 6)) {
#if defined(PROBE_REP) && (PROBE_REP & 32)
            ph_scan(F, layer); __syncthreads();
#endif
            ph_scan(F, layer); }
        SEAM(pb + 6);
        if (IN(pb + 7)) {
#if defined(PROBE_REP) && (PROBE_REP & 64)
            for (int rep_ = 0; rep_ < 4; ++rep_) { ph_m4(F, layer, !last, PROBE_WHICH); __syncthreads(); }
#endif
            ph_m4(F, layer, !last); }
        SEAM(pb + 7);
        if (IN(pb + 8)) { pg8::Gemm gm{wsb(F, WS_A), wsb(F, WS_WOUT), D, D}; pg8::StaticOrder S; S.init(ML, D, D, F.G, opaque_s(F.bid), last ? 0 : MC, KSPLIT); pg8::EpiYbf16 E{wsb(F, WS_Y), D, wsb(F, WS_YP), ML, MC};
            pg8::gemm_phase<pg8::EpiYbf16, pg8::StaticOrder, true, true>(F.lds + RING_OFF, gm, S, E); }
        SEAM(pb + 8);
        if (IN(pb + 9)) ph_rows<true, true>(F, Mrows, wsb(F, WS_XB), wsb(F, WS_XB) + (size_t)ML * D, wsb(F, WS_XB), wsb(F, WS_XB) + (size_t)ML * D, wsb(F, WS_Y), wsb(F, WS_YP), modL, 5, nw + 3 * D, 1.0f, wsb(F, WS_A), modL, 6, nw + 4 * D);
        SEAM(pb + 9);
        if (IN(pb + 10)) { pg8::Gemm gm{wsb(F, WS_A), wsb(F, WS_WGU2), D, D}; pg8::StaticOrder S; S.init(Mrows, NGU, D, F.G, opaque_s(F.bid)); pg8::EpiSwiGLU E{wsb(F, WS_PH), DFF};
            pg8::gemm_phase<pg8::EpiSwiGLU, pg8::StaticOrder, true, true>(F.lds + RING_OFF, gm, S, E); }
        if (IN(pb + 10) && !last) convert_set(F, layer + 1, false, (M / 256) * (NGU / 256) % F.G, 5);
        SEAM(pb + 10);
        if (IN(pb + 11)) { pg8::Gemm gm{wsb(F, WS_PH), wsb(F, WS_WD2), DFF, DFF}; pg8::StaticOrder S; S.init(ML, D, DFF, F.G, opaque_s(F.bid), last ? 0 : MC, KSPLIT); pg8::EpiYbf16 E{wsb(F, WS_Y), D, wsb(F, WS_YP), ML, MC};
            pg8::gemm_phase<pg8::EpiYbf16, pg8::StaticOrder, true, true>(F.lds + RING_OFF, gm, S, E); }
        if (IN(pb + 11) && !last) convert_set(F, layer + 1, false, (MC / 256) * (D / 256) * KSPLIT, 6);
        SEAM(pb + 11);
        if (IN(pb + 12)) {
            if (!last) { ph_rows<true, true>(F, M, wsb(F, WS_XB), wsb(F, WS_XB) + (size_t)ML * D, wsb(F, WS_XB), wsb(F, WS_XB) + (size_t)ML * D, wsb(F, WS_Y), wsb(F, WS_YP), modL, 8, nw + 5 * D, 0.5f, wsb(F, WS_A), modL + 5 * NMODC, 0, nw + 6 * D);
            }
            else ph_rows<true, false>(F, ML, wsb(F, WS_XB), wsb(F, WS_XB) + (size_t)ML * D, F.out, nullptr, wsb(F, WS_Y), nullptr, modL, 8, nw + 5 * D, 0.5f, nullptr, nullptr, 0, nullptr);
        }
        SEAM(pb + 12);
    }
#undef modL
#undef nw
#undef IN
#undef SEAM
}

#ifndef MK_SINGLE
#define MK_SINGLE 1
#endif
extern "C" void kernel_launch(void* const* d_in, const int* in_sizes, int n_in, void* d_out, int out_size, void* d_ws, size_t ws_size, hipStream_t stream) {
    static int grid = 0;
    if (grid == 0) {
        if (n_in != 22 || in_sizes[0] != ML * D || out_size != ML * D || ws_size < WS_END) { fprintf(stderr, "kernel_launch: unexpected shapes (n_in %d, in0 %d, out %d, ws %zu < %zu?); nothing launched\n", n_in, n_in > 0 ? in_sizes[0] : -1, out_size, ws_size, (size_t)WS_END); grid = -1; return; }
        int dev = 0, cus = 0, per_cu = 0;
        if (hipGetDevice(&dev) != hipSuccess || hipDeviceGetAttribute(&cus, hipDeviceAttributeMultiprocessorCount, dev) != hipSuccess) { grid = -1; return; }
        if (hipFuncSetAttribute((const void*)fwd_kernel, hipFuncAttributeMaxDynamicSharedMemorySize, LDS_BYTES) != hipSuccess) { fprintf(stderr, "kernel_launch: hipFuncSetAttribute failed\n"); grid = -1; return; }
        if (hipOccupancyMaxActiveBlocksPerMultiprocessor(&per_cu, (const void*)fwd_kernel, NTHR, LDS_BYTES) != hipSuccess || per_cu < 1) fprintf(stderr, "kernel_launch: occupancy query reports %d\n", per_cu);
        (void)hipGetLastError();
        grid = cus;
    }
    if (grid < 0) return;
    (void)hipMemsetAsync((char*)d_ws + WS_CTL, 0, CTL_ZERO_BYTES, stream);
    Args a{};
    for (int i = 0; i < 22; ++i) a.in[i] = (const float*)d_in[i];
    a.out = (float*)d_out; a.ws = (unsigned char*)d_ws;
#if MK_SINGLE
    a.ph_lo = 0; a.ph_hi = PH_TOTAL;
    hipLaunchKernelGGL(fwd_kernel, dim3(grid), dim3(NTHR), LDS_BYTES, stream, a);
#else
    for (int p = 0; p < PH_TOTAL; ++p) { a.ph_lo = p; a.ph_hi = p + 1; hipLaunchKernelGGL(fwd_kernel, dim3(grid), dim3(NTHR), LDS_BYTES, stream, a); }
#endif
}
```

```cpp
#include <hip/hip_runtime.h>
#include <cstdio>
#include <cstdint>
#include <cmath>
namespace pg8 {
#define PG8_LAS __attribute__((address_space(3)))
typedef unsigned short bf16_t;
typedef short bf16x8 __attribute__((ext_vector_type(8)));
typedef float f32x4 __attribute__((ext_vector_type(4)));
typedef unsigned u32x4 __attribute__((ext_vector_type(4)));
constexpr int BM = 256, BK = 64, HALF = 128, HTB = HALF * BK * 2  , STAGE_BYTES = 8 * HTB, NXCD = 8, WGM = 4;

#ifndef PG8_SWZ128
#define PG8_SWZ128 0
#endif
#if PG8_SWZ128
__host__ __device__ __forceinline__ int lds_sw(int r) { return (r & 7) ^ ((r >> 3) & 1); }
__host__ __device__ __forceinline__ int lds_byte(int r, int c) { return (r >> 3) * 1024 + (r & 7) * 128 + ((((c >> 3) ^ lds_sw(r)) & 7) << 4) + (c & 7) * 2; }
__host__ __device__ __forceinline__ void stage_rc(int b, int& R, int& C) { R = (b >> 10) * 8 + ((b >> 7) & 7); C = ((((b >> 4) & 7) ^ lds_sw(R)) << 3) + ((b & 15) >> 1); }
#else
__host__ __device__ __forceinline__ int lds_byte(int r, int c) { const int st = (r >> 4) * 2 + (c >> 5), rr = r & 15, cc = c & 31, ob = rr * 64 + cc * 2; return st * 1024 + (ob ^ (((ob >> 9) & 1) << 5)); }
__host__ __device__ __forceinline__ void stage_rc(int b, int& R, int& C) { const int st = b / 1024, sb = b % 1024, swz = sb ^ (((sb >> 9) & 1) << 5); R = (st >> 1) * 16 + swz / 64; C = (st & 1) * 32 + (swz % 64) / 2; }
#endif
__host__ __device__ __forceinline__ int perm32(int rho) { const int n = rho >> 4, i = rho & 15; return 8 * (i >> 2) + 4 * n + (i & 3); }

struct Unit { int pm, pn, kt0, nt, part; };
struct Gemm { const bf16_t* A; const bf16_t* Bt; int lda, K; };

struct StaticOrder {
    int nM, nN, nwg, G, c, ntk, nMt, S;
    __host__ __device__ void init(int Mfull, int N, int K, int G_, int c_, int Mtail = 0, int S_ = 1) { nM = Mfull / BM; nN = N / BM; nwg = nM * nN; G = G_; c = c_; ntk = K / BK; nMt = Mtail / BM; S = S_; }
    __host__ __device__ bool next(int i, Unit& u) const {
        const long L = (long)i * G + c; int pm, pn, kt0 = 0, nt = ntk, part = -1;
        if (L >= nwg) { const int t = (int)(L - nwg); if (t >= nMt * nN * S) return false;
            const int s = t % S, q = t / S; pn = q % nN; pm = nM + q / nN; nt = ntk / S; kt0 = s * nt; part = s; }
        else { int wgid = (int)L; { const int q = nwg / NXCD, r = nwg % NXCD, xcd = wgid % NXCD, off = wgid / NXCD; wgid = (xcd < r ? xcd * (q + 1) : r * (q + 1) + (xcd - r) * q) + off; }
            const int nig = WGM * nN, gid = wgid / nig, fm = gid * WGM, gsz = (nM - fm) < WGM ? (nM - fm) : WGM;
            pm = fm + ((wgid % nig) % gsz); pn = (wgid % nig) / gsz; }
        u.pm = pm; u.pn = pn; u.kt0 = kt0; u.nt = nt; u.part = part; return true;
    }
    __device__ __forceinline__ void a_ready(const Unit&) const {}
    __device__ __forceinline__ void done(const Unit&) const {}
};


__device__ __forceinline__ unsigned cvt_pk_bf16(float lo, float hi) { unsigned r; asm volatile("v_cvt_pk_bf16_f32 %0, %1, %2" : "=v"(r) : "v"(lo), "v"(hi)); return r; }
__device__ __forceinline__ float silu_f(float x) { return x * __builtin_amdgcn_rcpf(1.0f + __builtin_amdgcn_exp2f(x * -1.44269504089f)); }

struct EpiF32 {
    static constexpr bool PERM = false, AFTER_DRAIN = false;
    float* C; int ldc; float* Cpart; int tail_row0, tail_rows;
    __device__ __forceinline__ void operator()(const f32x4 (&acc)[2][2][4][2], const Unit& u, int wr, int wc, int fr, int fq) const {
        int row0 = u.pm * BM + wr * 64 + fr; const int col0 = u.pn * BM + wc * 32 + 4 * fq; float* base = C;
        if (u.part >= 0) { row0 -= tail_row0; base = Cpart + (size_t)u.part * tail_rows * ldc; }
#pragma unroll
        for (int ai = 0; ai < 2; ++ai)
#pragma unroll
            for (int m = 0; m < 4; ++m) { float* rowp = base + (size_t)(row0 + ai * HALF + m * 16) * ldc + col0;
#pragma unroll
                for (int bj = 0; bj < 2; ++bj)
#pragma unroll
                    for (int n = 0; n < 2; ++n) *(f32x4*)(rowp + bj * HALF + n * 16) = acc[ai][bj][m][n]; }
    }
};
struct EpiYbf16 {
    static constexpr bool PERM = true, AFTER_DRAIN = false;
    bf16_t* C; int ldc; bf16_t* Cpart; int tail_row0, tail_rows;
    __device__ __forceinline__ void operator()(const f32x4 (&acc)[2][2][4][2], const Unit& u, int wr, int wc, int fr, int fq) const {
        int row0 = u.pm * BM + wr * 64 + fr; const int col0 = u.pn * BM + wc * 32 + 8 * fq; bf16_t* base = C;
        if (u.part >= 0) { row0 -= tail_row0; base = Cpart + (size_t)u.part * tail_rows * ldc; }
#pragma unroll
        for (int ai = 0; ai < 2; ++ai)
#pragma unroll
            for (int m = 0; m < 4; ++m) { bf16_t* rowp = base + (size_t)(row0 + ai * HALF + m * 16) * ldc + col0;
#pragma unroll
                for (int bj = 0; bj < 2; ++bj) { const f32x4 v0 = acc[ai][bj][m][0], v1 = acc[ai][bj][m][1];
                    u32x4 w; w.x = cvt_pk_bf16(v0[0], v0[1]); w.y = cvt_pk_bf16(v0[2], v0[3]); w.z = cvt_pk_bf16(v1[0], v1[1]); w.w = cvt_pk_bf16(v1[2], v1[3]);
                    *(u32x4*)(rowp + bj * HALF) = w; } }
    }
};
struct EpiSwiGLU {
    static constexpr bool PERM = true, AFTER_DRAIN = false;
    bf16_t* O; int ldc;
    __device__ __forceinline__ void operator()(const f32x4 (&acc)[2][2][4][2], const Unit& u, int wr, int wc, int fr, int fq) const {
        const int row0 = u.pm * BM + wr * 64 + fr, col0 = u.pn * HALF + wc * 32 + 8 * fq;
#pragma unroll
        for (int ai = 0; ai < 2; ++ai)
#pragma unroll
            for (int m = 0; m < 4; ++m) { bf16_t* rowp = O + (size_t)(row0 + ai * HALF + m * 16) * ldc + col0;
                const f32x4 g0 = acc[ai][0][m][0], g1 = acc[ai][0][m][1], u0 = acc[ai][1][m][0], u1 = acc[ai][1][m][1];
                u32x4 w; w.x = cvt_pk_bf16(silu_f(g0[0]) * u0[0], silu_f(g0[1]) * u0[1]); w.y = cvt_pk_bf16(silu_f(g0[2]) * u0[2], silu_f(g0[3]) * u0[3]);
                w.z = cvt_pk_bf16(silu_f(g1[0]) * u1[0], silu_f(g1[1]) * u1[1]); w.w = cvt_pk_bf16(silu_f(g1[2]) * u1[2], silu_f(g1[3]) * u1[3]);
                *(u32x4*)rowp = w; }
    }
};
struct EpiProj {
    static constexpr bool PERM = true, AFTER_DRAIN = false;
    bf16_t* O; int ldc;
    __device__ __forceinline__ void operator()(const f32x4 (&acc)[2][2][4][2], const Unit& u, int wr, int wc, int fr, int fq) const {
        const int row0 = u.pm * BM + wr * 64 + fr, col0 = u.pn * BM + wc * 32 + 8 * fq;
#pragma unroll
        for (int ai = 0; ai < 2; ++ai)
#pragma unroll
            for (int m = 0; m < 4; ++m) { const int row = row0 + ai * HALF + m * 16; bf16_t* rowp = O + (size_t)row * ldc + col0;
#pragma unroll
                for (int bj = 0; bj < 2; ++bj) { const f32x4 v0 = acc[ai][bj][m][0], v1 = acc[ai][bj][m][1];
                    u32x4 w; w.x = cvt_pk_bf16(v0[0], v0[1]); w.y = cvt_pk_bf16(v0[2], v0[3]); w.z = cvt_pk_bf16(v1[0], v1[1]); w.w = cvt_pk_bf16(v1[2], v1[3]);
                    *(u32x4*)(rowp + bj * HALF) = w; } }
    }
};

template <class Epi, class Sched, bool ALIGN_EPI = false, bool SP2 = false>
__device__ __forceinline__ void gemm_phase(PG8_LAS unsigned char* lds, const Gemm g, const Sched& S, const Epi& E) {
    int tid_ = threadIdx.x; asm volatile("" : "+v"(tid_)); const int tid = tid_, wid = __builtin_amdgcn_readfirstlane(tid >> 6), lane = tid & 63, wr = wid >> 2, wc = wid & 3, fr = lane & 15, fq = lane >> 4;
    const int K = g.K, lda = g.lda;
    unsigned voffA[2], voffB[2];
#pragma unroll
    for (int i = 0; i < 2; ++i) { int R, C; stage_rc(tid * 16 + i * 8192, R, C); const int Rb = Epi::PERM ? ((R & ~31) + perm32(R & 31)) : R;
        voffA[i] = (unsigned)(R * lda + C) * 2u; voffB[i] = (unsigned)(Rb * K + C) * 2u; }
    const size_t kstep = (size_t)(BK * 2);
    const size_t hstepB = (size_t)HALF * K * 2, hstepA = (size_t)HALF * lda * 2;
    const size_t tstepB = 2 * hstepB, tstepA = 2 * hstepA;
    const unsigned ldsw = (unsigned)wid * 1024u;
    const int aoffk[2] = {lds_byte(wr * 64 + fr, fq * 8), lds_byte(wr * 64 + fr, 32 + fq * 8)}, boffk[2] = {lds_byte(wc * 32 + fr, fq * 8), lds_byte(wc * 32 + fr, 32 + fq * 8)};
#define PG8_SA(b, h) (((b) * 2 + (h)) * HTB)
#define PG8_SB(b, h) ((4 + (b) * 2 + (h)) * HTB)
#define PG8_STAGE(bufoff, gbase, voff) do { _Pragma("unroll") for (int _i = 0; _i < 2; ++_i) \
        __builtin_amdgcn_global_load_lds((const unsigned*)((const char*)(gbase) + (voff)[_i]), (PG8_LAS unsigned*)(lds + (bufoff) + ldsw + _i * 8192), 16, 0, 0); } while (0)
#define PG8_LDA(dst, b, h) do { _Pragma("unroll") for (int m = 0; m < 4; ++m) _Pragma("unroll") for (int k = 0; k < 2; ++k) dst[m][k] = *(const PG8_LAS bf16x8*)(lds + PG8_SA(b, h) + aoffk[k] + m * 2048); } while (0)
#define PG8_LDB(dst, b, h) do { _Pragma("unroll") for (int n = 0; n < 2; ++n) _Pragma("unroll") for (int k = 0; k < 2; ++k) dst[n][k] = *(const PG8_LAS bf16x8*)(lds + PG8_SB(b, h) + boffk[k] + n * 2048); } while (0)
#define PG8_MMA(ai, bj, At, Bt) do { __builtin_amdgcn_s_setprio(1); _Pragma("unroll") for (int m = 0; m < 4; ++m) _Pragma("unroll") for (int n = 0; n < 2; ++n) _Pragma("unroll") for (int k = 0; k < 2; ++k) \
        acc[ai][bj][m][n] = __builtin_amdgcn_mfma_f32_16x16x32_bf16(Bt[n][k], At[m][k], acc[ai][bj][m][n], 0, 0, 0); __builtin_amdgcn_s_setprio(0); } while (0)
#define PG8_WAIT_V(n) asm volatile("s_waitcnt vmcnt(" #n ")" ::: "memory")
#define PG8_WAIT_L(n) asm volatile("s_waitcnt lgkmcnt(" #n ")" ::: "memory")
#define PG8_BAR __builtin_amdgcn_s_barrier()
#define PG8_SCHED __builtin_amdgcn_sched_barrier(0)
    Unit cur, nxt; int ui = 0;
    if (!S.next(0, cur)) return;
    f32x4 acc[2][2][4][2];
#pragma unroll
    for (int a = 0; a < 2; ++a)
#pragma unroll
        for (int b = 0; b < 2; ++b)
#pragma unroll
            for (int m = 0; m < 4; ++m)
#pragma unroll
                for (int n = 0; n < 2; ++n) acc[a][b][m][n] = (f32x4){0.f, 0.f, 0.f, 0.f};
    bf16x8 At[4][2], B0[2][2], B1[2][2];
    const char* cA = (const char*)g.A + (size_t)cur.pm * tstepA + (size_t)cur.kt0 * kstep; const char* cB = (const char*)g.Bt + (size_t)cur.pn * tstepB + (size_t)cur.kt0 * kstep;
    S.a_ready(cur);
    if constexpr (SP2) {
        PG8_STAGE(PG8_SB(0, 0), cB, voffB); PG8_STAGE(PG8_SB(0, 1), cB + hstepB, voffB); PG8_STAGE(PG8_SA(0, 0), cA, voffA); PG8_STAGE(PG8_SA(0, 1), cA + hstepA, voffA);
        if (wr == 1) PG8_BAR;
        PG8_WAIT_V(2); PG8_BAR;
        PG8_STAGE(PG8_SB(1, 0), cB + kstep, voffB); PG8_STAGE(PG8_SA(1, 0), cA + kstep, voffA); PG8_STAGE(PG8_SB(1, 1), cB + hstepB + kstep, voffB);
        PG8_WAIT_V(6); PG8_BAR;
    } else {
        PG8_STAGE(PG8_SB(0, 0), cB, voffB); PG8_STAGE(PG8_SA(0, 0), cA, voffA); PG8_STAGE(PG8_SB(0, 1), cB + hstepB, voffB); PG8_STAGE(PG8_SA(0, 1), cA + hstepA, voffA);
        if (wr == 1) PG8_BAR;
        PG8_WAIT_V(4); PG8_BAR;
        PG8_STAGE(PG8_SB(1, 0), cB + kstep, voffB); PG8_STAGE(PG8_SA(1, 0), cA + kstep, voffA); PG8_STAGE(PG8_SB(1, 1), cB + hstepB + kstep, voffB);
        PG8_WAIT_V(6); PG8_BAR;
    }
    for (;;) {
        const bool has_next = S.next(ui + 1, nxt);
        const char* nA = has_next ? (const char*)g.A + (size_t)nxt.pm * tstepA + (size_t)nxt.kt0 * kstep : cA; const char* nB = has_next ? (const char*)g.Bt + (size_t)nxt.pn * tstepB + (size_t)nxt.kt0 * kstep : cB;
        const int nt = cur.nt;
        for (int t = 0; t < nt; t += 2) {
            const bool last = (t == nt - 2);
            const char* a1 = cA + (size_t)(t + 1) * kstep;
            const char* a2 = last ? nA : cA + (size_t)(t + 2) * kstep; const char* b2 = last ? nB : cB + (size_t)(t + 2) * kstep;
            const char* a3 = a2 + kstep; const char* b3 = b2 + kstep;
            if (last && has_next) S.a_ready(nxt);
            if constexpr (SP2) {
            PG8_LDB(B0, 0, 0); PG8_LDB(B1, 0, 1); PG8_SCHED; PG8_LDA(At, 0, 0); PG8_STAGE(PG8_SA(1, 1), a1 + hstepA, voffA);
            PG8_WAIT_V(8); PG8_WAIT_L(0); PG8_BAR; PG8_MMA(0, 0, At, B0); PG8_MMA(0, 1, At, B1); PG8_BAR; PG8_SCHED;
            PG8_LDA(At, 0, 1); PG8_STAGE(PG8_SB(0, 0), b2, voffB); PG8_STAGE(PG8_SB(0, 1), b2 + hstepB, voffB); PG8_STAGE(PG8_SA(0, 0), a2, voffA);
            PG8_WAIT_V(8); PG8_WAIT_L(0); PG8_BAR; PG8_MMA(1, 0, At, B0); PG8_MMA(1, 1, At, B1); PG8_BAR; PG8_SCHED;
            PG8_LDB(B0, 1, 0); PG8_LDB(B1, 1, 1); PG8_SCHED; PG8_LDA(At, 1, 0); PG8_STAGE(PG8_SA(0, 1), a2 + hstepA, voffA);
            PG8_WAIT_V(8); PG8_WAIT_L(0); PG8_BAR; PG8_MMA(0, 0, At, B0); PG8_MMA(0, 1, At, B1); PG8_BAR; PG8_SCHED;
            PG8_LDA(At, 1, 1); PG8_STAGE(PG8_SB(1, 0), b3, voffB); PG8_STAGE(PG8_SB(1, 1), b3 + hstepB, voffB); PG8_STAGE(PG8_SA(1, 0), a3, voffA);
            PG8_WAIT_V(8); PG8_WAIT_L(0); PG8_BAR; PG8_MMA(1, 0, At, B0); PG8_MMA(1, 1, At, B1); PG8_BAR; PG8_SCHED;
            } else {
            PG8_LDB(B0, 0, 0); PG8_SCHED; PG8_LDA(At, 0, 0); PG8_STAGE(PG8_SA(1, 1), a1 + hstepA, voffA);
            PG8_WAIT_L(8); PG8_BAR; PG8_WAIT_L(0); PG8_MMA(0, 0, At, B0); PG8_BAR; PG8_SCHED;
            PG8_LDB(B1, 0, 1); PG8_STAGE(PG8_SB(0, 0), b2, voffB);
            PG8_BAR; PG8_WAIT_L(0); PG8_MMA(0, 1, At, B1); PG8_BAR;
            PG8_LDA(At, 0, 1); PG8_STAGE(PG8_SA(0, 0), a2, voffA);
            PG8_BAR; PG8_WAIT_L(0); PG8_MMA(1, 0, At, B0); PG8_BAR; PG8_SCHED;
            PG8_STAGE(PG8_SB(0, 1), b2 + hstepB, voffB);
            PG8_WAIT_V(6); PG8_BAR; PG8_MMA(1, 1, At, B1); PG8_BAR;
            PG8_LDB(B0, 1, 0); PG8_SCHED; PG8_LDA(At, 1, 0); PG8_STAGE(PG8_SA(0, 1), a2 + hstepA, voffA);
            PG8_WAIT_L(8); PG8_BAR; PG8_WAIT_L(0); PG8_MMA(0, 0, At, B0); PG8_BAR; PG8_SCHED;
            PG8_LDB(B1, 1, 1); PG8_STAGE(PG8_SB(1, 0), b3, voffB);
            PG8_BAR; PG8_WAIT_L(0); PG8_MMA(0, 1, At, B1); PG8_BAR;
            PG8_LDA(At, 1, 1); PG8_STAGE(PG8_SA(1, 0), a3, voffA);
            PG8_BAR; PG8_WAIT_L(0); PG8_MMA(1, 0, At, B0); PG8_BAR; PG8_SCHED;
            PG8_STAGE(PG8_SB(1, 1), b3 + hstepB, voffB);
            PG8_WAIT_V(6); PG8_BAR; PG8_MMA(1, 1, At, B1); PG8_BAR;
            }
        }
        if constexpr (ALIGN_EPI) { if (wr == 0) PG8_BAR; }
        if constexpr (!Epi::AFTER_DRAIN) { E(acc, cur, wr, wc, fr, fq); S.done(cur); }
        if (!has_next) break;
#pragma unroll
        for (int a = 0; a < 2; ++a)
#pragma unroll
            for (int b = 0; b < 2; ++b)
#pragma unroll
                for (int m = 0; m < 4; ++m)
#pragma unroll
                    for (int n = 0; n < 2; ++n) acc[a][b][m][n] = (f32x4){0.f, 0.f, 0.f, 0.f};
        cur = nxt; cA = nA; cB = nB; ++ui;
        if constexpr (ALIGN_EPI) { if (wr == 1) PG8_BAR; }
    }
    PG8_WAIT_V(0);
    if constexpr (!ALIGN_EPI) { if (wr == 0) PG8_BAR; }
    PG8_BAR;
    if constexpr (Epi::AFTER_DRAIN) { E.fused(acc, cur, wr, wc, fr, fq, lds, wid, lane); S.done(cur); }
#undef PG8_SA
#undef PG8_SB
#undef PG8_STAGE
#undef PG8_LDA
#undef PG8_LDB
#undef PG8_MMA
#undef PG8_WAIT_V
#undef PG8_WAIT_L
#undef PG8_BAR
#undef PG8_SCHED
}
}

constexpr int D = 2048, NB = 4, T = 4096, CL = 256, ML = NB * T, MC = NB * CL, M = ML + MC;
constexpr int DFF = 5632, NGU = 2 * DFF, INC = 5664, INP = 5632, NMODC = 9 * D;
constexpr int NCR = M / 128;
constexpr int NLAYER = 2, KSPLIT = 4;
constexpr float EPS = 1e-6f;
constexpr int NWAVES = 8, NTHR = 512;
constexpr int PC_RQ = 0, PC_RK = 512, PC_RV = 1024, PC_RG = 1536, PC_AQ = 2048, PC_AK = 2560, PC_AV = 2816, PC_Z = 3072, PC_XBC = 4096, PC_DT = 5632;

constexpr size_t MiB = 1u << 20;
constexpr size_t WS_CTL = 0, CTL_ZERO_BYTES = 1 * MiB;
constexpr size_t WS_MOD = 1 * MiB;
constexpr size_t WS_MODP = 2 * MiB;
constexpr size_t WS_WGU1 = 14 * MiB, WS_WD1 = 58 * MiB, WS_WGU2 = 80 * MiB, WS_WD2 = 124 * MiB, WS_WIN = 146 * MiB, WS_WOUT = 169 * MiB;
constexpr size_t WS_XC = 177 * MiB;
constexpr size_t WS_A = 185 * MiB;
constexpr size_t WS_PH = 253 * MiB;
constexpr size_t WS_Y = 449 * MiB;
constexpr size_t WS_XB = 517 * MiB;
constexpr size_t WS_DTRAW = 585 * MiB, WS_DT = 588 * MiB, WS_CUMF = 591 * MiB, WS_RCUMB = 593 * MiB;
constexpr size_t WS_AQ = 595 * MiB, WS_AK = 612 * MiB, WS_SX = 621 * MiB, WS_SB = 655 * MiB, WS_SC = 664 * MiB;
constexpr size_t WS_YR = 673 * MiB, WS_YS = 707 * MiB;
constexpr size_t WS_RS = 775 * MiB;
constexpr size_t WS_SS = 843 * MiB;
constexpr size_t WS_SDEC = 979 * MiB;
constexpr size_t WS_YP = 980 * MiB;
constexpr size_t WS_RSB = 1012 * MiB, WS_SSB = 1046 * MiB;
constexpr size_t WS_END = 1114 * MiB;
static_assert(WS_MODP + (size_t)2 * 16 * 5 * NMODC * 4 <= WS_WGU1 && WS_WGU1 + (size_t)NGU * D * 2 <= WS_WD1 && WS_WD1 + (size_t)D * DFF * 2 <= WS_WGU2 && WS_WIN + (size_t)INC * D * 2 <= WS_WOUT && WS_WOUT + (size_t)D * D * 2 <= WS_XC, "ws map 1");
static_assert(WS_XC + (size_t)MC * D * 4 <= WS_A && WS_A + (size_t)M * D * 2 <= WS_PH && WS_PH + (size_t)M * INP * 2 <= WS_Y && WS_Y + (size_t)M * D * 4 <= WS_DTRAW, "ws map 2");
static_assert(WS_DTRAW + (size_t)M * 32 * 4 <= WS_DT && WS_DT + (size_t)M * 32 * 4 <= WS_CUMF && WS_CUMF + (size_t)M * 16 * 4 <= WS_RCUMB && WS_RCUMB + (size_t)M * 16 * 4 <= WS_AQ, "ws map 3");
static_assert(WS_AQ + (size_t)M * 512 * 2 <= WS_AK && WS_AK + (size_t)M * 256 * 2 <= WS_SX && WS_SX + (size_t)M * 1024 * 2 <= WS_SB && WS_SB + (size_t)M * 256 * 2 <= WS_SC && WS_SC + (size_t)M * 256 * 2 <= WS_YR, "ws map 4");
static_assert(WS_YR + (size_t)M * 512 * 4 <= WS_YS && WS_YS + (size_t)M * 1024 * 4 <= WS_RS && WS_RS + (size_t)NCR * 8 * 16384 * 4 <= WS_SS && WS_SS + (size_t)NCR * 32 * 8192 * 4 <= WS_SDEC, "ws map 5");
constexpr int CW_BAR = 4096;

constexpr int RING_OFF = 0, RING_BYTES = 131072;
constexpr int TS = 272, TILE = 128 * TS, HTILE = 64 * TS;
constexpr int AUX_OFF = 143360;
constexpr int MISC_OFF = AUX_OFF + 16384;
constexpr int LDS_BYTES = MISC_OFF + 256;
static_assert(AUX_OFF >= RING_BYTES && AUX_OFF >= 4 * TILE && LDS_BYTES <= 163840, "LDS map");

#define GAS __attribute__((address_space(1)))
#define LAS __attribute__((address_space(3)))
typedef unsigned short bf16;
typedef unsigned v4u __attribute__((ext_vector_type(4)));
typedef float f32x4 __attribute__((ext_vector_type(4)));
typedef short bf16x8 __attribute__((ext_vector_type(8)));
typedef LAS unsigned char* ldsp;
__device__ __forceinline__ unsigned f2bf(float f) { unsigned u = __builtin_bit_cast(unsigned, f); return (u + 0x7fffu + ((u >> 16) & 1u)) >> 16; }
__device__ __forceinline__ unsigned cvtpk(float lo, float hi) { unsigned r; asm("v_cvt_pk_bf16_f32 %0, %1, %2" : "=v"(r) : "v"(lo), "v"(hi)); return r; }
__device__ __forceinline__ unsigned pk2(float lo, float hi) { return cvtpk(lo, hi); }
__device__ __forceinline__ float bf2f(unsigned b) { return __builtin_bit_cast(float, b << 16); }
__device__ __forceinline__ float bflo(unsigned w) { return __builtin_bit_cast(float, w << 16); }
__device__ __forceinline__ float bfhi(unsigned w) { return __builtin_bit_cast(float, w & 0xffff0000u); }
__device__ __forceinline__ float silu(float x) { return x * __builtin_amdgcn_rcpf(1.0f + __builtin_amdgcn_exp2f(x * -1.44269504089f)); }
__device__ __forceinline__ float rsq(float x) { return __builtin_amdgcn_rsqf(x); }
__device__ __forceinline__ float wave_sum(float v) {
#pragma unroll
    for (int o = 1; o < 64; o <<= 1) v += __shfl_xor(v, o);
    return v;
}
__device__ __forceinline__ float sum16(float v) { v += __shfl_xor(v, 1); v += __shfl_xor(v, 2); v += __shfl_xor(v, 4); v += __shfl_xor(v, 8); return v; }
__device__ __forceinline__ float max16(float v) { v = fmaxf(v, __shfl_xor(v, 1)); v = fmaxf(v, __shfl_xor(v, 2)); v = fmaxf(v, __shfl_xor(v, 4)); v = fmaxf(v, __shfl_xor(v, 8)); return v; }

__device__ __forceinline__ int launder(int x) { asm volatile("" : "+v"(x)); return x; }
__device__ __forceinline__ int opaque_s(int x) { asm volatile("" : "+s"(x)); return x; }
#define XB_TMO      128
#define XB_XCNT(j)  (256  + 64 * (j))
#define XB_XSUB(j)  (1280 + 64 * (j))
#define XB_XGEN(j)  (2304 + 64 * (j))
#define XB_TOP      3328
#define XB_TOPGEN   3392
#define XCD_BAR_WORDS 3456
#define XB_SPIN_CAP (1u << 18)

__device__ __forceinline__ unsigned xb_ld(unsigned* p)              { return __hip_atomic_load(p, __ATOMIC_RELAXED, __HIP_MEMORY_SCOPE_AGENT); }
__device__ __forceinline__ unsigned xb_add(unsigned* p, unsigned v) { return __hip_atomic_fetch_add(p, v, __ATOMIC_RELAXED, __HIP_MEMORY_SCOPE_AGENT); }
__device__ __forceinline__ unsigned xb_xcc_id() { return (unsigned)__builtin_amdgcn_s_getreg((3 << 11) | 20) & 0xFu; }
#define XB_SPIN(cond, bar) do { unsigned _sp = 0; while (cond) { __builtin_amdgcn_s_sleep(1); \
    if ((++_sp & 255u) == 0u) { if (xb_ld(&(bar)[XB_TMO])) break; if (_sp > XB_SPIN_CAP) { atomicAdd(&(bar)[XB_TMO], 1u); break; } } } } while (0)

struct XcdBarrier {
    unsigned* bar; unsigned x;
    volatile LAS unsigned* st;
};

__device__ __forceinline__ XcdBarrier xcd_barrier_post(unsigned* bar, volatile LAS unsigned* st) {
    XcdBarrier b; b.bar = bar; b.x = xb_xcc_id(); b.st = st;
    if (threadIdx.x == 0) (void)xb_add(&bar[XB_XCNT(b.x)], 1u);
    return b;
}
__device__ __forceinline__ void xcd_barrier_complete(unsigned* bar, unsigned x, unsigned& nloc, unsigned& nx) {
    const unsigned G = gridDim.x * gridDim.y * gridDim.z;
    unsigned sum, cnt, mine, sp = 0u;
    for (;;) {
        sum = 0u; cnt = 0u; mine = 0u;
#pragma unroll
        for (unsigned j = 0; j < 16; ++j) { const unsigned c = xb_ld(&bar[XB_XCNT(j)]); sum += c; cnt += (c > 0u) ? 1u : 0u; mine = (j == x) ? c : mine; }
        if (sum == G) break;
        __builtin_amdgcn_s_sleep(1);
        if ((++sp & 255u) == 0u) { if (xb_ld(&bar[XB_TMO])) break; if (sp > XB_SPIN_CAP) { atomicAdd(&bar[XB_TMO], 1u); break; } }
    }
    nloc = mine > 0u ? mine : 1u; nx = cnt > 0u ? cnt : 1u;
}

__device__ __forceinline__ void xcd_barrier(const XcdBarrier& b) {
    asm volatile("s_waitcnt vmcnt(0)" ::: "memory");
    __syncthreads();
    if (threadIdx.x == 0) {
        unsigned* bar = b.bar;
        __builtin_amdgcn_s_waitcnt(0);
        unsigned nloc = b.st[0], nx = b.st[1];
        if (nloc == 0u) { unsigned xo = b.x; asm volatile("" : "+s"(xo)); xcd_barrier_complete(bar, xo, nloc, nx); b.st[0] = nloc; b.st[1] = nx; }
        const unsigned old = xb_add(&bar[XB_XSUB(b.x)], 1u);
        const unsigned gen = old / nloc;
        if (old + 1u == (gen + 1u) * nloc) {
            __builtin_amdgcn_fence(__ATOMIC_RELEASE, "agent");
            asm volatile("s_waitcnt vmcnt(0)" ::: "memory");
            const unsigned og = xb_add(&bar[XB_TOP], 1u);
            const unsigned tg = og / nx;
            if (og + 1u == (tg + 1u) * nx) xb_add(&bar[XB_TOPGEN], 1u);
            else XB_SPIN(xb_ld(&bar[XB_TOPGEN]) == tg, bar);
            __builtin_amdgcn_fence(__ATOMIC_ACQUIRE, "agent");
            xb_add(&bar[XB_XGEN(b.x)], 1u);
            asm volatile("s_waitcnt vmcnt(0)" ::: "memory");
        } else {
            XB_SPIN(xb_ld(&bar[XB_XGEN(b.x)]) == gen, bar);
            __builtin_amdgcn_fence(__ATOMIC_ACQUIRE, "agent");
            asm volatile("s_waitcnt vmcnt(0)" ::: "memory");
        }
    }
    __syncthreads();
}

struct Args { const float* in[22]; float* out; unsigned char* ws; int ph_lo, ph_hi; };
struct Frame {
    ldsp lds;
    volatile LAS unsigned* MISC;
    int tid, lane, wave, G, bid;
    float* out;
    unsigned char* ws;
};
__device__ __forceinline__ const float* inp(int i) { const __attribute__((address_space(4))) Args* ka = (const __attribute__((address_space(4))) Args*)__builtin_amdgcn_kernarg_segment_ptr(); return ka->in[opaque_s(i)]; }
__device__ __forceinline__ float* wsf(const Frame& F, size_t off) { return (float*)(F.ws + ((size_t)(unsigned)opaque_s((int)(off >> 20)) << 20)); }
__device__ __forceinline__ bf16* wsb(const Frame& F, size_t off) { return (bf16*)(F.ws + ((size_t)(unsigned)opaque_s((int)(off >> 20)) << 20)); }
enum { I_X = 0, I_C, I_CTX, I_CCTX, I_WADA, I_BADA, I_NORMW, I_GU1, I_D1, I_GU2, I_D2, I_WIN, I_WOUT, I_RDEC, I_RNW, I_SINK, I_CONVW, I_CONVB, I_ALOG, I_DTB, I_DSKIP, I_SNW };

struct TrItem { const float* W; bf16* WT; int K, N, drow0, k0, n0; };
__device__ __forceinline__ void tr_load(const TrItem& t, f32x4 (&v)[16], int lane) {
    const int c4 = 4 * (lane & 15), kq = lane >> 4; const bool okc = t.n0 + c4 < t.N;
#pragma unroll
    for (int i = 0; i < 16; ++i) { v[i] = (f32x4){0.f, 0.f, 0.f, 0.f}; if (okc) v[i] = *(const f32x4*)(t.W + (size_t)(t.k0 + 4 * i + kq) * t.N + t.n0 + c4); }
}
__device__ __forceinline__ void tr_finish(const TrItem& t, const f32x4 (&v)[16], LAS float* scr, int lane) {
    const int c4 = 4 * (lane & 15), kq = lane >> 4;
#pragma unroll
    for (int i = 0; i < 16; ++i) { LAS float* d = scr + (4 * i + kq) * 65 + c4; d[0] = v[i].x; d[1] = v[i].y; d[2] = v[i].z; d[3] = v[i].w; }
    asm volatile("s_waitcnt lgkmcnt(0)" ::: "memory");
    const int c = lane & 7;
#pragma unroll
    for (int j = 0; j < 8; ++j) { const int n = (lane >> 3) + 8 * j; const LAS float* s = scr + (8 * c) * 65 + n;
        v4u o; o.x = pk2(s[0 * 65], s[1 * 65]); o.y = pk2(s[2 * 65], s[3 * 65]); o.z = pk2(s[4 * 65], s[5 * 65]); o.w = pk2(s[6 * 65], s[7 * 65]);
        if (t.n0 + n < t.N) *(v4u*)(t.WT + (size_t)(t.drow0 + n) * t.K + t.k0 + 8 * c) = o; }
    asm volatile("s_waitcnt lgkmcnt(0)" ::: "memory");
}
__device__ __forceinline__ void convert_set(Frame& F, int layer, bool second, int wg0, int part = 0) {
    const int tid = launder(F.tid), lane = tid & 63, wave = __builtin_amdgcn_readfirstlane(tid >> 6), bid = opaque_s(F.bid);
    if (bid < wg0) return;
    LAS float* scr = (LAS float*)(F.lds + wave * 16640);
    const int gw = (bid - wg0) * NWAVES + wave, NGW = (F.G - wg0) * NWAVES;
    constexpr int I_GU = (D / 64) * (NGU / 64), I_DN = (DFF / 64) * (D / 64), I_IN = (D / 64) * ((INC + 63) / 64), I_OUT = (D / 64) * (D / 64);
    const float* gu = inp(second ? I_GU2 : I_GU1) + (size_t)layer * D * NGU; const float* dn = inp(second ? I_D2 : I_D1) + (size_t)layer * DFF * D;
    const float* sq = second ? inp(I_WOUT) + (size_t)layer * D * D : inp(I_WIN) + (size_t)layer * D * INC;
    bf16* const pGU = wsb(F, second ? WS_WGU2 : WS_WGU1); bf16* const pDN = wsb(F, second ? WS_WD2 : WS_WD1); bf16* const pSQ = wsb(F, second ? WS_WOUT : WS_WIN);
    const int nsq = second ? I_OUT : I_IN, nsqb = second ? D / 64 : (INC + 63) / 64, Nsq = second ? D : INC;
    const int it0 = part == 2 || part == 5 ? I_GU : part == 4 ? I_GU / 2 : part == 6 ? I_GU + I_DN : 0;
    const int it1 = part == 1 || part == 4 ? I_GU : part == 3 ? I_GU / 2 : part == 5 ? I_GU + I_DN : I_GU + I_DN + nsq;
#define TR_DESCRIBE(it_, t_) do { int r_ = (it_); \
        if (r_ < I_GU) { const int kb = r_ / (NGU / 64), nb = r_ % (NGU / 64), n0 = 64 * nb, half = n0 >= DFF ? 1 : 0, c0 = n0 - half * DFF;     \
            t_.W = gu; t_.WT = pGU; t_.K = D; t_.N = NGU; t_.drow0 = 256 * (c0 >> 7) + 128 * half + (c0 & 127); t_.k0 = 64 * kb; t_.n0 = n0; } \
        else if (r_ < I_GU + I_DN) { r_ -= I_GU; const int kb = r_ / (D / 64), nb = r_ % (D / 64); t_.W = dn; t_.WT = pDN; t_.K = DFF; t_.N = D; t_.drow0 = 64 * nb; t_.k0 = 64 * kb; t_.n0 = 64 * nb; } \
        else { r_ -= I_GU + I_DN; const int kb = r_ / nsqb, nb = r_ % nsqb; t_.W = sq; t_.WT = pSQ; t_.K = D; t_.N = Nsq; t_.drow0 = 64 * nb; t_.k0 = 64 * kb; t_.n0 = 64 * nb; } } while (0)
    TrItem tc, tn; f32x4 vc[16], vn[16];
    int it = it0 + gw;
    if (it < it1) { TR_DESCRIBE(it, tc); tr_load(tc, vc, lane); }
    for (; it < it1; it += NGW) {
        const bool more = it + NGW < it1;
        if (more) { TR_DESCRIBE(it + NGW, tn); tr_load(tn, vn, lane); }
        tr_finish(tc, vc, scr, lane);
        if (more) { tc = tn;
#pragma unroll
            for (int i = 0; i < 16; ++i) vc[i] = vn[i]; }
    }
#undef TR_DESCRIBE
    __syncthreads();
}
__device__ __forceinline__ void ph_convert_weights(Frame& F, int layer) { convert_set(F, layer, false, 0); convert_set(F, layer, true, 0); }
__device__ __forceinline__ void ph_adaln_partial(Frame& F) {
    const int tid = launder(F.tid), lane = tid & 63, wave = __builtin_amdgcn_readfirstlane(tid >> 6), bid = opaque_s(F.bid); (void)lane; (void)wave; (void)bid;
    float* const pMODP = wsf(F, WS_MODP);    const float* const iC = inp(I_C);    const float* const iCCTX = inp(I_CCTX);    const float* const iWADA = inp(I_WADA);
    LAS float* s = (LAS float*)F.lds;
    for (int i = tid; i < 5 * D; i += NTHR) { const int v = i / D, k = i % D; const float c = (v < 4) ? iC[v * D + k] : iCCTX[k]; s[i] = c / (1.0f + expf(-c)); }
    __syncthreads();
    const int gw = bid * NWAVES + wave, NGW = F.G * NWAVES;
    constexpr int NBLK = NMODC / 256;
    for (int u = gw; u < 2 * NBLK * 16; u += NGW) {
        const int layer = u / (NBLK * 16), r = u % (NBLK * 16), ks = r % 16, nb = r / 16, n0 = nb * 256 + 4 * lane;
        const float* W = iWADA + (size_t)layer * D * NMODC + (size_t)(ks * 128) * NMODC + n0;
        f32x4 a0 = {0.f, 0.f, 0.f, 0.f}, a1 = a0, a2 = a0, a3 = a0, a4 = a0;
#pragma unroll 8
        for (int kk = 0; kk < 128; ++kk) { const f32x4 w = *(const f32x4*)(W + (size_t)kk * NMODC); const int k = ks * 128 + kk;
            a0 += w * s[k]; a1 += w * s[D + k]; a2 += w * s[2 * D + k]; a3 += w * s[3 * D + k]; a4 += w * s[4 * D + k]; }
        float* o = pMODP + ((size_t)(layer * 16 + ks) * 5) * NMODC + n0;
        *(f32x4*)(o) = a0; *(f32x4*)(o + NMODC) = a1; *(f32x4*)(o + 2 * NMODC) = a2; *(f32x4*)(o + 3 * NMODC) = a3; *(f32x4*)(o + 4 * NMODC) = a4;
    }
    __syncthreads();
}
__device__ __forceinline__ void ph_mod_reduce(Frame& F) {
    const int tid = launder(F.tid), lane = tid & 63, wave = __builtin_amdgcn_readfirstlane(tid >> 6), bid = opaque_s(F.bid); (void)lane; (void)wave; (void)bid;
    float* const pMOD = wsf(F, WS_MOD);    float* const pMODP = wsf(F, WS_MODP);    const float* const iBADA = inp(I_BADA);    const float* const iNW = inp(I_NORMW);
    for (int i = bid * NTHR + tid; i < 2 * 5 * NMODC; i += F.G * NTHR) {
        const int layer = i / (5 * NMODC), rem = i % (5 * NMODC), v = rem / NMODC, n = rem % NMODC;
        float a = iBADA[layer * NMODC + n];
#pragma unroll
        for (int ks = 0; ks < 16; ++ks) a += pMODP[((size_t)(layer * 16 + ks) * 5 + v) * NMODC + n];
        const int ch = n / D, col = n % D, sub = ch / 3, kind = ch % 3; const float* nwl = iNW + (size_t)layer * 6 * D;
        if (kind == 1) a = (1.0f + a) * nwl[(2 * sub) * D + col];
        else if (kind == 2) a = a * (sub == 1 ? 1.0f : 0.5f) * nwl[(2 * sub + 1) * D + col];
        pMOD[i] = a;
    }
}

template <bool XINB, bool XOUTB> __device__ __forceinline__ void ph_rows(Frame& F, int nrows, const void* xin_l, const void* xin_c, void* xout_l, void* xout_c, const bf16* Y, const bf16* Ypart,
                                        const float* modA, int gi, const float* wpost, float resw, bf16* Aout, const float* modB, int si, const float* wpre) {
    const int tid = launder(F.tid), lane = tid & 63, wave = __builtin_amdgcn_readfirstlane(tid >> 6), bid = opaque_s(F.bid);
    const int gw = bid * NWAVES + wave, NGW = F.G * NWAVES;
    (void)wpost; (void)resw; (void)wpre;
    f32x4 xf_c[8], xf_n[8]; v4u xb_c[4], xb_n[4], yb_c[4], yb_n[4];
#define ROWS_COL(jj) (8 * lane + 512 * (jj))
#define ROWS_UNPK(w, lo, hi) do { lo = (f32x4){bflo((w)[0]), bfhi((w)[0]), bflo((w)[1]), bfhi((w)[1])}; hi = (f32x4){bflo((w)[2]), bfhi((w)[2]), bflo((w)[3]), bfhi((w)[3])}; } while (0)
#define ROWS_PK(lo, hi) ((v4u){pk2((lo).x, (lo).y), pk2((lo).z, (lo).w), pk2((hi).x, (hi).y), pk2((hi).z, (hi).w)})
#define ROWS_LOAD(rw, xf, xb, yb) do { const int rw_ = (rw); const bool lat_ = rw_ < ML; \
        if (XINB) { const bf16* xr_ = lat_ ? (const bf16*)xin_l + (size_t)rw_ * D : (const bf16*)xin_c + (size_t)(rw_ - ML) * D; _Pragma("unroll") for (int jj = 0; jj < 4; ++jj) xb[jj] = *(const v4u*)(xr_ + ROWS_COL(jj)); } \
        else { const float* xr_ = lat_ ? (const float*)xin_l + (size_t)rw_ * D : (const float*)xin_c + (size_t)(rw_ - ML) * D; \
            _Pragma("unroll") for (int jj = 0; jj < 4; ++jj) { xf[2 * jj] = *(const f32x4*)(xr_ + ROWS_COL(jj)); xf[2 * jj + 1] = *(const f32x4*)(xr_ + ROWS_COL(jj) + 4); } } \
        if (Y && (lat_ || !Ypart)) { _Pragma("unroll") for (int jj = 0; jj < 4; ++jj) yb[jj] = *(const v4u*)(Y + (size_t)rw_ * D + ROWS_COL(jj)); } } while (0)
#pragma unroll
    for (int j = 0; j < 8; ++j) xf_c[j] = xf_n[j] = (f32x4){0.f, 0.f, 0.f, 0.f};
#pragma unroll
    for (int jj = 0; jj < 4; ++jj) xb_c[jj] = xb_n[jj] = yb_c[jj] = yb_n[jj] = (v4u){0u, 0u, 0u, 0u};
    if (gw < nrows) ROWS_LOAD(gw, xf_c, xb_c, yb_c);
    for (int row = gw; row < nrows; row += NGW) {
        const bool lat = row < ML; const int v = lat ? (row >> 12) : 4;
        if (row + NGW < nrows) ROWS_LOAD(row + NGW, xf_n, xb_n, yb_n);
        f32x4 x[8];
        if (XINB) {
#pragma unroll
            for (int jj = 0; jj < 4; ++jj) ROWS_UNPK(xb_c[jj], x[2 * jj], x[2 * jj + 1]);
        } else {
#pragma unroll
            for (int j = 0; j < 8; ++j) x[j] = xf_c[j];
        }
        if (Y) {
            f32x4 y[8]; float ss = 0.f;
            if (!lat && Ypart) {
#pragma unroll
                for (int jj = 0; jj < 4; ++jj) { f32x4 a0 = {0.f, 0.f, 0.f, 0.f}, a1 = a0;
#pragma unroll
                    for (int sp = 0; sp < KSPLIT; ++sp) { const v4u yw = *(const v4u*)(Ypart + ((size_t)sp * MC + (row - ML)) * D + ROWS_COL(jj)); f32x4 p0, p1; ROWS_UNPK(yw, p0, p1); a0 += p0; a1 += p1; }
                    y[2 * jj] = a0; y[2 * jj + 1] = a1; }
            } else {
#pragma unroll
                for (int jj = 0; jj < 4; ++jj) ROWS_UNPK(yb_c[jj], y[2 * jj], y[2 * jj + 1]);
            }
#pragma unroll
            for (int j = 0; j < 8; ++j) { ss += (y[j].x * y[j].x + y[j].y * y[j].y) + (y[j].z * y[j].z + y[j].w * y[j].w); }
            const float rs = rsq(wave_sum(ss) * (1.0f / D) + EPS);
            const float* gp = modA + (size_t)v * NMODC + gi * D;
#pragma unroll
            for (int j = 0; j < 8; ++j) { const int c = ROWS_COL(j >> 1) + 4 * (j & 1); const f32x4 g = *(const f32x4*)(gp + c); x[j] += g * (y[j] * rs); }
        }
        if (xout_l) {
            if (XOUTB) { bf16* xo = lat ? (bf16*)xout_l + (size_t)row * D : (bf16*)xout_c + (size_t)(row - ML) * D;
#pragma unroll
                for (int jj = 0; jj < 4; ++jj) *(v4u*)(xo + ROWS_COL(jj)) = ROWS_PK(x[2 * jj], x[2 * jj + 1]);
            } else { float* xo = lat ? (float*)xout_l + (size_t)row * D : (float*)xout_c + (size_t)(row - ML) * D;
#pragma unroll
                for (int j = 0; j < 8; ++j) *(f32x4*)(xo + ROWS_COL(j >> 1) + 4 * (j & 1)) = x[j]; } }
        if (Aout) {
            float ss = 0.f;
#pragma unroll
            for (int j = 0; j < 8; ++j) ss += (x[j].x * x[j].x + x[j].y * x[j].y) + (x[j].z * x[j].z + x[j].w * x[j].w);
            const float rs2 = rsq(wave_sum(ss) * (1.0f / D) + EPS);
            const float* shp = modB + (size_t)v * NMODC + si * D; const float* scp = shp + D; bf16* ao = Aout + (size_t)row * D;
#pragma unroll
            for (int jj = 0; jj < 4; ++jj) { const int c = ROWS_COL(jj);
                const f32x4 sh0 = *(const f32x4*)(shp + c), sh1 = *(const f32x4*)(shp + c + 4), sc0 = *(const f32x4*)(scp + c), sc1 = *(const f32x4*)(scp + c + 4);
                const f32x4 h0 = (x[2 * jj] * rs2) * sc0 + sh0, h1 = (x[2 * jj + 1] * rs2) * sc1 + sh1;
                *(v4u*)(ao + c) = ROWS_PK(h0, h1); }
        }
#pragma unroll
        for (int j = 0; j < 8; ++j) xf_c[j] = xf_n[j];
#pragma unroll
        for (int jj = 0; jj < 4; ++jj) { xb_c[jj] = xb_n[jj]; yb_c[jj] = yb_n[jj]; }
    }
#undef ROWS_LOAD
#undef ROWS_COL
#undef ROWS_UNPK
#undef ROWS_PK
}


__device__ __forceinline__ void ph_dt_tasks(Frame& F, int layer) {
    const int tid = launder(F.tid), lane = tid & 63, wave = __builtin_amdgcn_readfirstlane(tid >> 6), bid = opaque_s(F.bid);
    float* const pDT = wsf(F, WS_DT); const bf16* const pA2 = wsb(F, WS_A); const bf16* const pWdt = wsb(F, WS_WIN) + (size_t)PC_DT * D;
    LAS f32x4* red = (LAS f32x4*)(F.lds + AUX_OFF);
    const int r = lane & 15, g = lane >> 4, kq = wave & 3; const float b0 = inp(I_DTB)[layer * 32 + r], b1 = inp(I_DTB)[layer * 32 + 16 + r];
    for (int it = bid; it < M / 32; it += F.G) {
        const int row0 = 32 * it + 16 * (wave >> 2);
        const bf16* ap = pA2 + (size_t)(row0 + r) * D + kq * 512 + 8 * g; const bf16* wp = pWdt + (size_t)r * D + kq * 512 + 8 * g;
        bf16x8 av[16];
#pragma unroll
        for (int ks = 0; ks < 16; ++ks) av[ks] = *(const bf16x8*)(ap + 32 * ks);
        f32x4 a0 = {0.f, 0.f, 0.f, 0.f}, a1 = a0;
#pragma unroll
        for (int ks = 0; ks < 16; ++ks) { const bf16x8 w0_ = *(const bf16x8*)(wp + 32 * ks), w1_ = *(const bf16x8*)(wp + (size_t)16 * D + 32 * ks);
            a0 = __builtin_amdgcn_mfma_f32_16x16x32_bf16(av[ks], w0_, a0, 0, 0, 0); a1 = __builtin_amdgcn_mfma_f32_16x16x32_bf16(av[ks], w1_, a1, 0, 0, 0); }
        red[(wave * 2 + 0) * 64 + lane] = a0; red[(wave * 2 + 1) * 64 + lane] = a1;
        __syncthreads();
        if (kq == 0) {
#pragma unroll
            for (int k = 1; k < 4; ++k) { a0 += red[((wave + k) * 2 + 0) * 64 + lane]; a1 += red[((wave + k) * 2 + 1) * 64 + lane]; }
#pragma unroll
            for (int q = 0; q < 4; ++q) { float* o = pDT + (size_t)(row0 + 4 * g + q) * 32 + r; const float x0 = a0[q] + b0, x1 = a1[q] + b1;
                o[0] = fmaxf(x0, 0.f) + log1pf(__expf(-fabsf(x0))); o[16] = fmaxf(x1, 0.f) + log1pf(__expf(-fabsf(x1))); }
        }
        __syncthreads();
    }
}
__device__ __forceinline__ void ph_prep(Frame& F, int layer) {
    const int tid = launder(F.tid), lane = tid & 63, wave = __builtin_amdgcn_readfirstlane(tid >> 6), bid = opaque_s(F.bid);
    const bf16* const pP = wsb(F, WS_PH); bf16* const pAQ = wsb(F, WS_AQ); bf16* const pAK = wsb(F, WS_AK); bf16* const pSX = wsb(F, WS_SX); bf16* const pSB = wsb(F, WS_SB); bf16* const pSC = wsb(F, WS_SC);
    const int gw = bid * NWAVES + wave, NGW = F.G * NWAVES;
    const float* cw = inp(I_CONVW) + (size_t)layer * 3 * 1536; const float* cb = inp(I_CONVB) + (size_t)layer * 1536;
    LAS float* cosT = (LAS float*)F.lds; LAS float* sinT = cosT + 2048;
    for (int i = tid; i < 2048; i += NTHR) { const float ang = (float)(i >> 5) * powf(10000.0f, -(float)(2 * (i & 31)) / 64.0f); float sn, cs; sincosf(ang, &sn, &cs); cosT[i] = cs; sinT[i] = sn; }
    f32x4 w0[3][2], w1[3][2], w2[3][2], wb[3][2];
#pragma unroll
    for (int r = 0; r < 3; ++r)
#pragma unroll
        for (int hf = 0; hf < 2; ++hf) { const int c = 8 * lane + 512 * r + 4 * hf; w0[r][hf] = *(const f32x4*)(cw + c); w1[r][hf] = *(const f32x4*)(cw + 1536 + c); w2[r][hf] = *(const f32x4*)(cw + 3072 + c); wb[r][hf] = *(const f32x4*)(cb + c); }
    __syncthreads();
    const int ch16 = lane & 15, fb = 8 * (ch16 & 3); const bool second = (ch16 & 4) != 0, colpart = (ch16 & 8) != 0;
    v4u qc, kc, u0c[3], u1c[3], u2c[3], qn, kn, u0n[3], u1n[3], u2n[3];
#define PREP_LOAD(rw, q_, k_, u0_, u1_, u2_) do { const int rw_ = (rw); const bool lat_ = rw_ < ML; const int t_ = lat_ ? (rw_ & (T - 1)) : ((rw_ - ML) & (CL - 1)), tl_ = lat_ ? T : CL; \
        const bf16* pr_ = pP + (size_t)rw_ * INP; q_ = *(const v4u*)(pr_ + PC_AQ + 8 * lane); k_ = *(const v4u*)(pr_ + PC_AK + 8 * (lane & 31)); \
        _Pragma("unroll") for (int r = 0; r < 3; ++r) { const int ch = 8 * lane + 512 * r; u1_[r] = *(const v4u*)(pr_ + PC_XBC + ch); u0_[r] = (v4u){0u, 0u, 0u, 0u}; u2_[r] = (v4u){0u, 0u, 0u, 0u}; \
            if (t_ > 0) u0_[r] = *(const v4u*)(pr_ - INP + PC_XBC + ch); if (t_ < tl_ - 1) u2_[r] = *(const v4u*)(pr_ + INP + PC_XBC + ch); } } while (0)
    qn = kn = (v4u){0u, 0u, 0u, 0u};
#pragma unroll
    for (int r = 0; r < 3; ++r) u0n[r] = u1n[r] = u2n[r] = (v4u){0u, 0u, 0u, 0u};
    if (gw < M) PREP_LOAD(gw, qc, kc, u0c, u1c, u2c);
    for (int row = gw; row < M; row += NGW) {
        const bool lat = row < ML; const int t = lat ? (row & (T - 1)) : ((row - ML) & (CL - 1));
        if (row + NGW < M) PREP_LOAD(row + NGW, qn, kn, u0n, u1n, u2n);
        f32x4 cs0 = {1.f, 1.f, 1.f, 1.f}, cs1 = cs0, sn0 = {0.f, 0.f, 0.f, 0.f}, sn1 = sn0;
        if (lat) { const int pos = colpart ? (t & 63) : (t >> 6); cs0 = *(const LAS f32x4*)(cosT + pos * 32 + fb); cs1 = *(const LAS f32x4*)(cosT + pos * 32 + fb + 4); sn0 = *(const LAS f32x4*)(sinT + pos * 32 + fb); sn1 = *(const LAS f32x4*)(sinT + pos * 32 + fb + 4);
            if (!second) { sn0 = -sn0; sn1 = -sn1; } }
        v4u qo, ko;
#pragma unroll
        for (int e = 0; e < 4; ++e) { const unsigned pq = (unsigned)__shfl_xor((int)qc[e], 4), pk = (unsigned)__shfl_xor((int)kc[e], 4);
            const float c0 = e < 2 ? cs0[2 * e] : cs1[2 * e - 4], c1 = e < 2 ? cs0[2 * e + 1] : cs1[2 * e - 3], s0 = e < 2 ? sn0[2 * e] : sn1[2 * e - 4], s1 = e < 2 ? sn0[2 * e + 1] : sn1[2 * e - 3];
            qo[e] = pk2(bflo(qc[e]) * c0 + bflo(pq) * s0, bfhi(qc[e]) * c1 + bfhi(pq) * s1); ko[e] = pk2(bflo(kc[e]) * c0 + bflo(pk) * s0, bfhi(kc[e]) * c1 + bfhi(pk) * s1); }
        *(v4u*)(pAQ + (size_t)row * 512 + 8 * lane) = qo;
        if (lane < 32) *(v4u*)(pAK + (size_t)row * 256 + 8 * lane) = ko;
#pragma unroll
        for (int r = 0; r < 3; ++r) {
            const int ch = 8 * lane + 512 * r;
            unsigned ow[4];
#pragma unroll
            for (int e2 = 0; e2 < 4; ++e2) { const int hf = e2 >> 1, k0 = 2 * (e2 & 1);
                const float ylo = w0[r][hf][k0] * bflo(u0c[r][e2]) + w1[r][hf][k0] * bflo(u1c[r][e2]) + w2[r][hf][k0] * bflo(u2c[r][e2]) + wb[r][hf][k0];
                const float yhi = w0[r][hf][k0 + 1] * bfhi(u0c[r][e2]) + w1[r][hf][k0 + 1] * bfhi(u1c[r][e2]) + w2[r][hf][k0 + 1] * bfhi(u2c[r][e2]) + wb[r][hf][k0 + 1];
                ow[e2] = pk2(silu(ylo), silu(yhi)); }
            const v4u o = {ow[0], ow[1], ow[2], ow[3]};
            if (ch < 1024) *(v4u*)(pSX + (size_t)row * 1024 + ch) = o;
            else if (ch < 1280) *(v4u*)(pSB + (size_t)row * 256 + (ch - 1024)) = o;
            else *(v4u*)(pSC + (size_t)row * 256 + (ch - 1280)) = o;
        }
        qc = qn; kc = kn;
#pragma unroll
        for (int r = 0; r < 3; ++r) { u0c[r] = u0n[r]; u1c[r] = u1n[r]; u2c[r] = u2n[r]; }
    }
#undef PREP_LOAD
    __syncthreads();
}

__device__ __forceinline__ int swz(int r, int c16) { return r * TS + (c16 << 4); }
__device__ __forceinline__ int swz_el(int r, int col) { return r * TS + (col << 1); }
template <int NT> __device__ __forceinline__ void mma_1xN(f32x4 (&acc)[NT], ldsp At, int arow0, ldsp Bt, int brow0, int lane) {
    const int r = lane & 15, g = lane >> 4;
#pragma unroll
    for (int ks = 0; ks < 4; ++ks) {
        const bf16x8 a = *(const LAS bf16x8*)(At + swz(arow0 + r, 4 * ks + g));
#pragma unroll
        for (int nt = 0; nt < NT; ++nt) {
            const bf16x8 b = *(const LAS bf16x8*)(Bt + swz(brow0 + 16 * nt + r, 4 * ks + g));
            acc[nt] = __builtin_amdgcn_mfma_f32_16x16x32_bf16(a, b, acc[nt], 0, 0, 0);
        }
        __builtin_amdgcn_sched_barrier(0);
    }
}
template <int NT> __device__ __forceinline__ void zero_acc(f32x4 (&acc)[NT]) {
#pragma unroll
    for (int i = 0; i < NT; ++i) acc[i] = (f32x4){0.f, 0.f, 0.f, 0.f};
}
__device__ __forceinline__ void stage_direct(ldsp tile, const bf16* g, int ld, int rows, int tid) {
    for (int c = tid; c < rows * 16; c += NTHR) { const int r = c >> 4, ch = c & 15; *(LAS v4u*)(tile + swz(r, ch)) = *(const v4u*)(g + (size_t)r * ld + ch * 8); }
}
__device__ __forceinline__ void stage_direct_f32(ldsp tile, const float* g, int ld, int rows, int tid) {
    for (int c = tid; c < rows * 16; c += NTHR) { const int r = c >> 4, ch = c & 15; const f32x4 a = *(const f32x4*)(g + (size_t)r * ld + ch * 8), b = *(const f32x4*)(g + (size_t)r * ld + ch * 8 + 4);
        *(LAS v4u*)(tile + swz(r, ch)) = (v4u){pk2(a.x, a.y), pk2(a.z, a.w), pk2(b.x, b.y), pk2(b.z, b.w)}; }
}
__device__ __forceinline__ void stage_tr(ldsp tile, const bf16* g, int ld, int ncols, const LAS float* rs, int tid) {
    const int nch = ncols >> 3;
    for (int c = tid; c < 128 * nch; c += NTHR) { const int r = c & 127, ch = c >> 7; const v4u v = *(const v4u*)(g + (size_t)r * ld + ch * 8); const float sc = rs ? rs[r] : 1.0f;
#pragma unroll
        for (int i = 0; i < 4; ++i) { const float lo = bflo(v[i]) * sc, hi = bfhi(v[i]) * sc;
            *(LAS bf16*)(tile + swz_el(ch * 8 + 2 * i, r)) = (bf16)f2bf(lo); *(LAS bf16*)(tile + swz_el(ch * 8 + 2 * i + 1, r)) = (bf16)f2bf(hi); } }
}

typedef short s16x4 __attribute__((ext_vector_type(4)));
constexpr int TSR = 272;
constexpr int TST = 288;
constexpr int TSX = 544;
__device__ __forceinline__ bf16x8 row_frag(ldsp t, int ts, int row0, int ks, int lane) { return *(const LAS bf16x8*)(t + (row0 + (lane & 15)) * ts + ((4 * ks + (lane >> 4)) << 4)); }
__device__ __forceinline__ bf16x8 tr_frag(ldsp t, int ts, int k0, int c0, int lane) {
    ldsp a = t + (k0 + 4 * (lane >> 4) + ((lane >> 2) & 3)) * ts + (c0 + 4 * (lane & 3)) * 2;
    const s16x4 lo = __builtin_amdgcn_ds_read_tr16_b64_v4i16((LAS s16x4*)a), hi = __builtin_amdgcn_ds_read_tr16_b64_v4i16((LAS s16x4*)(a + 16 * ts));
    return (bf16x8){lo[0], lo[1], lo[2], lo[3], hi[0], hi[1], hi[2], hi[3]};
}
__device__ __forceinline__ bf16x8 acc_frag(f32x4 lo, f32x4 hi) { const v4u w = {cvtpk(lo[0], lo[1]), cvtpk(lo[2], lo[3]), cvtpk(hi[0], hi[1]), cvtpk(hi[2], hi[3])}; return __builtin_bit_cast(bf16x8, w); }
__device__ __forceinline__ bf16x8 scale_frag(bf16x8 a, const LAS float* w, int k0, int lane) {
    const f32x4 wl = *(const LAS f32x4*)(w + k0 + 4 * (lane >> 4)), wh = *(const LAS f32x4*)(w + k0 + 16 + 4 * (lane >> 4)); const v4u x = __builtin_bit_cast(v4u, a);
    const v4u o = {cvtpk(bflo(x[0]) * wl[0], bfhi(x[0]) * wl[1]), cvtpk(bflo(x[1]) * wl[2], bfhi(x[1]) * wl[3]), cvtpk(bflo(x[2]) * wh[0], bfhi(x[2]) * wh[1]), cvtpk(bflo(x[3]) * wh[2], bfhi(x[3]) * wh[3])};
    return __builtin_bit_cast(bf16x8, o);
}
#define MFMA16(a, b, c) __builtin_amdgcn_mfma_f32_16x16x32_bf16(a, b, c, 0, 0, 0)
#define SCHED_FENCE() __builtin_amdgcn_sched_barrier(0)
template <int MT> __device__ __forceinline__ void mma_xt(f32x4 (&acc)[MT], ldsp t, int ts, const bf16x8 (&own)[4], int lane) {
    bf16x8 a[MT];
#pragma unroll
    for (int mt = 0; mt < MT; ++mt) a[mt] = row_frag(t, ts, 16 * mt, 0, lane);
#pragma unroll
    for (int ks = 0; ks < 4; ++ks) { bf16x8 an[MT];
        if (ks < 3) {
#pragma unroll
            for (int mt = 0; mt < MT; ++mt) an[mt] = row_frag(t, ts, 16 * mt, ks + 1, lane); }
#pragma unroll
        for (int mt = 0; mt < MT; ++mt) acc[mt] = MFMA16(a[mt], own[ks], acc[mt]);
        SCHED_FENCE();
        if (ks < 3) {
#pragma unroll
            for (int mt = 0; mt < MT; ++mt) a[mt] = an[mt]; }
    }
}
template <int NT, bool SWAP = false> __device__ __forceinline__ void mma_at(f32x4 (&acc)[NT], const bf16x8 (&afr)[4], ldsp t, int ts, int c0, int lane) {
    bf16x8 b[NT];
#pragma unroll
    for (int nt = 0; nt < NT; ++nt) b[nt] = tr_frag(t, ts, 0, c0 + 16 * nt, lane);
#pragma unroll
    for (int ks = 0; ks < 4; ++ks) { bf16x8 bn[NT];
        if (ks < 3) {
#pragma unroll
            for (int nt = 0; nt < NT; ++nt) bn[nt] = tr_frag(t, ts, 32 * (ks + 1), c0 + 16 * nt, lane); }
#pragma unroll
        for (int nt = 0; nt < NT; ++nt) acc[nt] = SWAP ? MFMA16(b[nt], afr[ks], acc[nt]) : MFMA16(afr[ks], b[nt], acc[nt]);
        SCHED_FENCE();
        if (ks < 3) {
#pragma unroll
            for (int nt = 0; nt < NT; ++nt) b[nt] = bn[nt]; }
    }
}
template <int ROWS, int COLS> struct Stage { static constexpr int CPR = COLS / 8, N = ROWS * CPR / NTHR; v4u v[N];
    __device__ __forceinline__ void load(const bf16* g, int ld, int tid) {
#pragma unroll
        for (int i = 0; i < N; ++i) { const int c = tid + NTHR * i, r = c / CPR, ch = c % CPR; v[i] = *(const v4u*)(g + (size_t)r * ld + ch * 8); } }
    __device__ __forceinline__ void store(ldsp tile, int ts, int tid) const {
#pragma unroll
        for (int i = 0; i < N; ++i) { const int c = tid + NTHR * i, r = c / CPR, ch = c % CPR; *(LAS v4u*)(tile + r * ts + (ch << 4)) = v[i]; } }
};

__device__ __forceinline__ void m2_ret_unit(Frame& F, int layer, int cr, int h, bool need_y) {
    const int tid = launder(F.tid), lane = tid & 63, w = __builtin_amdgcn_readfirstlane(tid >> 6), r = lane & 15, g = lane >> 4;
    const bf16* Pm = wsb(F, WS_PH) + (size_t)cr * 128 * INP; bf16* const pYR = wsb(F, WS_YR); bf16* const pRS = wsb(F, WS_RS);
    ldsp TK = F.lds, TV = F.lds + 128 * TSR;
    LAS float* aux = (LAS float*)(F.lds + AUX_OFF);
    LAS float* ef = aux; LAS float* eb = aux + 128; LAS float* nf = aux + 256; LAS float* nb = aux + 384; LAS float* wf = aux + 512; LAS float* wb = aux + 640;
    const float scale = 0.08838834764831845f;
    Stage<128, 128> sk, sv; sk.load(Pm + PC_RK + h * 128, INP, tid); sv.load(Pm + PC_RV + h * 128, INP, tid);
    bf16x8 qf[4];
#pragma unroll
    for (int ks = 0; ks < 4; ++ks) qf[ks] = *(const bf16x8*)(Pm + (size_t)(16 * w + r) * INP + PC_RQ + h * 128 + 32 * ks + 8 * g);
    const float lgf = -fabsf(inp(I_RDEC)[layer * 8 + h]), lgb = -fabsf(inp(I_RDEC)[layer * 8 + 4 + h]);
    __syncthreads();
    sk.store(TK, TSR, tid); sv.store(TV, TST, tid);
    if (tid < 128) { const float t = (float)tid; ef[tid] = __expf(lgf * t); nf[tid] = __expf(-lgf * t); eb[tid] = __expf(lgb * t); nb[tid] = __expf(-lgb * t); wf[tid] = __expf(lgf * (127.f - t)); wb[tid] = __expf(lgb * t); }
    __syncthreads();
    f32x4 s[8]; zero_acc(s); mma_xt<8>(s, TK, TSR, qf, lane);
    { const int i = 16 * w + r; const float efi = ef[i] * scale, nbi = nb[i] * scale;
#pragma unroll
      for (int mt = 0; mt < 8; ++mt) { const int j0 = 16 * mt + 4 * g; const f32x4 nfj = *(const LAS f32x4*)(nf + j0), ebj = *(const LAS f32x4*)(eb + j0);
#pragma unroll
          for (int q = 0; q < 4; ++q) { const int j = j0 + q; const float dec = (i >= j ? efi * nfj[q] : 0.f) + (i <= j ? nbi * ebj[q] : 0.f); s[mt][q] *= dec; } } }
    bf16x8 pa[4];
#pragma unroll
    for (int ks = 0; ks < 4; ++ks) pa[ks] = acc_frag(s[2 * ks], s[2 * ks + 1]);
    if (need_y) { f32x4 y[8]; zero_acc(y); mma_at<8, true>(y, pa, TV, TST, 0, lane);
#pragma unroll
        for (int nt = 0; nt < 8; ++nt) *(unsigned long long*)(pYR + (size_t)(cr * 128 + 16 * w + r) * 512 + h * 128 + 16 * nt + 4 * g) = (unsigned long long)cvtpk(y[nt][0], y[nt][1]) | ((unsigned long long)cvtpk(y[nt][2], y[nt][3]) << 32); }
#pragma unroll
    for (int dir = 0; dir < 2; ++dir) { bf16x8 va[4];
#pragma unroll
        for (int ks = 0; ks < 4; ++ks) va[ks] = scale_frag(tr_frag(TV, TST, 32 * ks, 16 * w, lane), dir ? wb : wf, 32 * ks, lane);
        f32x4 u[8]; zero_acc(u); mma_at<8, true>(u, va, TK, TSR, 0, lane);
        bf16* dst = pRS + ((size_t)(cr * 4 + h) * 2 + dir) * 16384 + (16 * w + r) * 128 + 4 * g;
#pragma unroll
        for (int nt = 0; nt < 8; ++nt) *(unsigned long long*)(dst + 16 * nt) = (unsigned long long)cvtpk(u[nt][0], u[nt][1]) | ((unsigned long long)cvtpk(u[nt][2], u[nt][3]) << 32); }
}
__device__ __forceinline__ void m2_ssd_unit(Frame& F, int layer, int cr, int grp, int hq, bool need_y) {
    const int tid = launder(F.tid), lane = tid & 63, w = __builtin_amdgcn_readfirstlane(tid >> 6), r = lane & 15, g = lane >> 4, m0 = cr * 128, h0 = grp * 8 + hq * 4;
    const bf16* const pSX = wsb(F, WS_SX); const bf16* const pSB = wsb(F, WS_SB); const bf16* const pSC = wsb(F, WS_SC); const float* const pDT = wsf(F, WS_DT);
    float* const pCUMF = wsf(F, WS_CUMF); float* const pRCUMB = wsf(F, WS_RCUMB); float* const pSDEC = wsf(F, WS_SDEC); bf16* const pYS = wsb(F, WS_YS); bf16* const pSS = wsb(F, WS_SS);
    ldsp TB = F.lds, TX = F.lds + 128 * TSR;
    LAS float* aux = (LAS float*)(F.lds + AUX_OFF);
    Stage<128, 128> sb; Stage<128, 256> sx; sb.load(pSB + (size_t)m0 * 256 + grp * 128, 256, tid); sx.load(pSX + (size_t)m0 * 1024 + h0 * 64, 1024, tid);
    bf16x8 cf[4];
#pragma unroll
    for (int ks = 0; ks < 4; ++ks) cf[ks] = *(const bf16x8*)(pSC + (size_t)(m0 + 16 * w + r) * 256 + grp * 128 + 32 * ks + 8 * g);
    const int chh = w >> 1, cdir = w & 1, ch_ = h0 + chh;
    const float alog_ = inp(I_ALOG)[layer * 32 + cdir * 16 + ch_], d0 = pDT[(size_t)(m0 + lane) * 32 + cdir * 16 + ch_], d1 = pDT[(size_t)(m0 + 64 + lane) * 32 + cdir * 16 + ch_];
    __syncthreads();
    sb.store(TB, TSR, tid); sx.store(TX, TSX, tid);
    {
      const int hh = chh, dir = cdir, h = ch_; const float a = -__expf(alog_);
      float p0 = d0 * a, p1 = d1 * a; const float l0 = p0, l1 = p1;
#pragma unroll
      for (int o = 1; o < 64; o <<= 1) { const float t0 = __shfl_up(p0, o), t1 = __shfl_up(p1, o); if (lane >= o) { p0 += t0; p1 += t1; } }
      const float tot0 = __shfl(p0, 63), tot = tot0 + __shfl(p1, 63); p1 += tot0;
      float c0, c1, w0, w1;
      if (dir == 0) { c0 = p0; c1 = p1; w0 = d0 * __expf(tot - p0); w1 = d1 * __expf(tot - p1); }
      else { c0 = tot - p0 + l0; c1 = tot - p1 + l1; w0 = d0 * __expf(tot - c0); w1 = d1 * __expf(tot - c1); }
      LAS float* base = aux + (hh * 2 + dir) * 384;
      const float L2E = 1.44269504089f;
      base[lane] = c0 * L2E; base[64 + lane] = c1 * L2E; base[128 + lane] = d0; base[192 + lane] = d1; base[256 + lane] = w0; base[320 + lane] = w1;
      float* cg = dir ? pRCUMB : pCUMF; cg[(size_t)(m0 + lane) * 16 + h] = c0 * L2E; cg[(size_t)(m0 + 64 + lane) * 16 + h] = c1 * L2E;
      if (lane == 0) pSDEC[(size_t)(cr * 16 + h) * 2 + dir] = __expf(tot);
    }
    __syncthreads();
    f32x4 cb[8]; zero_acc(cb); mma_xt<8>(cb, TB, TSR, cf, lane);
    for (int hh = 0; hh < 4; ++hh) {
        const int h = h0 + hh, l = 16 * w + r;
        const LAS float* cumf = aux + (hh * 2) * 384; const LAS float* dtf = cumf + 128; const LAS float* wf = cumf + 256;
        const LAS float* rcum = aux + (hh * 2 + 1) * 384; const LAS float* dtb = rcum + 128; const LAS float* wb = rcum + 256;
        const float cfl = cumf[l], rcl = rcum[l];
        f32x4 m[8];
#pragma unroll
        for (int mt = 0; mt < 8; ++mt) { const int s0 = 16 * mt + 4 * g;
            if (mt < w) { const f32x4 cs = *(const LAS f32x4*)(cumf + s0), ds = *(const LAS f32x4*)(dtf + s0);
#pragma unroll
                for (int q = 0; q < 4; ++q) m[mt][q] = cb[mt][q] * (__builtin_amdgcn_exp2f(cfl - cs[q]) * ds[q]);
            } else if (mt > w) { const f32x4 rs = *(const LAS f32x4*)(rcum + s0), es = *(const LAS f32x4*)(dtb + s0);
#pragma unroll
                for (int q = 0; q < 4; ++q) m[mt][q] = cb[mt][q] * (__builtin_amdgcn_exp2f(rcl - rs[q]) * es[q]);
            } else { const f32x4 cs = *(const LAS f32x4*)(cumf + s0), ds = *(const LAS f32x4*)(dtf + s0), rs = *(const LAS f32x4*)(rcum + s0), es = *(const LAS f32x4*)(dtb + s0);
#pragma unroll
                for (int q = 0; q < 4; ++q) { const int s = s0 + q; const float mf = (l >= s) ? __builtin_amdgcn_exp2f(cfl - cs[q]) * ds[q] : 0.f, mb = (l <= s) ? __builtin_amdgcn_exp2f(rcl - rs[q]) * es[q] : 0.f; m[mt][q] = cb[mt][q] * (mf + mb); } } }
        bf16x8 pa[4];
#pragma unroll
        for (int ks = 0; ks < 4; ++ks) pa[ks] = acc_frag(m[2 * ks], m[2 * ks + 1]);
        if (need_y) { f32x4 y[4]; zero_acc(y); mma_at<4, true>(y, pa, TX, TSX, hh * 64, lane);
#pragma unroll
            for (int nt = 0; nt < 4; ++nt) *(unsigned long long*)(pYS + (size_t)(m0 + 16 * w + r) * 1024 + h * 64 + 16 * nt + 4 * g) = (unsigned long long)cvtpk(y[nt][0], y[nt][1]) | ((unsigned long long)cvtpk(y[nt][2], y[nt][3]) << 32); }
#pragma unroll
        for (int dir = 0; dir < 2; ++dir) { bf16x8 xa[4];
#pragma unroll
            for (int ks = 0; ks < 4; ++ks) xa[ks] = scale_frag(tr_frag(TX, TSX, 32 * ks, hh * 64 + 16 * (w & 3), lane), dir ? wb : wf, 32 * ks, lane);
            f32x4 u[4]; zero_acc(u); mma_at<4, true>(u, xa, TB, TSR, 64 * (w >> 2), lane);
            bf16* dst = pSS + ((size_t)(cr * 16 + h) * 2 + dir) * 8192 + (16 * (w & 3) + r) * 128 + 64 * (w >> 2) + 4 * g;
#pragma unroll
            for (int nt = 0; nt < 4; ++nt) *(unsigned long long*)(dst + 16 * nt) = (unsigned long long)cvtpk(u[nt][0], u[nt][1]) | ((unsigned long long)cvtpk(u[nt][2], u[nt][3]) << 32); }
    }
}
__device__ __forceinline__ void m2_att_unit(Frame& F, int layer, int b, int qb, int qh, bool is_ctx) {
    const int tid = launder(F.tid), lane = tid & 63, w = __builtin_amdgcn_readfirstlane(tid >> 6), r = lane & 15, g = lane >> 4, kvh = qh >> 1;
    const bf16* const pAQ = wsb(F, WS_AQ); const bf16* const pAK = wsb(F, WS_AK); const bf16* const pP = wsb(F, WS_PH); bf16* const pA = wsb(F, WS_A);
    const int qrow0 = is_ctx ? (ML + b * CL + qb * 128) : (b * T + qb * 128);
    constexpr int KVB = 128 * TSR + 128 * TST;
    const float scale = 0.08838834764831845f;
    const int nleft = (!is_ctx && qb > 0) ? 1 : 0, nright = (!is_ctx && qb < T / 128 - 1) ? 1 : 0, nt_ = is_ctx ? 2 : 3 + nleft + nright, crow = ML + b * CL;
#define TILE_INFO(ti, row, mode) do { int t_ = (ti); row = crow + t_ * 128; mode = 0; \
        if (!is_ctx) { if (t_ == 0) row = qrow0; else if (nleft && t_ == 1) { row = qrow0 - 128; mode = 1; } else if (nright && t_ == 1 + nleft) { row = qrow0 + 128; mode = 2; } else row = crow + (t_ - 1 - nleft - nright) * 128; } } while (0)
    bf16x8 qf[4];
#pragma unroll
    for (int ks = 0; ks < 4; ++ks) qf[ks] = *(const bf16x8*)(pAQ + (size_t)(qrow0 + 16 * w + r) * 512 + qh * 128 + 32 * ks + 8 * g);
    float mrun = -1e30f, lrun = 0.f; f32x4 o[8]; zero_acc(o);
    v4u kr[4], vr[4];
    const int srow = tid >> 4, sch = tid & 15;
    { int row0_, mode0_; TILE_INFO(0, row0_, mode0_); (void)mode0_; const bf16* kg = pAK + (size_t)(row0_ + srow) * 256 + kvh * 128 + sch * 8; const bf16* vg = pP + (size_t)(row0_ + srow) * INP + PC_AV + kvh * 128 + sch * 8;
#pragma unroll
      for (int k = 0; k < 4; ++k) { kr[k] = *(const v4u*)(kg + (size_t)(32 * k) * 256); vr[k] = *(const v4u*)(vg + (size_t)(32 * k) * INP); } }
    __syncthreads();
#pragma unroll
    for (int k = 0; k < 4; ++k) { *(LAS v4u*)(F.lds + (srow + 32 * k) * TSR + (sch << 4)) = kr[k]; *(LAS v4u*)(F.lds + 128 * TSR + (srow + 32 * k) * TST + (sch << 4)) = vr[k]; }
    __syncthreads();
    for (int ti = 0; ti < nt_; ++ti) {
        ldsp TK = F.lds + (ti & 1) * KVB, TV = TK + 128 * TSR;
        int mode, row_cur; TILE_INFO(ti, row_cur, mode); (void)row_cur;
        if (ti + 1 < nt_) { int tr_, mode_n; TILE_INFO(ti + 1, tr_, mode_n); (void)mode_n; const bf16* kg = pAK + (size_t)(tr_ + srow) * 256 + kvh * 128 + sch * 8; const bf16* vg = pP + (size_t)(tr_ + srow) * INP + PC_AV + kvh * 128 + sch * 8;
#pragma unroll
            for (int k = 0; k < 4; ++k) { kr[k] = *(const v4u*)(kg + (size_t)(32 * k) * 256); vr[k] = *(const v4u*)(vg + (size_t)(32 * k) * INP); } }
        f32x4 s[8]; zero_acc(s); mma_xt<8>(s, TK, TSR, qf, lane);
        const int i = 16 * w + r; float mx = -1e30f;
#pragma unroll
        for (int mt = 0; mt < 8; ++mt)
#pragma unroll
            for (int q = 0; q < 4; ++q) { const int j = 16 * mt + 4 * g + q; const bool valid = (mode == 0) || (mode == 1 ? (j >= i) : (j <= i)); const float v = valid ? s[mt][q] * scale : -INFINITY; s[mt][q] = v; mx = fmaxf(mx, v); }
        mx = fmaxf(mx, __shfl_xor(mx, 16)); mx = fmaxf(mx, __shfl_xor(mx, 32));
        const float mnew = fmaxf(mrun, mx), alpha = __expf(mrun - mnew); float rsum = 0.f;
#pragma unroll
        for (int mt = 0; mt < 8; ++mt)
#pragma unroll
            for (int q = 0; q < 4; ++q) { const float p = __expf(s[mt][q] - mnew); s[mt][q] = p; rsum += p; }
        rsum += __shfl_xor(rsum, 16); rsum += __shfl_xor(rsum, 32);
        lrun = lrun * alpha + rsum; mrun = mnew;
        bf16x8 pa[4];
#pragma unroll
        for (int ks = 0; ks < 4; ++ks) pa[ks] = acc_frag(s[2 * ks], s[2 * ks + 1]);
#pragma unroll
        for (int nt = 0; nt < 8; ++nt) o[nt] = o[nt] * alpha;
        mma_at<8, true>(o, pa, TV, TST, 0, lane);
        if (ti + 1 < nt_) { ldsp NK = F.lds + ((ti + 1) & 1) * KVB, NV = NK + 128 * TSR;
#pragma unroll
            for (int k = 0; k < 4; ++k) { *(LAS v4u*)(NK + (srow + 32 * k) * TSR + (sch << 4)) = kr[k]; *(LAS v4u*)(NV + (srow + 32 * k) * TST + (sch << 4)) = vr[k]; } }
        __syncthreads();
    }
    const float sk = inp(I_SINK)[layer * 4 + qh];
    const float mfin = fmaxf(mrun, sk), afin = __expf(mrun - mfin), lfin = lrun * afin + __expf(sk - mfin), fq_ = afin / lfin;
#pragma unroll
    for (int nt = 0; nt < 8; ++nt) { const f32x4 ov = o[nt] * fq_;
        *(unsigned long long*)(pA + (size_t)(qrow0 + 16 * w + r) * D + 512 + qh * 128 + 16 * nt + 4 * g) = (unsigned long long)cvtpk(ov[0], ov[1]) | ((unsigned long long)cvtpk(ov[2], ov[3]) << 32); }
#undef TILE_INFO
}
__device__ __forceinline__ void ph_m2(Frame& F, int layer, bool ctx_out, int which = 7) {
    const int tid = launder(F.tid), lane = tid & 63, wave = __builtin_amdgcn_readfirstlane(tid >> 6), bid = opaque_s(F.bid); (void)lane; (void)wave; (void)bid;
    const int natt = 512 + (ctx_out ? 32 : 0);
    const int vb = (F.G & 7) == 0 ? (bid & 7) * (F.G >> 3) + (bid >> 3) : bid;
    if (which & 1) for (int u = vb; u < natt; u += F.G) {
        if (u < 512) m2_att_unit(F, layer, u >> 7, (u >> 2) & 31, u & 3, false);
        else { const int v = u - 512; m2_att_unit(F, layer, v >> 3, (v >> 2) & 1, v & 3, true); }
    }
    if (which & 2) for (int u = (vb + 224) % F.G; u < NCR * 4; u += F.G) { const int cr = u >> 2; m2_ssd_unit(F, layer, cr, (u >> 1) & 1, u & 1, ctx_out || cr < 128); }
    if (which & 4) for (int u = (vb + 192) % F.G; u < NCR * 4; u += F.G) { const int cr = u >> 2; m2_ret_unit(F, layer, cr, u & 3, ctx_out || cr < 128); }
    __syncthreads();
}

__device__ __forceinline__ int chain_cr(int b, int dir, int step) {
    if (step < 2) return 128 + b * 2 + (dir ? 1 - step : step);
    return b * 32 + (dir ? 33 - step : step - 2);
}
__device__ __forceinline__ void ph_scan(Frame& F, int layer) {
    const int tid = launder(F.tid), bid = opaque_s(F.bid);
    const bf16* const pRS = wsb(F, WS_RS); const bf16* const pSS = wsb(F, WS_SS); const float* const pSDEC = wsf(F, WS_SDEC); const float* const iRDEC = inp(I_RDEC);
    bf16* const pRSB = wsb(F, WS_RSB); bf16* const pSSB = wsb(F, WS_SSB);
    const int gt = bid * NTHR + tid, NT_ = F.G * NTHR;
    for (int it = gt; it < 65536 + 131072; it += NT_) {
        const bool ret = it < 65536; const int j = ret ? it : it - 65536;
        int e8, x, dir, h, b; if (ret) { e8 = j & 2047; x = j >> 11; dir = x & 1; h = (x >> 1) & 3; b = x >> 3; } else { e8 = j & 1023; x = j >> 10; dir = x & 1; h = (x >> 1) & 15; b = x >> 5; }
        const bf16* src = ret ? pRS : pSS; bf16* dstb = ret ? pRSB : pSSB; const int nh = ret ? 4 : 16, tsz = ret ? 16384 : 8192;
        const float rdec = ret ? __expf(-fabsf(iRDEC[layer * 8 + dir * 4 + h]) * 128.0f) : 0.f;
        float s[8];
#pragma unroll
        for (int k = 0; k < 8; ++k) s[k] = 0.f;
#pragma unroll
        for (int b0 = 0; b0 < 34; b0 += 12) { constexpr int NBMAX = 12; v4u u[NBMAX]; float dc[NBMAX]; size_t of[NBMAX];
#pragma unroll
            for (int i = 0; i < NBMAX; ++i) if (b0 + i < 34) { const int cr = chain_cr(b, dir, b0 + i); of[i] = ((size_t)(cr * nh + h) * 2 + dir) * tsz + e8 * 8; u[i] = *(const v4u*)(src + of[i]); dc[i] = ret ? rdec : pSDEC[(size_t)(cr * 16 + h) * 2 + dir]; }
#pragma unroll
            for (int i = 0; i < NBMAX; ++i) if (b0 + i < 34) {
                *(v4u*)(dstb + of[i]) = (v4u){pk2(s[0], s[1]), pk2(s[2], s[3]), pk2(s[4], s[5]), pk2(s[6], s[7])};
#pragma unroll
                for (int k = 0; k < 4; ++k) { s[2 * k] = s[2 * k] * dc[i] + bflo(u[i][k]); s[2 * k + 1] = s[2 * k + 1] * dc[i] + bfhi(u[i][k]); } } }
    }
}


__device__ __forceinline__ void m4_ret_unit(Frame& F, int layer, int cr, int h) {
    const int tid = launder(F.tid), lane = tid & 63, w = __builtin_amdgcn_readfirstlane(tid >> 6), r = lane & 15, g = lane >> 4, i = 16 * w + r;
    const bf16* const pYR = wsb(F, WS_YR); const bf16* const pRSB = wsb(F, WS_RSB); bf16* const pA = wsb(F, WS_A); const bf16* const pP = wsb(F, WS_PH);
    const size_t m = (size_t)cr * 128 + i;
    const float scale = 0.08838834764831845f;
    ldsp T0 = F.lds, T1 = F.lds + 128 * TSR;
    Stage<128, 128> s0, s1; s0.load(pRSB + ((size_t)(cr * 4 + h) * 2 + 0) * 16384, 128, tid); s1.load(pRSB + ((size_t)(cr * 4 + h) * 2 + 1) * 16384, 128, tid);
    bf16x8 qf[4];
#pragma unroll
    for (int ks = 0; ks < 4; ++ks) qf[ks] = *(const bf16x8*)(pP + m * INP + PC_RQ + h * 128 + 32 * ks + 8 * g);
    unsigned long long yq[8], gq[8];
#pragma unroll
    for (int mt = 0; mt < 8; ++mt) { yq[mt] = *(const unsigned long long*)(pYR + m * 512 + h * 128 + 16 * mt + 4 * g); gq[mt] = *(const unsigned long long*)(pP + m * INP + PC_RG + h * 128 + 16 * mt + 4 * g); }
    const float lgf = -fabsf(inp(I_RDEC)[layer * 8 + h]), lgb = -fabsf(inp(I_RDEC)[layer * 8 + 4 + h]);
    __syncthreads();
    s0.store(T0, TSR, tid); s1.store(T1, TSR, tid);
    __syncthreads();
    f32x4 af[8], ab[8]; zero_acc(af); zero_acc(ab);
    mma_xt<8>(af, T0, TSR, qf, lane); mma_xt<8>(ab, T1, TSR, qf, lane);
    const float qfac = __expf(lgf * (float)(i + 1)) * scale, qbac = __expf(lgb * (float)(128 - i)) * scale;
    f32x4 y[8]; float sm = 0.f;
#pragma unroll
    for (int mt = 0; mt < 8; ++mt) { const unsigned long long yw = yq[mt]; const unsigned y0 = (unsigned)yw, y1 = (unsigned)(yw >> 32);
        y[mt] = (f32x4){bflo(y0), bfhi(y0), bflo(y1), bfhi(y1)} + af[mt] * qfac + ab[mt] * qbac; sm += (y[mt][0] + y[mt][1]) + (y[mt][2] + y[mt][3]); }
    sm += __shfl_xor(sm, 16); sm += __shfl_xor(sm, 32);
    const float mu = sm * (1.0f / 128.0f); float vs = 0.f;
#pragma unroll
    for (int mt = 0; mt < 8; ++mt) { y[mt] = y[mt] - mu; vs += (y[mt][0] * y[mt][0] + y[mt][1] * y[mt][1]) + (y[mt][2] * y[mt][2] + y[mt][3] * y[mt][3]); }
    vs += __shfl_xor(vs, 16); vs += __shfl_xor(vs, 32);
    const float rstd = rsq(vs * (1.0f / 128.0f) + EPS);
    const float* nw = inp(I_RNW) + layer * 512 + h * 128;
#pragma unroll
    for (int mt = 0; mt < 8; ++mt) { const int e = 16 * mt + 4 * g; const f32x4 wv = *(const f32x4*)(nw + e);
        const unsigned long long gt = gq[mt]; const unsigned g0 = (unsigned)gt, g1 = (unsigned)(gt >> 32);
        const f32x4 o = y[mt] * rstd * wv;
        *(unsigned long long*)(pA + m * D + h * 128 + e) = (unsigned long long)pk2(o[0] * silu(bflo(g0)), o[1] * silu(bfhi(g0))) | ((unsigned long long)pk2(o[2] * silu(bflo(g1)), o[3] * silu(bfhi(g1))) << 32); }
}
__device__ __forceinline__ void m4_ssd_unit(Frame& F, int layer, int cr, int flags = 7) {
    const int tid = launder(F.tid), lane = tid & 63, w = __builtin_amdgcn_readfirstlane(tid >> 6), r = lane & 15, g = lane >> 4;
    const float* const pCUMF = wsf(F, WS_CUMF); const float* const pRCUMB = wsf(F, WS_RCUMB); const bf16* const pYS = wsb(F, WS_YS); const bf16* const pSSB = wsb(F, WS_SSB);
    bf16* const pA = wsb(F, WS_A); const bf16* const pP = wsb(F, WS_PH); const bf16* const pSX = wsb(F, WS_SX); const bf16* const pSC = wsb(F, WS_SC);
    const float* const nw = inp(I_SNW) + layer * 1024; const float* const dskp = inp(I_DSKIP) + layer * 16;
    const size_t m = (size_t)cr * 128 + 16 * w + r;
    typedef unsigned long long u64;
    constexpr int HB = 4 * 64 * TSR;
    v4u sr[8];
    const bf16* sbase = pSSB + (size_t)(cr * 16) * 2 * 8192 + (size_t)tid * 8;
#define M4_RHO(p) (16 * (2 * ((p) >> 5) + (((p) >> 2) & 1)) + 4 * (((p) >> 3) & 3) + ((p) & 3))
#define M4_COL(mt) (32 * ((mt) >> 1) + 8 * g + 4 * ((mt) & 1))
#define M4_STAGE_LD(step) _Pragma("unroll") for (int k = 0; k < 8; ++k) sr[k] = *(const v4u*)(sbase + (size_t)(step) * 32768 + (size_t)k * 4096)
#define M4_STAGE_ST(buf) _Pragma("unroll") for (int k = 0; k < 8; ++k) { const int c = tid + 512 * k; *(LAS v4u*)(F.lds + (buf) * HB + (c >> 10) * (64 * TSR) + M4_RHO((c >> 4) & 63) * TSR + ((c & 15) << 4)) = sr[k]; }
    u64 yq[2][4], xq[2][4], zq[2][4]; float cfq[2], cbq[2], dq[2];
#define M4_EPI_LD(step) _Pragma("unroll") for (int j = 0; j < 2; ++j) { const int hh_ = 2 * (step) + j; \
        _Pragma("unroll") for (int mt = 0; mt < 4; ++mt) { const int c = hh_ * 64 + M4_COL(mt); yq[j][mt] = *(const u64*)(pYS + m * 1024 + c); xq[j][mt] = *(const u64*)(pSX + m * 1024 + c); \
            zq[j][mt] = *(const u64*)(pP + m * INP + PC_Z + c); } \
        cfq[j] = pCUMF[m * 16 + hh_]; cbq[j] = pRCUMB[m * 16 + hh_]; dq[j] = dskp[hh_]; }
    const int s0 = cr & 7;
    M4_STAGE_LD(s0); M4_EPI_LD(s0);
    __syncthreads();
    M4_STAGE_ST(0);
    __syncthreads();
    bf16x8 cf[4]; float ssq = 0.f;
    for (int s = 0; s < 8; ++s) { const int sp = (s + s0) & 7, spn = (s + 1 + s0) & 7;
        if (s == 0 || (sp & 3) == 0) {
#pragma unroll
            for (int ks = 0; ks < 4; ++ks) cf[ks] = *(const bf16x8*)(pSC + m * 256 + (sp >> 2) * 128 + 32 * ks + 8 * g); }
        if (s < 7) { M4_STAGE_LD(spn); }
        ldsp T = F.lds + (s & 1) * HB;
        f32x4 acc[2][2][4];
#pragma unroll
        for (int j = 0; j < 2; ++j)
#pragma unroll
            for (int dir = 0; dir < 2; ++dir) { zero_acc(acc[j][dir]); if (flags & 1) mma_xt<4>(acc[j][dir], T + (2 * j + dir) * (64 * TSR), TSR, cf, lane); }
        if (flags & 2)
#pragma unroll
        for (int j = 0; j < 2; ++j) { const float ef = __builtin_amdgcn_exp2f(cfq[j]), eb = __builtin_amdgcn_exp2f(cbq[j]), dsk = dq[j];
#pragma unroll
            for (int mt = 0; mt < 4; ++mt) { const int c = (2 * sp + j) * 64 + M4_COL(mt);
                const unsigned x0 = (unsigned)xq[j][mt], x1 = (unsigned)(xq[j][mt] >> 32), z0 = (unsigned)zq[j][mt], z1 = (unsigned)(zq[j][mt] >> 32), y0 = (unsigned)yq[j][mt], y1 = (unsigned)(yq[j][mt] >> 32);
                f32x4 y = (f32x4){bflo(y0), bfhi(y0), bflo(y1), bfhi(y1)} + acc[j][0][mt] * ef + acc[j][1][mt] * eb;
                y[0] = (y[0] + dsk * bflo(x0)) * silu(bflo(z0)); y[1] = (y[1] + dsk * bfhi(x0)) * silu(bfhi(z0)); y[2] = (y[2] + dsk * bflo(x1)) * silu(bflo(z1)); y[3] = (y[3] + dsk * bfhi(x1)) * silu(bfhi(z1));
                ssq += (y[0] * y[0] + y[1] * y[1]) + (y[2] * y[2] + y[3] * y[3]);
                *(u64*)(pA + m * D + 1024 + c) = (u64)pk2(y[0], y[1]) | ((u64)pk2(y[2], y[3]) << 32); } }
        if (s < 7) { M4_EPI_LD(spn); M4_STAGE_ST((s + 1) & 1); }
        __syncthreads();
    }
#undef M4_RHO
#undef M4_STAGE_LD
#undef M4_STAGE_ST
#undef M4_EPI_LD
    ssq += __shfl_xor(ssq, 16); ssq += __shfl_xor(ssq, 32);
    const float rs = rsq(ssq * (1.0f / 1024.0f) + EPS);
    if (flags & 4)
#pragma unroll
    for (int bq = 0; bq < 4; ++bq) { u64 v[16]; f32x4 nv[16];
#pragma unroll
        for (int k = 0; k < 16; ++k) { const int c = (4 * bq + (k >> 2)) * 64 + M4_COL(k & 3); v[k] = *(const u64*)(pA + m * D + 1024 + c); nv[k] = *(const f32x4*)(nw + c); }
#pragma unroll
        for (int k = 0; k < 16; ++k) { const unsigned v0 = (unsigned)v[k], v1 = (unsigned)(v[k] >> 32); const f32x4 sc = nv[k] * rs;
            *(u64*)(pA + m * D + 1024 + (4 * bq + (k >> 2)) * 64 + M4_COL(k & 3)) = (u64)pk2(bflo(v0) * sc[0], bfhi(v0) * sc[1]) | ((u64)pk2(bflo(v1) * sc[2], bfhi(v1) * sc[3]) << 32); } }
#undef M4_COL
}
#if defined(PROBE_SEG)
#define SEG_BEGIN(id) unsigned long long segt0_##id = 0; if ((PROBE_SEG >> (id)) & 1) segt0_##id = __builtin_amdgcn_s_memrealtime();
#define SEG_END(id) if ((PROBE_SEG >> (id)) & 1) { __syncthreads(); const unsigned long long t1_ = __builtin_amdgcn_s_memrealtime(); while (__builtin_amdgcn_s_memrealtime() - t1_ < t1_ - segt0_##id) __builtin_amdgcn_s_sleep(16); __syncthreads(); }
#else
#define SEG_BEGIN(id)
#define SEG_END(id)
#endif
__device__ __forceinline__ void ph_m4(Frame& F, int layer, bool ctx_out, int which = 3) {
    const int bid = opaque_s(F.bid);
    const int ncr = ctx_out ? NCR : 128;
    if (bid < ncr) { if (which & 1) {
#ifdef PROBE_M4FLAGS
        for (int rep_ = 0; rep_ < 4; ++rep_) m4_ssd_unit(F, layer, bid, opaque_s(PROBE_M4FLAGS));
#endif
        SEG_BEGIN(0) m4_ssd_unit(F, layer, bid); SEG_END(0) } }
    else if (which & 2) { SEG_BEGIN(1) for (int u = bid - ncr; u < ncr * 4; u += F.G - ncr) m4_ret_unit(F, layer, u >> 2, u & 3); SEG_END(1) }
    __syncthreads();
    SEG_BEGIN(2)
    if (ctx_out && which == 3) convert_set(F, layer + 1, false, ncr, 1);
    SEG_END(2)
}

constexpr int PH_PER_LAYER = 13, PH_TOTAL = 3 + NLAYER * PH_PER_LAYER;
__global__ void __launch_bounds__(NTHR, 2) fwd_kernel(Args args) {
    extern __shared__ __attribute__((aligned(16))) unsigned char lds_raw[];
    Frame F;
    F.lds = (ldsp)lds_raw; F.MISC = (volatile LAS unsigned*)(F.lds + MISC_OFF);
    F.tid = threadIdx.x; F.lane = F.tid & 63; F.wave = __builtin_amdgcn_readfirstlane(F.tid >> 6); F.G = gridDim.x; F.bid = blockIdx.x;
    F.out = args.out; unsigned char* ws = args.ws; F.ws = ws;
    for (int u = F.tid; u < (LDS_BYTES - MISC_OFF) / 4; u += NTHR) ((LAS unsigned*)(F.lds + MISC_OFF))[u] = 0u;
    __syncthreads();
    const int lo = args.ph_lo, hi = args.ph_hi;
    XcdBarrier bar; bar.bar = (unsigned*)(ws + WS_CTL) + CW_BAR; bar.x = 0; bar.st = nullptr;
    if (hi - lo > 1) bar = xcd_barrier_post((unsigned*)(ws + WS_CTL) + CW_BAR, F.MISC + 8);
#define IN(k) ((unsigned)(opaque_s(k) - lo) < (unsigned)(hi - lo))
#if defined(PROBE_REP) && (PROBE_REP & 8)
#define PROBE_ROWS(x) x __syncthreads();
#else
#define PROBE_ROWS(x)
#endif
#if defined(PROBE_SPIN)
    unsigned long long tprev_ = __builtin_amdgcn_s_memrealtime();
#define SEAM(k) do { if (IN(k) && IN((k) + 1)) xcd_barrier(bar); \
        if (((unsigned long long)(PROBE_SPIN) >> (k)) & 1ull) { const unsigned long long t1_ = __builtin_amdgcn_s_memrealtime(); \
            while (__builtin_amdgcn_s_memrealtime() - t1_ < t1_ - tprev_) __builtin_amdgcn_s_sleep(16); __syncthreads(); } \
        tprev_ = __builtin_amdgcn_s_memrealtime(); } while (0)
#else
#define SEAM(k) do { if (IN(k) && IN((k) + 1)) xcd_barrier(bar); } while (0)
#endif

    if (IN(0)) { ph_adaln_partial(F); convert_set(F, 0, false, 0);
    }
    SEAM(0);
    if (IN(1)) ph_mod_reduce(F);
    SEAM(1);
    if (IN(2)) ph_rows<false, false>(F, M, inp(I_X), inp(I_CTX), nullptr, nullptr, nullptr, nullptr, nullptr, 0, nullptr, 0.f, wsb(F, WS_A), wsf(F, WS_MOD), 0, inp(I_NORMW));
    SEAM(2);
    for (int layer = 0; layer < NLAYER; ++layer) {
        const int pb = 3 + layer * PH_PER_LAYER; const bool last = layer == NLAYER - 1; const int Mrows = last ? ML : M;
#define modL (wsf(F, WS_MOD) + (size_t)layer * 5 * NMODC)
#define nw (inp(I_NORMW) + (size_t)layer * 6 * D)
        if (IN(pb + 0)) { pg8::Gemm gm{wsb(F, WS_A), wsb(F, WS_WGU1), D, D}; pg8::StaticOrder S; S.init(M, NGU, D, F.G, opaque_s(F.bid)); pg8::EpiSwiGLU E{wsb(F, WS_PH), DFF};
            pg8::gemm_phase<pg8::EpiSwiGLU, pg8::StaticOrder, true, true>(F.lds + RING_OFF, gm, S, E);
#if defined(PROBE_REP) && (PROBE_REP & 4)
            __syncthreads(); pg8::gemm_phase<pg8::EpiSwiGLU, pg8::StaticOrder, true, true>(F.lds + RING_OFF, gm, S, E);
#endif
        }
        if (IN(pb + 0)) convert_set(F, layer, true, (M / 256) * (NGU / 256) % F.G, 3);
        SEAM(pb + 0);
        if (IN(pb + 1)) { pg8::Gemm gm{wsb(F, WS_PH), wsb(F, WS_WD1), DFF, DFF}; pg8::StaticOrder S; S.init(ML, D, DFF, F.G, opaque_s(F.bid), MC, KSPLIT); pg8::EpiYbf16 E{wsb(F, WS_Y), D, wsb(F, WS_YP), ML, MC};
            pg8::gemm_phase<pg8::EpiYbf16, pg8::StaticOrder, true, true>(F.lds + RING_OFF, gm, S, E);
#if defined(PROBE_REP) && (PROBE_REP & 128)
            __syncthreads(); pg8::gemm_phase<pg8::EpiYbf16, pg8::StaticOrder, true, true>(F.lds + RING_OFF, gm, S, E);
#endif
        }
        if (IN(pb + 1)) convert_set(F, layer, true, (MC / 256) * (D / 256) * KSPLIT, 2);
        SEAM(pb + 1);
        if (IN(pb + 2)) { bf16* xb = wsb(F, WS_XB);
            if (layer == 0) ph_rows<false, true>(F, M, inp(I_X), inp(I_CTX), xb, xb + (size_t)ML * D, wsb(F, WS_Y), wsb(F, WS_YP), modL, 2, nw + D, 0.5f, wsb(F, WS_A), modL, 3, nw + 2 * D);
            else ph_rows<true, true>(F, M, xb, xb + (size_t)ML * D, xb, xb + (size_t)ML * D, wsb(F, WS_Y), wsb(F, WS_YP), modL, 2, nw + D, 0.5f, wsb(F, WS_A), modL, 3, nw + 2 * D); }
        SEAM(pb + 2);
        if (IN(pb + 3)) { pg8::Gemm gm{wsb(F, WS_A), wsb(F, WS_WIN), D, D}; pg8::StaticOrder S; S.init(M, INP, D, F.G, opaque_s(F.bid)); pg8::EpiProj E{wsb(F, WS_PH), INP};
            pg8::gemm_phase<pg8::EpiProj, pg8::StaticOrder, true, true>(F.lds + RING_OFF, gm, S, E);
#if defined(PROBE_REP) && (PROBE_REP & 256)
            __syncthreads(); pg8::gemm_phase<pg8::EpiProj, pg8::StaticOrder, true, true>(F.lds + RING_OFF, gm, S, E);
#endif
        }
        if (IN(pb + 3)) convert_set(F, layer, true, (M / 256) * (INP / 256) % F.G, 4);
        SEAM(pb + 3);
        if (IN(pb + 4)) { ph_dt_tasks(F, layer); ph_prep(F, layer);
#if defined(PROBE_REP) && (PROBE_REP & 1)
            ph_prep(F, layer);
#endif
        }
        SEAM(pb + 4);
        if (IN(pb + 5)) { ph_m2(F, layer, !last);
#if defined(PROBE_REP) && (PROBE_REP & 2)
            for (int rep_ = 0; rep_ < 4; ++rep_) ph_m2(F, layer, !last, PROBE_WHICH);
#endif
        }
        SEAM(pb + 5);
        if (IN(pb + 6)) {
#if defined(PROBE_REP) && (PROBE_REP & 32)
            ph_scan(F, layer); __syncthreads();
#endif
            ph_scan(F, layer); }
        SEAM(pb + 6);
        if (IN(pb + 7)) {
#if defined(PROBE_REP) && (PROBE_REP & 64)
            for (int rep_ = 0; rep_ < 4; ++rep_) { ph_m4(F, layer, !last, PROBE_WHICH); __syncthreads(); }
#endif
            ph_m4(F, layer, !last); }
        SEAM(pb + 7);
        if (IN(pb + 8)) { pg8::Gemm gm{wsb(F, WS_A), wsb(F, WS_WOUT), D, D}; pg8::StaticOrder S; S.init(ML, D, D, F.G, opaque_s(F.bid), last ? 0 : MC, KSPLIT); pg8::EpiYbf16 E{wsb(F, WS_Y), D, wsb(F, WS_YP), ML, MC};
            pg8::gemm_phase<pg8::EpiYbf16, pg8::StaticOrder, true, true>(F.lds + RING_OFF, gm, S, E); }
        SEAM(pb + 8);
        if (IN(pb + 9)) ph_rows<true, true>(F, Mrows, wsb(F, WS_XB), wsb(F, WS_XB) + (size_t)ML * D, wsb(F, WS_XB), wsb(F, WS_XB) + (size_t)ML * D, wsb(F, WS_Y), wsb(F, WS_YP), modL, 5, nw + 3 * D, 1.0f, wsb(F, WS_A), modL, 6, nw + 4 * D);
        SEAM(pb + 9);
        if (IN(pb + 10)) { pg8::Gemm gm{wsb(F, WS_A), wsb(F, WS_WGU2), D, D}; pg8::StaticOrder S; S.init(Mrows, NGU, D, F.G, opaque_s(F.bid)); pg8::EpiSwiGLU E{wsb(F, WS_PH), DFF};
            pg8::gemm_phase<pg8::EpiSwiGLU, pg8::StaticOrder, true, true>(F.lds + RING_OFF, gm, S, E); }
        if (IN(pb + 10) && !last) convert_set(F, layer + 1, false, (M / 256) * (NGU / 256) % F.G, 5);
        SEAM(pb + 10);
        if (IN(pb + 11)) { pg8::Gemm gm{wsb(F, WS_PH), wsb(F, WS_WD2), DFF, DFF}; pg8::StaticOrder S; S.init(ML, D, DFF, F.G, opaque_s(F.bid), last ? 0 : MC, KSPLIT); pg8::EpiYbf16 E{wsb(F, WS_Y), D, wsb(F, WS_YP), ML, MC};
            pg8::gemm_phase<pg8::EpiYbf16, pg8::StaticOrder, true, true>(F.lds + RING_OFF, gm, S, E); }
        if (IN(pb + 11) && !last) convert_set(F, layer + 1, false, (MC / 256) * (D / 256) * KSPLIT, 6);
        SEAM(pb + 11);
        if (IN(pb + 12)) {
            if (!last) { ph_rows<true, true>(F, M, wsb(F, WS_XB), wsb(F, WS_XB) + (size_t)ML * D, wsb(F, WS_XB), wsb(F, WS_XB) + (size_t)ML * D, wsb(F, WS_Y), wsb(F, WS_YP), modL, 8, nw + 5 * D, 0.5f, wsb(F, WS_A), modL + 5 * NMODC, 0, nw + 6 * D);
            }
            else ph_rows<true, false>(F, ML, wsb(F, WS_XB), wsb(F, WS_XB) + (size_t)ML * D, F.out, nullptr, wsb(F, WS_Y), nullptr, modL, 8, nw + 5 * D, 0.5f, nullptr, nullptr, 0, nullptr);
        }
        SEAM(pb + 12);
    }
#undef modL
#undef nw
#undef IN
#undef SEAM
}

#ifndef MK_SINGLE
#define MK_SINGLE 1
#endif
extern "C" void kernel_launch(void* const* d_in, const int* in_sizes, int n_in, void* d_out, int out_size, void* d_ws, size_t ws_size, hipStream_t stream) {
    static int grid = 0;
    if (grid == 0) {
        if (n_in != 22 || in_sizes[0] != ML * D || out_size != ML * D || ws_size < WS_END) { fprintf(stderr, "kernel_launch: unexpected shapes (n_in %d, in0 %d, out %d, ws %zu < %zu?); nothing launched\n", n_in, n_in > 0 ? in_sizes[0] : -1, out_size, ws_size, (size_t)WS_END); grid = -1; return; }
        int dev = 0, cus = 0, per_cu = 0;
        if (hipGetDevice(&dev) != hipSuccess || hipDeviceGetAttribute(&cus, hipDeviceAttributeMultiprocessorCount, dev) != hipSuccess) { grid = -1; return; }
        if (hipFuncSetAttribute((const void*)fwd_kernel, hipFuncAttributeMaxDynamicSharedMemorySize, LDS_BYTES) != hipSuccess) { fprintf(stderr, "kernel_launch: hipFuncSetAttribute failed\n"); grid = -1; return; }
        if (hipOccupancyMaxActiveBlocksPerMultiprocessor(&per_cu, (const void*)fwd_kernel, NTHR, LDS_BYTES) != hipSuccess || per_cu < 1) fprintf(stderr, "kernel_launch: occupancy query reports %d\n", per_cu);
        (void)hipGetLastError();
        grid = cus;
    }
    if (grid < 0) return;
    (void)hipMemsetAsync((char*)d_ws + WS_CTL, 0, CTL_ZERO_BYTES, stream);
    Args a{};
    for (int i = 0; i < 22; ++i) a.in[i] = (const float*)d_in[i];
    a.out = (float*)d_out; a.ws = (unsigned char*)d_ws;
#if MK_SINGLE
    a.ph_lo = 0; a.ph_hi = PH_TOTAL;
    hipLaunchKernelGGL(fwd_kernel, dim3(grid), dim3(NTHR), LDS_BYTES, stream, a);
#else
    for (int p = 0; p < PH_TOTAL; ++p) { a.ph_lo = p; a.ph_hi = p + 1; hipLaunchKernelGGL(fwd_kernel, dim3(grid), dim3(NTHR), LDS_BYTES, stream, a); }
#endif
}
```

```cpp
#include <hip/hip_runtime.h>
#include <cstdio>
#include <cstdint>
#include <cmath>
namespace pg8 {
#define PG8_LAS __attribute__((address_space(3)))
typedef unsigned short bf16_t;
typedef short bf16x8 __attribute__((ext_vector_type(8)));
typedef float f32x4 __attribute__((ext_vector_type(4)));
typedef unsigned u32x4 __attribute__((ext_vector_type(4)));
constexpr int BM = 256, BK = 64, HALF = 128, HTB = HALF * BK * 2  , STAGE_BYTES = 8 * HTB, NXCD = 8, WGM = 4;

#ifndef PG8_SWZ128
#define PG8_SWZ128 0
#endif
#if PG8_SWZ128
__host__ __device__ __forceinline__ int lds_sw(int r) { return (r & 7) ^ ((r >> 3) & 1); }
__host__ __device__ __forceinline__ int lds_byte(int r, int c) { return (r >> 3) * 1024 + (r & 7) * 128 + ((((c >> 3) ^ lds_sw(r)) & 7) << 4) + (c & 7) * 2; }
__host__ __device__ __forceinline__ void stage_rc(int b, int& R, int& C) { R = (b >> 10) * 8 + ((b >> 7) & 7); C = ((((b >> 4) & 7) ^ lds_sw(R)) << 3) + ((b & 15) >> 1); }
#else
__host__ __device__ __forceinline__ int lds_byte(int r, int c) { const int st = (r >> 4) * 2 + (c >> 5), rr = r & 15, cc = c & 31, ob = rr * 64 + cc * 2; return st * 1024 + (ob ^ (((ob >> 9) & 1) << 5)); }
__host__ __device__ __forceinline__ void stage_rc(int b, int& R, int& C) { const int st = b / 1024, sb = b % 1024, swz = sb ^ (((sb >> 9) & 1) << 5); R = (st >> 1) * 16 + swz / 64; C = (st & 1) * 32 + (swz % 64) / 2; }
#endif
__host__ __device__ __forceinline__ int perm32(int rho) { const int n = rho >> 4, i = rho & 15; return 8 * (i >> 2) + 4 * n + (i & 3); }

struct Unit { int pm, pn, kt0, nt, part; };
struct Gemm { const bf16_t* A; const bf16_t* Bt; int lda, K; };

struct StaticOrder {
    int nM, nN, nwg, G, c, ntk, nMt, S;
    __host__ __device__ void init(int Mfull, int N, int K, int G_, int c_, int Mtail = 0, int S_ = 1) { nM = Mfull / BM; nN = N / BM; nwg = nM * nN; G = G_; c = c_; ntk = K / BK; nMt = Mtail / BM; S = S_; }
    __host__ __device__ bool next(int i, Unit& u) const {
        const long L = (long)i * G + c; int pm, pn, kt0 = 0, nt = ntk, part = -1;
        if (L >= nwg) { const int t = (int)(L - nwg); if (t >= nMt * nN * S) return false;
            const int s = t % S, q = t / S; pn = q % nN; pm = nM + q / nN; nt = ntk / S; kt0 = s * nt; part = s; }
        else { int wgid = (int)L; { const int q = nwg / NXCD, r = nwg % NXCD, xcd = wgid % NXCD, off = wgid / NXCD; wgid = (xcd < r ? xcd * (q + 1) : r * (q + 1) + (xcd - r) * q) + off; }
            const int nig = WGM * nN, gid = wgid / nig, fm = gid * WGM, gsz = (nM - fm) < WGM ? (nM - fm) : WGM;
            pm = fm + ((wgid % nig) % gsz); pn = (wgid % nig) / gsz; }
        u.pm = pm; u.pn = pn; u.kt0 = kt0; u.nt = nt; u.part = part; return true;
    }
    __device__ __forceinline__ void a_ready(const Unit&) const {}
    __device__ __forceinline__ void done(const Unit&) const {}
};


__device__ __forceinline__ unsigned cvt_pk_bf16(float lo, float hi) { unsigned r; asm volatile("v_cvt_pk_bf16_f32 %0, %1, %2" : "=v"(r) : "v"(lo), "v"(hi)); return r; }
__device__ __forceinline__ float silu_f(float x) { return x * __builtin_amdgcn_rcpf(1.0f + __builtin_amdgcn_exp2f(x * -1.44269504089f)); }

struct EpiF32 {
    static constexpr bool PERM = false, AFTER_DRAIN = false;
    float* C; int ldc; float* Cpart; int tail_row0, tail_rows;
    __device__ __forceinline__ void operator()(const f32x4 (&acc)[2][2][4][2], const Unit& u, int wr, int wc, int fr, int fq) const {
        int row0 = u.pm * BM + wr * 64 + fr; const int col0 = u.pn * BM + wc * 32 + 4 * fq; float* base = C;
        if (u.part >= 0) { row0 -= tail_row0; base = Cpart + (size_t)u.part * tail_rows * ldc; }
#pragma unroll
        for (int ai = 0; ai < 2; ++ai)
#pragma unroll
            for (int m = 0; m < 4; ++m) { float* rowp = base + (size_t)(row0 + ai * HALF + m * 16) * ldc + col0;
#pragma unroll
                for (int bj = 0; bj < 2; ++bj)
#pragma unroll
                    for (int n = 0; n < 2; ++n) *(f32x4*)(rowp + bj * HALF + n * 16) = acc[ai][bj][m][n]; }
    }
};
struct EpiYbf16 {
    static constexpr bool PERM = true, AFTER_DRAIN = false;
    bf16_t* C; int ldc; bf16_t* Cpart; int tail_row0, tail_rows;
    __device__ __forceinline__ void operator()(const f32x4 (&acc)[2][2][4][2], const Unit& u, int wr, int wc, int fr, int fq) const {
        int row0 = u.pm * BM + wr * 64 + fr; const int col0 = u.pn * BM + wc * 32 + 8 * fq; bf16_t* base = C;
        if (u.part >= 0) { row0 -= tail_row0; base = Cpart + (size_t)u.part * tail_rows * ldc; }
#pragma unroll
        for (int ai = 0; ai < 2; ++ai)
#pragma unroll
            for (int m = 0; m < 4; ++m) { bf16_t* rowp = base + (size_t)(row0 + ai * HALF + m * 16) * ldc + col0;
#pragma unroll
                for (int bj = 0; bj < 2; ++bj) { const f32x4 v0 = acc[ai][bj][m][0], v1 = acc[ai][bj][m][1];
                    u32x4 w; w.x = cvt_pk_bf16(v0[0], v0[1]); w.y = cvt_pk_bf16(v0[2], v0[3]); w.z = cvt_pk_bf16(v1[0], v1[1]); w.w = cvt_pk_bf16(v1[2], v1[3]);
                    *(u32x4*)(rowp + bj * HALF) = w; } }
    }
};
struct EpiSwiGLU {
    static constexpr bool PERM = true, AFTER_DRAIN = false;
    bf16_t* O; int ldc;
    __device__ __forceinline__ void operator()(const f32x4 (&acc)[2][2][4][2], const Unit& u, int wr, int wc, int fr, int fq) const {
        const int row0 = u.pm * BM + wr * 64 + fr, col0 = u.pn * HALF + wc * 32 + 8 * fq;
#pragma unroll
        for (int ai = 0; ai < 2; ++ai)
#pragma unroll
            for (int m = 0; m < 4; ++m) { bf16_t* rowp = O + (size_t)(row0 + ai * HALF + m * 16) * ldc + col0;
                const f32x4 g0 = acc[ai][0][m][0], g1 = acc[ai][0][m][1], u0 = acc[ai][1][m][0], u1 = acc[ai][1][m][1];
                u32x4 w; w.x = cvt_pk_bf16(silu_f(g0[0]) * u0[0], silu_f(g0[1]) * u0[1]); w.y = cvt_pk_bf16(silu_f(g0[2]) * u0[2], silu_f(g0[3]) * u0[3]);
                w.z = cvt_pk_bf16(silu_f(g1[0]) * u1[0], silu_f(g1[1]) * u1[1]); w.w = cvt_pk_bf16(silu_f(g1[2]) * u1[2], silu_f(g1[3]) * u1[3]);
                *(u32x4*)rowp = w; }
    }
};
struct EpiProj {
    static constexpr bool PERM = true, AFTER_DRAIN = false;
    bf16_t* O; int ldc;
    __device__ __forceinline__ void operator()(const f32x4 (&acc)[2][2][4][2], const Unit& u, int wr, int wc, int fr, int fq) const {
        const int row0 = u.pm * BM + wr * 64 + fr, col0 = u.pn * BM + wc * 32 + 8 * fq;
#pragma unroll
        for (int ai = 0; ai < 2; ++ai)
#pragma unroll
            for (int m = 0; m < 4; ++m) { const int row = row0 + ai * HALF + m * 16; bf16_t* rowp = O + (size_t)row * ldc + col0;
#pragma unroll
                for (int bj = 0; bj < 2; ++bj) { const f32x4 v0 = acc[ai][bj][m][0], v1 = acc[ai][bj][m][1];
                    u32x4 w; w.x = cvt_pk_bf16(v0[0], v0[1]); w.y = cvt_pk_bf16(v0[2], v0[3]); w.z = cvt_pk_bf16(v1[0], v1[1]); w.w = cvt_pk_bf16(v1[2], v1[3]);
                    *(u32x4*)(rowp + bj * HALF) = w; } }
    }
};

template <class Epi, class Sched, bool ALIGN_EPI = false, bool SP2 = false>
__device__ __forceinline__ void gemm_phase(PG8_LAS unsigned char* lds, const Gemm g, const Sched& S, const Epi& E) {
    int tid_ = threadIdx.x; asm volatile("" : "+v"(tid_)); const int tid = tid_, wid = __builtin_amdgcn_readfirstlane(tid >> 6), lane = tid & 63, wr = wid >> 2, wc = wid & 3, fr = lane & 15, fq = lane >> 4;
    const int K = g.K, lda = g.lda;
    unsigned voffA[2], voffB[2];
#pragma unroll
    for (int i = 0; i < 2; ++i) { int R, C; stage_rc(tid * 16 + i * 8192, R, C); const int Rb = Epi::PERM ? ((R & ~31) + perm32(R & 31)) : R;
        voffA[i] = (unsigned)(R * lda + C) * 2u; voffB[i] = (unsigned)(Rb * K + C) * 2u; }
    const size_t kstep = (size_t)(BK * 2);
    const size_t hstepB = (size_t)HALF * K * 2, hstepA = (size_t)HALF * lda * 2;
    const size_t tstepB = 2 * hstepB, tstepA = 2 * hstepA;
    const unsigned ldsw = (unsigned)wid * 1024u;
    const int aoffk[2] = {lds_byte(wr * 64 + fr, fq * 8), lds_byte(wr * 64 + fr, 32 + fq * 8)}, boffk[2] = {lds_byte(wc * 32 + fr, fq * 8), lds_byte(wc * 32 + fr, 32 + fq * 8)};
#define PG8_SA(b, h) (((b) * 2 + (h)) * HTB)
#define PG8_SB(b, h) ((4 + (b) * 2 + (h)) * HTB)
#define PG8_STAGE(bufoff, gbase, voff) do { _Pragma("unroll") for (int _i = 0; _i < 2; ++_i) \
        __builtin_amdgcn_global_load_lds((const unsigned*)((const char*)(gbase) + (voff)[_i]), (PG8_LAS unsigned*)(lds + (bufoff) + ldsw + _i * 8192), 16, 0, 0); } while (0)
#define PG8_LDA(dst, b, h) do { _Pragma("unroll") for (int m = 0; m < 4; ++m) _Pragma("unroll") for (int k = 0; k < 2; ++k) dst[m][k] = *(const PG8_LAS bf16x8*)(lds + PG8_SA(b, h) + aoffk[k] + m * 2048); } while (0)
#define PG8_LDB(dst, b, h) do { _Pragma("unroll") for (int n = 0; n < 2; ++n) _Pragma("unroll") for (int k = 0; k < 2; ++k) dst[n][k] = *(const PG8_LAS bf16x8*)(lds + PG8_SB(b, h) + boffk[k] + n * 2048); } while (0)
#define PG8_MMA(ai, bj, At, Bt) do { __builtin_amdgcn_s_setprio(1); _Pragma("unroll") for (int m = 0; m < 4; ++m) _Pragma("unroll") for (int n = 0; n < 2; ++n) _Pragma("unroll") for (int k = 0; k < 2; ++k) \
        acc[ai][bj][m][n] = __builtin_amdgcn_mfma_f32_16x16x32_bf16(Bt[n][k], At[m][k], acc[ai][bj][m][n], 0, 0, 0); __builtin_amdgcn_s_setprio(0); } while (0)
#define PG8_WAIT_V(n) asm volatile("s_waitcnt vmcnt(" #n ")" ::: "memory")
#define PG8_WAIT_L(n) asm volatile("s_waitcnt lgkmcnt(" #n ")" ::: "memory")
#define PG8_BAR __builtin_amdgcn_s_barrier()
#define PG8_SCHED __builtin_amdgcn_sched_barrier(0)
    Unit cur, nxt; int ui = 0;
    if (!S.next(0, cur)) return;
    f32x4 acc[2][2][4][2];
#pragma unroll
    for (int a = 0; a < 2; ++a)
#pragma unroll
        for (int b = 0; b < 2; ++b)
#pragma unroll
            for (int m = 0; m < 4; ++m)
#pragma unroll
                for (int n = 0; n < 2; ++n) acc[a][b][m][n] = (f32x4){0.f, 0.f, 0.f, 0.f};
    bf16x8 At[4][2], B0[2][2], B1[2][2];
    const char* cA = (const char*)g.A + (size_t)cur.pm * tstepA + (size_t)cur.kt0 * kstep; const char* cB = (const char*)g.Bt + (size_t)cur.pn * tstepB + (size_t)cur.kt0 * kstep;
    S.a_ready(cur);
    if constexpr (SP2) {
        PG8_STAGE(PG8_SB(0, 0), cB, voffB); PG8_STAGE(PG8_SB(0, 1), cB + hstepB, voffB); PG8_STAGE(PG8_SA(0, 0), cA, voffA); PG8_STAGE(PG8_SA(0, 1), cA + hstepA, voffA);
        if (wr == 1) PG8_BAR;
        PG8_WAIT_V(2); PG8_BAR;
        PG8_STAGE(PG8_SB(1, 0), cB + kstep, voffB); PG8_STAGE(PG8_SA(1, 0), cA + kstep, voffA); PG8_STAGE(PG8_SB(1, 1), cB + hstepB + kstep, voffB);
        PG8_WAIT_V(6); PG8_BAR;
    } else {
        PG8_STAGE(PG8_SB(0, 0), cB, voffB); PG8_STAGE(PG8_SA(0, 0), cA, voffA); PG8_STAGE(PG8_SB(0, 1), cB + hstepB, voffB); PG8_STAGE(PG8_SA(0, 1), cA + hstepA, voffA);
        if (wr == 1) PG8_BAR;
        PG8_WAIT_V(4); PG8_BAR;
        PG8_STAGE(PG8_SB(1, 0), cB + kstep, voffB); PG8_STAGE(PG8_SA(1, 0), cA + kstep, voffA); PG8_STAGE(PG8_SB(1, 1), cB + hstepB + kstep, voffB);
        PG8_WAIT_V(6); PG8_BAR;
    }
    for (;;) {
        const bool has_next = S.next(ui + 1, nxt);
        const char* nA = has_next ? (const char*)g.A + (size_t)nxt.pm * tstepA + (size_t)nxt.kt0 * kstep : cA; const char* nB = has_next ? (const char*)g.Bt + (size_t)nxt.pn * tstepB + (size_t)nxt.kt0 * kstep : cB;
        const int nt = cur.nt;
        for (int t = 0; t < nt; t += 2) {
            const bool last = (t == nt - 2);
            const char* a1 = cA + (size_t)(t + 1) * kstep;
            const char* a2 = last ? nA : cA + (size_t)(t + 2) * kstep; const char* b2 = last ? nB : cB + (size_t)(t + 2) * kstep;
            const char* a3 = a2 + kstep; const char* b3 = b2 + kstep;
            if (last && has_next) S.a_ready(nxt);
            if constexpr (SP2) {
            PG8_LDB(B0, 0, 0); PG8_LDB(B1, 0, 1); PG8_SCHED; PG8_LDA(At, 0, 0); PG8_STAGE(PG8_SA(1, 1), a1 + hstepA, voffA);
            PG8_WAIT_V(8); PG8_WAIT_L(0); PG8_BAR; PG8_MMA(0, 0, At, B0); PG8_MMA(0, 1, At, B1); PG8_BAR; PG8_SCHED;
            PG8_LDA(At, 0, 1); PG8_STAGE(PG8_SB(0, 0), b2, voffB); PG8_STAGE(PG8_SB(0, 1), b2 + hstepB, voffB); PG8_STAGE(PG8_SA(0, 0), a2, voffA);
            PG8_WAIT_V(8); PG8_WAIT_L(0); PG8_BAR; PG8_MMA(1, 0, At, B0); PG8_MMA(1, 1, At, B1); PG8_BAR; PG8_SCHED;
            PG8_LDB(B0, 1, 0); PG8_LDB(B1, 1, 1); PG8_SCHED; PG8_LDA(At, 1, 0); PG8_STAGE(PG8_SA(0, 1), a2 + hstepA, voffA);
            PG8_WAIT_V(8); PG8_WAIT_L(0); PG8_BAR; PG8_MMA(0, 0, At, B0); PG8_MMA(0, 1, At, B1); PG8_BAR; PG8_SCHED;
            PG8_LDA(At, 1, 1); PG8_STAGE(PG8_SB(1, 0), b3, voffB); PG8_STAGE(PG8_SB(1, 1), b3 + hstepB, voffB); PG8_STAGE(PG8_SA(1, 0), a3, voffA);
            PG8_WAIT_V(8); PG8_WAIT_L(0); PG8_BAR; PG8_MMA(1, 0, At, B0); PG8_MMA(1, 1, At, B1); PG8_BAR; PG8_SCHED;
            } else {
            PG8_LDB(B0, 0, 0); PG8_SCHED; PG8_LDA(At, 0, 0); PG8_STAGE(PG8_SA(1, 1), a1 + hstepA, voffA);
            PG8_WAIT_L(8); PG8_BAR; PG8_WAIT_L(0); PG8_MMA(0, 0, At, B0); PG8_BAR; PG8_SCHED;
            PG8_LDB(B1, 0, 1); PG8_STAGE(PG8_SB(0, 0), b2, voffB);
            PG8_BAR; PG8_WAIT_L(0); PG8_MMA(0, 1, At, B1); PG8_BAR;
            PG8_LDA(At, 0, 1); PG8_STAGE(PG8_SA(0, 0), a2, voffA);
            PG8_BAR; PG8_WAIT_L(0); PG8_MMA(1, 0, At, B0); PG8_BAR; PG8_SCHED;
            PG8_STAGE(PG8_SB(0, 1), b2 + hstepB, voffB);
            PG8_WAIT_V(6); PG8_BAR; PG8_MMA(1, 1, At, B1); PG8_BAR;
            PG8_LDB(B0, 1, 0); PG8_SCHED; PG8_LDA(At, 1, 0); PG8_STAGE(PG8_SA(0, 1), a2 + hstepA, voffA);
            PG8_WAIT_L(8); PG8_BAR; PG8_WAIT_L(0); PG8_MMA(0, 0, At, B0); PG8_BAR; PG8_SCHED;
            PG8_LDB(B1, 1, 1); PG8_STAGE(PG8_SB(1, 0), b3, voffB);
            PG8_BAR; PG8_WAIT_L(0); PG8_MMA(0, 1, At, B1); PG8_BAR;
            PG8_LDA(At, 1, 1); PG8_STAGE(PG8_SA(1, 0), a3, voffA);
            PG8_BAR; PG8_WAIT_L(0); PG8_MMA(1, 0, At, B0); PG8_BAR; PG8_SCHED;
            PG8_STAGE(PG8_SB(1, 1), b3 + hstepB, voffB);
            PG8_WAIT_V(6); PG8_BAR; PG8_MMA(1, 1, At, B1); PG8_BAR;
            }
        }
        if constexpr (ALIGN_EPI) { if (wr == 0) PG8_BAR; }
        if constexpr (!Epi::AFTER_DRAIN) { E(acc, cur, wr, wc, fr, fq); S.done(cur); }
        if (!has_next) break;
#pragma unroll
        for (int a = 0; a < 2; ++a)
#pragma unroll
            for (int b = 0; b < 2; ++b)
#pragma unroll
                for (int m = 0; m < 4; ++m)
#pragma unroll
                    for (int n = 0; n < 2; ++n) acc[a][b][m][n] = (f32x4){0.f, 0.f, 0.f, 0.f};
        cur = nxt; cA = nA; cB = nB; ++ui;
        if constexpr (ALIGN_EPI) { if (wr == 1) PG8_BAR; }
    }
    PG8_WAIT_V(0);
    if constexpr (!ALIGN_EPI) { if (wr == 0) PG8_BAR; }
    PG8_BAR;
    if constexpr (Epi::AFTER_DRAIN) { E.fused(acc, cur, wr, wc, fr, fq, lds, wid, lane); S.done(cur); }
#undef PG8_SA
#undef PG8_SB
#undef PG8_STAGE
#undef PG8_LDA
#undef PG8_LDB
#undef PG8_MMA
#undef PG8_WAIT_V
#undef PG8_WAIT_L
#undef PG8_BAR
#undef PG8_SCHED
}
}

constexpr int D = 2048, NB = 4, T = 4096, CL = 256, ML = NB * T, MC = NB * CL, M = ML + MC;
constexpr int DFF = 5632, NGU = 2 * DFF, INC = 5664, INP = 5632, NMODC = 9 * D;
constexpr int NCR = M / 128;
constexpr int NLAYER = 2, KSPLIT = 4;
constexpr float EPS = 1e-6f;
constexpr int NWAVES = 8, NTHR = 512;
constexpr int PC_RQ = 0, PC_RK = 512, PC_RV = 1024, PC_RG = 1536, PC_AQ = 2048, PC_AK = 2560, PC_AV = 2816, PC_Z = 3072, PC_XBC = 4096, PC_DT = 5632;

constexpr size_t MiB = 1u << 20;
constexpr size_t WS_CTL = 0, CTL_ZERO_BYTES = 1 * MiB;
constexpr size_t WS_MOD = 1 * MiB;
constexpr size_t WS_MODP = 2 * MiB;
constexpr size_t WS_WGU1 = 14 * MiB, WS_WD1 = 58 * MiB, WS_WGU2 = 80 * MiB, WS_WD2 = 124 * MiB, WS_WIN = 146 * MiB, WS_WOUT = 169 * MiB;
constexpr size_t WS_XC = 177 * MiB;
constexpr size_t WS_A = 185 * MiB;
constexpr size_t WS_PH = 253 * MiB;
constexpr size_t WS_Y = 449 * MiB;
constexpr size_t WS_XB = 517 * MiB;
constexpr size_t WS_DTRAW = 585 * MiB, WS_DT = 588 * MiB, WS_CUMF = 591 * MiB, WS_RCUMB = 593 * MiB;
constexpr size_t WS_AQ = 595 * MiB, WS_AK = 612 * MiB, WS_SX = 621 * MiB, WS_SB = 655 * MiB, WS_SC = 664 * MiB;
constexpr size_t WS_YR = 673 * MiB, WS_YS = 707 * MiB;
constexpr size_t WS_RS = 775 * MiB;
constexpr size_t WS_SS = 843 * MiB;
constexpr size_t WS_SDEC = 979 * MiB;
constexpr size_t WS_YP = 980 * MiB;
constexpr size_t WS_RSB = 1012 * MiB, WS_SSB = 1046 * MiB;
constexpr size_t WS_END = 1114 * MiB;
static_assert(WS_MODP + (size_t)2 * 16 * 5 * NMODC * 4 <= WS_WGU1 && WS_WGU1 + (size_t)NGU * D * 2 <= WS_WD1 && WS_WD1 + (size_t)D * DFF * 2 <= WS_WGU2 && WS_WIN + (size_t)INC * D * 2 <= WS_WOUT && WS_WOUT + (size_t)D * D * 2 <= WS_XC, "ws map 1");
static_assert(WS_XC + (size_t)MC * D * 4 <= WS_A && WS_A + (size_t)M * D * 2 <= WS_PH && WS_PH + (size_t)M * INP * 2 <= WS_Y && WS_Y + (size_t)M * D * 4 <= WS_DTRAW, "ws map 2");
static_assert(WS_DTRAW + (size_t)M * 32 * 4 <= WS_DT && WS_DT + (size_t)M * 32 * 4 <= WS_CUMF && WS_CUMF + (size_t)M * 16 * 4 <= WS_RCUMB && WS_RCUMB + (size_t)M * 16 * 4 <= WS_AQ, "ws map 3");
static_assert(WS_AQ + (size_t)M * 512 * 2 <= WS_AK && WS_AK + (size_t)M * 256 * 2 <= WS_SX && WS_SX + (size_t)M * 1024 * 2 <= WS_SB && WS_SB + (size_t)M * 256 * 2 <= WS_SC && WS_SC + (size_t)M * 256 * 2 <= WS_YR, "ws map 4");
static_assert(WS_YR + (size_t)M * 512 * 4 <= WS_YS && WS_YS + (size_t)M * 1024 * 4 <= WS_RS && WS_RS + (size_t)NCR * 8 * 16384 * 4 <= WS_SS && WS_SS + (size_t)NCR * 32 * 8192 * 4 <= WS_SDEC, "ws map 5");
constexpr int CW_BAR = 4096;

constexpr int RING_OFF = 0, RING_BYTES = 131072;
constexpr int TS = 272, TILE = 128 * TS, HTILE = 64 * TS;
constexpr int AUX_OFF = 143360;
constexpr int MISC_OFF = AUX_OFF + 16384;
constexpr int LDS_BYTES = MISC_OFF + 256;
static_assert(AUX_OFF >= RING_BYTES && AUX_OFF >= 4 * TILE && LDS_BYTES <= 163840, "LDS map");

#define GAS __attribute__((address_space(1)))
#define LAS __attribute__((address_space(3)))
typedef unsigned short bf16;
typedef unsigned v4u __attribute__((ext_vector_type(4)));
typedef float f32x4 __attribute__((ext_vector_type(4)));
typedef short bf16x8 __attribute__((ext_vector_type(8)));
typedef LAS unsigned char* ldsp;
__device__ __forceinline__ unsigned f2bf(float f) { unsigned u = __builtin_bit_cast(unsigned, f); return (u + 0x7fffu + ((u >> 16) & 1u)) >> 16; }
__device__ __forceinline__ unsigned cvtpk(float lo, float hi) { unsigned r; asm("v_cvt_pk_bf16_f32 %0, %1, %2" : "=v"(r) : "v"(lo), "v"(hi)); return r; }
__device__ __forceinline__ unsigned pk2(float lo, float hi) { return cvtpk(lo, hi); }
__device__ __forceinline__ float bf2f(unsigned b) { return __builtin_bit_cast(float, b << 16); }
__device__ __forceinline__ float bflo(unsigned w) { return __builtin_bit_cast(float, w << 16); }
__device__ __forceinline__ float bfhi(unsigned w) { return __builtin_bit_cast(float, w & 0xffff0000u); }
__device__ __forceinline__ float silu(float x) { return x * __builtin_amdgcn_rcpf(1.0f + __builtin_amdgcn_exp2f(x * -1.44269504089f)); }
__device__ __forceinline__ float rsq(float x) { return __builtin_amdgcn_rsqf(x); }
__device__ __forceinline__ float wave_sum(float v) {
#pragma unroll
    for (int o = 1; o < 64; o <<= 1) v += __shfl_xor(v, o);
    return v;
}
__device__ __forceinline__ float sum16(float v) { v += __shfl_xor(v, 1); v += __shfl_xor(v, 2); v += __shfl_xor(v, 4); v += __shfl_xor(v, 8); return v; }
__device__ __forceinline__ float max16(float v) { v = fmaxf(v, __shfl_xor(v, 1)); v = fmaxf(v, __shfl_xor(v, 2)); v = fmaxf(v, __shfl_xor(v, 4)); v = fmaxf(v, __shfl_xor(v, 8)); return v; }

__device__ __forceinline__ int launder(int x) { asm volatile("" : "+v"(x)); return x; }
__device__ __forceinline__ int opaque_s(int x) { asm volatile("" : "+s"(x)); return x; }
#define XB_TMO      128
#define XB_XCNT(j)  (256  + 64 * (j))
#define XB_XSUB(j)  (1280 + 64 * (j))
#define XB_XGEN(j)  (2304 + 64 * (j))
#define XB_TOP      3328
#define XB_TOPGEN   3392
#define XCD_BAR_WORDS 3456
#define XB_SPIN_CAP (1u << 18)

__device__ __forceinline__ unsigned xb_ld(unsigned* p)              { return __hip_atomic_load(p, __ATOMIC_RELAXED, __HIP_MEMORY_SCOPE_AGENT); }
__device__ __forceinline__ unsigned xb_add(unsigned* p, unsigned v) { return __hip_atomic_fetch_add(p, v, __ATOMIC_RELAXED, __HIP_MEMORY_SCOPE_AGENT); }
__device__ __forceinline__ unsigned xb_xcc_id() { return (unsigned)__builtin_amdgcn_s_getreg((3 << 11) | 20) & 0xFu; }
#define XB_SPIN(cond, bar) do { unsigned _sp = 0; while (cond) { __builtin_amdgcn_s_sleep(1); \
    if ((++_sp & 255u) == 0u) { if (xb_ld(&(bar)[XB_TMO])) break; if (_sp > XB_SPIN_CAP) { atomicAdd(&(bar)[XB_TMO], 1u); break; } } } } while (0)

struct XcdBarrier {
    unsigned* bar; unsigned x;
    volatile LAS unsigned* st;
};

__device__ __forceinline__ XcdBarrier xcd_barrier_post(unsigned* bar, volatile LAS unsigned* st) {
    XcdBarrier b; b.bar = bar; b.x = xb_xcc_id(); b.st = st;
    if (threadIdx.x == 0) (void)xb_add(&bar[XB_XCNT(b.x)], 1u);
    return b;
}
__device__ __forceinline__ void xcd_barrier_complete(unsigned* bar, unsigned x, unsigned& nloc, unsigned& nx) {
    const unsigned G = gridDim.x * gridDim.y * gridDim.z;
    unsigned sum, cnt, mine, sp = 0u;
    for (;;) {
        sum = 0u; cnt = 0u; mine = 0u;
#pragma unroll
        for (unsigned j = 0; j < 16; ++j) { const unsigned c = xb_ld(&bar[XB_XCNT(j)]); sum += c; cnt += (c > 0u) ? 1u : 0u; mine = (j == x) ? c : mine; }
        if (sum == G) break;
        __builtin_amdgcn_s_sleep(1);
        if ((++sp & 255u) == 0u) { if (xb_ld(&bar[XB_TMO])) break; if (sp > XB_SPIN_CAP) { atomicAdd(&bar[XB_TMO], 1u); break; } }
    }
    nloc = mine > 0u ? mine : 1u; nx = cnt > 0u ? cnt : 1u;
}

__device__ __forceinline__ void xcd_barrier(const XcdBarrier& b) {
    asm volatile("s_waitcnt vmcnt(0)" ::: "memory");
    __syncthreads();
    if (threadIdx.x == 0) {
        unsigned* bar = b.bar;
        __builtin_amdgcn_s_waitcnt(0);
        unsigned nloc = b.st[0], nx = b.st[1];
        if (nloc == 0u) { unsigned xo = b.x; asm volatile("" : "+s"(xo)); xcd_barrier_complete(bar, xo, nloc, nx); b.st[0] = nloc; b.st[1] = nx; }
        const unsigned old = xb_add(&bar[XB_XSUB(b.x)], 1u);
        const unsigned gen = old / nloc;
        if (old + 1u == (gen + 1u) * nloc) {
            __builtin_amdgcn_fence(__ATOMIC_RELEASE, "agent");
            asm volatile("s_waitcnt vmcnt(0)" ::: "memory");
            const unsigned og = xb_add(&bar[XB_TOP], 1u);
            const unsigned tg = og / nx;
            if (og + 1u == (tg + 1u) * nx) xb_add(&bar[XB_TOPGEN], 1u);
            else XB_SPIN(xb_ld(&bar[XB_TOPGEN]) == tg, bar);
            __builtin_amdgcn_fence(__ATOMIC_ACQUIRE, "agent");
            xb_add(&bar[XB_XGEN(b.x)], 1u);
            asm volatile("s_waitcnt vmcnt(0)" ::: "memory");
        } else {
            XB_SPIN(xb_ld(&bar[XB_XGEN(b.x)]) == gen, bar);
            __builtin_amdgcn_fence(__ATOMIC_ACQUIRE, "agent");
            asm volatile("s_waitcnt vmcnt(0)" ::: "memory");
        }
    }
    __syncthreads();
}

struct Args { const float* in[22]; float* out; unsigned char* ws; int ph_lo, ph_hi; };
struct Frame {
    ldsp lds;
    volatile LAS unsigned* MISC;
    int tid, lane, wave, G, bid;
    float* out;
    unsigned char* ws;
};
__device__ __forceinline__ const float* inp(int i) { const __attribute__((address_space(4))) Args* ka = (const __attribute__((address_space(4))) Args*)__builtin_amdgcn_kernarg_segment_ptr(); return ka->in[opaque_s(i)]; }
__device__ __forceinline__ float* wsf(const Frame& F, size_t off) { return (float*)(F.ws + ((size_t)(unsigned)opaque_s((int)(off >> 20)) << 20)); }
__device__ __forceinline__ bf16* wsb(const Frame& F, size_t off) { return (bf16*)(F.ws + ((size_t)(unsigned)opaque_s((int)(off >> 20)) << 20)); }
enum { I_X = 0, I_C, I_CTX, I_CCTX, I_WADA, I_BADA, I_NORMW, I_GU1, I_D1, I_GU2, I_D2, I_WIN, I_WOUT, I_RDEC, I_RNW, I_SINK, I_CONVW, I_CONVB, I_ALOG, I_DTB, I_DSKIP, I_SNW };

struct TrItem { const float* W; bf16* WT; int K, N, drow0, k0, n0; };
__device__ __forceinline__ void tr_load(const TrItem& t, f32x4 (&v)[16], int lane) {
    const int c4 = 4 * (lane & 15), kq = lane >> 4; const bool okc = t.n0 + c4 < t.N;
#pragma unroll
    for (int i = 0; i < 16; ++i) { v[i] = (f32x4){0.f, 0.f, 0.f, 0.f}; if (okc) v[i] = *(const f32x4*)(t.W + (size_t)(t.k0 + 4 * i + kq) * t.N + t.n0 + c4); }
}
__device__ __forceinline__ void tr_finish(const TrItem& t, const f32x4 (&v)[16], LAS float* scr, int lane) {
    const int c4 = 4 * (lane & 15), kq = lane >> 4;
#pragma unroll
    for (int i = 0; i < 16; ++i) { LAS float* d = scr + (4 * i + kq) * 65 + c4; d[0] = v[i].x; d[1] = v[i].y; d[2] = v[i].z; d[3] = v[i].w; }
    asm volatile("s_waitcnt lgkmcnt(0)" ::: "memory");
    const int c = lane & 7;
#pragma unroll
    for (int j = 0; j < 8; ++j) { const int n = (lane >> 3) + 8 * j; const LAS float* s = scr + (8 * c) * 65 + n;
        v4u o; o.x = pk2(s[0 * 65], s[1 * 65]); o.y = pk2(s[2 * 65], s[3 * 65]); o.z = pk2(s[4 * 65], s[5 * 65]); o.w = pk2(s[6 * 65], s[7 * 65]);
        if (t.n0 + n < t.N) *(v4u*)(t.WT + (size_t)(t.drow0 + n) * t.K + t.k0 + 8 * c) = o; }
    asm volatile("s_waitcnt lgkmcnt(0)" ::: "memory");
}
__device__ __forceinline__ void convert_set(Frame& F, int layer, bool second, int wg0, int part = 0) {
    const int tid = launder(F.tid), lane = tid & 63, wave = __builtin_amdgcn_readfirstlane(tid >> 6), bid = opaque_s(F.bid);
    if (bid < wg0) return;
    LAS float* scr = (LAS float*)(F.lds + wave * 16640);
    const int gw = (bid - wg0) * NWAVES + wave, NGW = (F.G - wg0) * NWAVES;
    constexpr int I_GU = (D / 64) * (NGU / 64), I_DN = (DFF / 64) * (D / 64), I_IN = (D / 64) * ((INC + 63) / 64), I_OUT = (D / 64) * (D / 64);
    const float* gu = inp(second ? I_GU2 : I_GU1) + (size_t)layer * D * NGU; const float* dn = inp(second ? I_D2 : I_D1) + (size_t)layer * DFF * D;
    const float* sq = second ? inp(I_WOUT) + (size_t)layer * D * D : inp(I_WIN) + (size_t)layer * D * INC;
    bf16* const pGU = wsb(F, second ? WS_WGU2 : WS_WGU1); bf16* const pDN = wsb(F, second ? WS_WD2 : WS_WD1); bf16* const pSQ = wsb(F, second ? WS_WOUT : WS_WIN);
    const int nsq = second ? I_OUT : I_IN, nsqb = second ? D / 64 : (INC + 63) / 64, Nsq = second ? D : INC;
    const int it0 = part == 2 || part == 5 ? I_GU : part == 4 ? I_GU / 2 : part == 6 ? I_GU + I_DN : 0;
    const int it1 = part == 1 || part == 4 ? I_GU : part == 3 ? I_GU / 2 : part == 5 ? I_GU + I_DN : I_GU + I_DN + nsq;
#define TR_DESCRIBE(it_, t_) do { int r_ = (it_); \
        if (r_ < I_GU) { const int kb = r_ / (NGU / 64), nb = r_ % (NGU / 64), n0 = 64 * nb, half = n0 >= DFF ? 1 : 0, c0 = n0 - half * DFF;     \
            t_.W = gu; t_.WT = pGU; t_.K = D; t_.N = NGU; t_.drow0 = 256 * (c0 >> 7) + 128 * half + (c0 & 127); t_.k0 = 64 * kb; t_.n0 = n0; } \
        else if (r_ < I_GU + I_DN) { r_ -= I_GU; const int kb = r_ / (D / 64), nb = r_ % (D / 64); t_.W = dn; t_.WT = pDN; t_.K = DFF; t_.N = D; t_.drow0 = 64 * nb; t_.k0 = 64 * kb; t_.n0 = 64 * nb; } \
        else { r_ -= I_GU + I_DN; const int kb = r_ / nsqb, nb = r_ % nsqb; t_.W = sq; t_.WT = pSQ; t_.K = D; t_.N = Nsq; t_.drow0 = 64 * nb; t_.k0 = 64 * kb; t_.n0 = 64 * nb; } } while (0)
    TrItem tc, tn; f32x4 vc[16], vn[16];
    int it = it0 + gw;
    if (it < it1) { TR_DESCRIBE(it, tc); tr_load(tc, vc, lane); }
    for (; it < it1; it += NGW) {
        const bool more = it + NGW < it1;
        if (more) { TR_DESCRIBE(it + NGW, tn); tr_load(tn, vn, lane); }
        tr_finish(tc, vc, scr, lane);
        if (more) { tc = tn;
#pragma unroll
            for (int i = 0; i < 16; ++i) vc[i] = vn[i]; }
    }
#undef TR_DESCRIBE
    __syncthreads();
}
__device__ __forceinline__ void ph_convert_weights(Frame& F, int layer) { convert_set(F, layer, false, 0); convert_set(F, layer, true, 0); }
__device__ __forceinline__ void ph_adaln_partial(Frame& F) {
    const int tid = launder(F.tid), lane = tid & 63, wave = __builtin_amdgcn_readfirstlane(tid >> 6), bid = opaque_s(F.bid); (void)lane; (void)wave; (void)bid;
    float* const pMODP = wsf(F, WS_MODP);    const float* const iC = inp(I_C);    const float* const iCCTX = inp(I_CCTX);    const float* const iWADA = inp(I_WADA);
    LAS float* s = (LAS float*)F.lds;
    for (int i = tid; i < 5 * D; i += NTHR) { const int v = i / D, k = i % D; const float c = (v < 4) ? iC[v * D + k] : iCCTX[k]; s[i] = c / (1.0f + expf(-c)); }
    __syncthreads();
    const int gw = bid * NWAVES + wave, NGW = F.G * NWAVES;
    constexpr int NBLK = NMODC / 256;
    for (int u = gw; u < 2 * NBLK * 16; u += NGW) {
        const int layer = u / (NBLK * 16), r = u % (NBLK * 16), ks = r % 16, nb = r / 16, n0 = nb * 256 + 4 * lane;
        const float* W = iWADA + (size_t)layer * D * NMODC + (size_t)(ks * 128) * NMODC + n0;
        f32x4 a0 = {0.f, 0.f, 0.f, 0.f}, a1 = a0, a2 = a0, a3 = a0, a4 = a0;
#pragma unroll 8
        for (int kk = 0; kk < 128; ++kk) { const f32x4 w = *(const f32x4*)(W + (size_t)kk * NMODC); const int k = ks * 128 + kk;
            a0 += w * s[k]; a1 += w * s[D + k]; a2 += w * s[2 * D + k]; a3 += w * s[3 * D + k]; a4 += w * s[4 * D + k]; }
        float* o = pMODP + ((size_t)(layer * 16 + ks) * 5) * NMODC + n0;
        *(f32x4*)(o) = a0; *(f32x4*)(o + NMODC) = a1; *(f32x4*)(o + 2 * NMODC) = a2; *(f32x4*)(o + 3 * NMODC) = a3; *(f32x4*)(o + 4 * NMODC) = a4;
    }
    __syncthreads();
}
__device__ __forceinline__ void ph_mod_reduce(Frame& F) {
    const int tid = launder(F.tid), lane = tid & 63, wave = __builtin_amdgcn_readfirstlane(tid >> 6), bid = opaque_s(F.bid); (void)lane; (void)wave; (void)bid;
    float* const pMOD = wsf(F, WS_MOD);    float* const pMODP = wsf(F, WS_MODP);    const float* const iBADA = inp(I_BADA);    const float* const iNW = inp(I_NORMW);
    for (int i = bid * NTHR + tid; i < 2 * 5 * NMODC; i += F.G * NTHR) {
        const int layer = i / (5 * NMODC), rem = i % (5 * NMODC), v = rem / NMODC, n = rem % NMODC;
        float a = iBADA[layer * NMODC + n];
#pragma unroll
        for (int ks = 0; ks < 16; ++ks) a += pMODP[((size_t)(layer * 16 + ks) * 5 + v) * NMODC + n];
        const int ch = n / D, col = n % D, sub = ch / 3, kind = ch % 3; const float* nwl = iNW + (size_t)layer * 6 * D;
        if (kind == 1) a = (1.0f + a) * nwl[(2 * sub) * D + col];
        else if (kind == 2) a = a * (sub == 1 ? 1.0f : 0.5f) * nwl[(2 * sub + 1) * D + col];
        pMOD[i] = a;
    }
}

template <bool XINB, bool XOUTB> __device__ __forceinline__ void ph_rows(Frame& F, int nrows, const void* xin_l, const void* xin_c, void* xout_l, void* xout_c, const bf16* Y, const bf16* Ypart,
                                        const float* modA, int gi, const float* wpost, float resw, bf16* Aout, const float* modB, int si, const float* wpre) {
    const int tid = launder(F.tid), lane = tid & 63, wave = __builtin_amdgcn_readfirstlane(tid >> 6), bid = opaque_s(F.bid);
    const int gw = bid * NWAVES + wave, NGW = F.G * NWAVES;
    (void)wpost; (void)resw; (void)wpre;
    f32x4 xf_c[8], xf_n[8]; v4u xb_c[4], xb_n[4], yb_c[4], yb_n[4];
#define ROWS_COL(jj) (8 * lane + 512 * (jj))
#define ROWS_UNPK(w, lo, hi) do { lo = (f32x4){bflo((w)[0]), bfhi((w)[0]), bflo((w)[1]), bfhi((w)[1])}; hi = (f32x4){bflo((w)[2]), bfhi((w)[2]), bflo((w)[3]), bfhi((w)[3])}; } while (0)
#define ROWS_PK(lo, hi) ((v4u){pk2((lo).x, (lo).y), pk2((lo).z, (lo).w), pk2((hi).x, (hi).y), pk2((hi).z, (hi).w)})
#define ROWS_LOAD(rw, xf, xb, yb) do { const int rw_ = (rw); const bool lat_ = rw_ < ML; \
        if (XINB) { const bf16* xr_ = lat_ ? (const bf16*)xin_l + (size_t)rw_ * D : (const bf16*)xin_c + (size_t)(rw_ - ML) * D; _Pragma("unroll") for (int jj = 0; jj < 4; ++jj) xb[jj] = *(const v4u*)(xr_ + ROWS_COL(jj)); } \
        else { const float* xr_ = lat_ ? (const float*)xin_l + (size_t)rw_ * D : (const float*)xin_c + (size_t)(rw_ - ML) * D; \
            _Pragma("unroll") for (int jj = 0; jj < 4; ++jj) { xf[2 * jj] = *(const f32x4*)(xr_ + ROWS_COL(jj)); xf[2 * jj + 1] = *(const f32x4*)(xr_ + ROWS_COL(jj) + 4); } } \
        if (Y && (lat_ || !Ypart)) { _Pragma("unroll") for (int jj = 0; jj < 4; ++jj) yb[jj] = *(const v4u*)(Y + (size_t)rw_ * D + ROWS_COL(jj)); } } while (0)
#pragma unroll
    for (int j = 0; j < 8; ++j) xf_c[j] = xf_n[j] = (f32x4){0.f, 0.f, 0.f, 0.f};
#pragma unroll
    for (int jj = 0; jj < 4; ++jj) xb_c[jj] = xb_n[jj] = yb_c[jj] = yb_n[jj] = (v4u){0u, 0u, 0u, 0u};
    if (gw < nrows) ROWS_LOAD(gw, xf_c, xb_c, yb_c);
    for (int row = gw; row < nrows; row += NGW) {
        const bool lat = row < ML; const int v = lat ? (row >> 12) : 4;
        if (row + NGW < nrows) ROWS_LOAD(row + NGW, xf_n, xb_n, yb_n);
        f32x4 x[8];
        if (XINB) {
#pragma unroll
            for (int jj = 0; jj < 4; ++jj) ROWS_UNPK(xb_c[jj], x[2 * jj], x[2 * jj + 1]);
        } else {
#pragma unroll
            for (int j = 0; j < 8; ++j) x[j] = xf_c[j];
        }
        if (Y) {
            f32x4 y[8]; float ss = 0.f;
            if (!lat && Ypart) {
#pragma unroll
                for (int jj = 0; jj < 4; ++jj) { f32x4 a0 = {0.f, 0.f, 0.f, 0.f}, a1 = a0;
#pragma unroll
                    for (int sp = 0; sp < KSPLIT; ++sp) { const v4u yw = *(const v4u*)(Ypart + ((size_t)sp * MC + (row - ML)) * D + ROWS_COL(jj)); f32x4 p0, p1; ROWS_UNPK(yw, p0, p1); a0 += p0; a1 += p1; }
                    y[2 * jj] = a0; y[2 * jj + 1] = a1; }
            } else {
#pragma unroll
                for (int jj = 0; jj < 4; ++jj) ROWS_UNPK(yb_c[jj], y[2 * jj], y[2 * jj + 1]);
            }
#pragma unroll
            for (int j = 0; j < 8; ++j) { ss += (y[j].x * y[j].x + y[j].y * y[j].y) + (y[j].z * y[j].z + y[j].w * y[j].w); }
            const float rs = rsq(wave_sum(ss) * (1.0f / D) + EPS);
            const float* gp = modA + (size_t)v * NMODC + gi * D;
#pragma unroll
            for (int j = 0; j < 8; ++j) { const int c = ROWS_COL(j >> 1) + 4 * (j & 1); const f32x4 g = *(const f32x4*)(gp + c); x[j] += g * (y[j] * rs); }
        }
        if (xout_l) {
            if (XOUTB) { bf16* xo = lat ? (bf16*)xout_l + (size_t)row * D : (bf16*)xout_c + (size_t)(row - ML) * D;
#pragma unroll
                for (int jj = 0; jj < 4; ++jj) *(v4u*)(xo + ROWS_COL(jj)) = ROWS_PK(x[2 * jj], x[2 * jj + 1]);
            } else { float* xo = lat ? (float*)xout_l + (size_t)row * D : (float*)xout_c + (size_t)(row - ML) * D;
#pragma unroll
                for (int j = 0; j < 8; ++j) *(f32x4*)(xo + ROWS_COL(j >> 1) + 4 * (j & 1)) = x[j]; } }
        if (Aout) {
            float ss = 0.f;
#pragma unroll
            for (int j = 0; j < 8; ++j) ss += (x[j].x * x[j].x + x[j].y * x[j].y) + (x[j].z * x[j].z + x[j].w * x[j].w);
            const float rs2 = rsq(wave_sum(ss) * (1.0f / D) + EPS);
            const float* shp = modB + (size_t)v * NMODC + si * D; const float* scp = shp + D; bf16* ao = Aout + (size_t)row * D;
#pragma unroll
            for (int jj = 0; jj < 4; ++jj) { const int c = ROWS_COL(jj);
                const f32x4 sh0 = *(const f32x4*)(shp + c), sh1 = *(const f32x4*)(shp + c + 4), sc0 = *(const f32x4*)(scp + c), sc1 = *(const f32x4*)(scp + c + 4);
                const f32x4 h0 = (x[2 * jj] * rs2) * sc0 + sh0, h1 = (x[2 * jj + 1] * rs2) * sc1 + sh1;
                *(v4u*)(ao + c) = ROWS_PK(h0, h1); }
        }
#pragma unroll
        for (int j = 0; j < 8; ++j) xf_c[j] = xf_n[j];
#pragma unroll
        for (int jj = 0; jj < 4; ++jj) { xb_c[jj] = xb_n[jj]; yb_c[jj] = yb_n[jj]; }
    }
#undef ROWS_LOAD
#undef ROWS_COL
#undef ROWS_UNPK
#undef ROWS_PK
}


__device__ __forceinline__ void ph_dt_tasks(Frame& F, int layer) {
    const int tid = launder(F.tid), lane = tid & 63, wave = __builtin_amdgcn_readfirstlane(tid >> 6), bid = opaque_s(F.bid);
    float* const pDT = wsf(F, WS_DT); const bf16* const pA2 = wsb(F, WS_A); const bf16* const pWdt = wsb(F, WS_WIN) + (size_t)PC_DT * D;
    LAS f32x4* red = (LAS f32x4*)(F.lds + AUX_OFF);
    const int r = lane & 15, g = lane >> 4, kq = wave & 3; const float b0 = inp(I_DTB)[layer * 32 + r], b1 = inp(I_DTB)[layer * 32 + 16 + r];
    bf16x8 wv0[16], wv1[16];
    { const bf16* wp = pWdt + (size_t)r * D + kq * 512 + 8 * g;
#pragma unroll
      for (int ks = 0; ks < 16; ++ks) { wv0[ks] = *(const bf16x8*)(wp + 32 * ks); wv1[ks] = *(const bf16x8*)(wp + (size_t)16 * D + 32 * ks); } }
    for (int it = bid; it < M / 32; it += F.G) {
        const int row0 = 32 * it + 16 * (wave >> 2);
        const bf16* ap = pA2 + (size_t)(row0 + r) * D + kq * 512 + 8 * g;
        bf16x8 av[16];
#pragma unroll
        for (int ks = 0; ks < 16; ++ks) av[ks] = *(const bf16x8*)(ap + 32 * ks);
        f32x4 a0 = {0.f, 0.f, 0.f, 0.f}, a1 = a0;
#pragma unroll
        for (int ks = 0; ks < 16; ++ks) { a0 = __builtin_amdgcn_mfma_f32_16x16x32_bf16(av[ks], wv0[ks], a0, 0, 0, 0); a1 = __builtin_amdgcn_mfma_f32_16x16x32_bf16(av[ks], wv1[ks], a1, 0, 0, 0); }
        red[(wave * 2 + 0) * 64 + lane] = a0; red[(wave * 2 + 1) * 64 + lane] = a1;
        __syncthreads();
        if (kq == 0) {
#pragma unroll
            for (int k = 1; k < 4; ++k) { a0 += red[((wave + k) * 2 + 0) * 64 + lane]; a1 += red[((wave + k) * 2 + 1) * 64 + lane]; }
#pragma unroll
            for (int q = 0; q < 4; ++q) { float* o = pDT + (size_t)(row0 + 4 * g + q) * 32 + r; const float x0 = a0[q] + b0, x1 = a1[q] + b1;
                o[0] = fmaxf(x0, 0.f) + log1pf(__expf(-fabsf(x0))); o[16] = fmaxf(x1, 0.f) + log1pf(__expf(-fabsf(x1))); }
        }
        __syncthreads();
    }
}
__device__ __forceinline__ void ph_prep(Frame& F, int layer) {
    const int tid = launder(F.tid), lane = tid & 63, wave = __builtin_amdgcn_readfirstlane(tid >> 6), bid = opaque_s(F.bid);
    const bf16* const pP = wsb(F, WS_PH); bf16* const pAQ = wsb(F, WS_AQ); bf16* const pAK = wsb(F, WS_AK); bf16* const pSX = wsb(F, WS_SX); bf16* const pSB = wsb(F, WS_SB); bf16* const pSC = wsb(F, WS_SC);
    const int gw = bid * NWAVES + wave, NGW = F.G * NWAVES;
    const float* cw = inp(I_CONVW) + (size_t)layer * 3 * 1536; const float* cb = inp(I_CONVB) + (size_t)layer * 1536;
    LAS float* cosT = (LAS float*)F.lds; LAS float* sinT = cosT + 2048;
    for (int i = tid; i < 2048; i += NTHR) { const float ang = (float)(i >> 5) * powf(10000.0f, -(float)(2 * (i & 31)) / 64.0f); float sn, cs; sincosf(ang, &sn, &cs); cosT[i] = cs; sinT[i] = sn; }
    f32x4 w0[3][2], w1[3][2], w2[3][2], wb[3][2];
#pragma unroll
    for (int r = 0; r < 3; ++r)
#pragma unroll
        for (int hf = 0; hf < 2; ++hf) { const int c = 8 * lane + 512 * r + 4 * hf; w0[r][hf] = *(const f32x4*)(cw + c); w1[r][hf] = *(const f32x4*)(cw + 1536 + c); w2[r][hf] = *(const f32x4*)(cw + 3072 + c); wb[r][hf] = *(const f32x4*)(cb + c); }
    __syncthreads();
    const int ch16 = lane & 15, fb = 8 * (ch16 & 3); const bool second = (ch16 & 4) != 0, colpart = (ch16 & 8) != 0;
    v4u qc, kc, u0c[3], u1c[3], u2c[3], qn, kn, u0n[3], u1n[3], u2n[3];
#define PREP_LOAD(rw, q_, k_, u0_, u1_, u2_) do { const int rw_ = (rw); const bool lat_ = rw_ < ML; const int t_ = lat_ ? (rw_ & (T - 1)) : ((rw_ - ML) & (CL - 1)), tl_ = lat_ ? T : CL; \
        const bf16* pr_ = pP + (size_t)rw_ * INP; q_ = *(const v4u*)(pr_ + PC_AQ + 8 * lane); k_ = *(const v4u*)(pr_ + PC_AK + 8 * (lane & 31)); \
        _Pragma("unroll") for (int r = 0; r < 3; ++r) { const int ch = 8 * lane + 512 * r; u1_[r] = *(const v4u*)(pr_ + PC_XBC + ch); u0_[r] = (v4u){0u, 0u, 0u, 0u}; u2_[r] = (v4u){0u, 0u, 0u, 0u}; \
            if (t_ > 0) u0_[r] = *(const v4u*)(pr_ - INP + PC_XBC + ch); if (t_ < tl_ - 1) u2_[r] = *(const v4u*)(pr_ + INP + PC_XBC + ch); } } while (0)
    qn = kn = (v4u){0u, 0u, 0u, 0u};
#pragma unroll
    for (int r = 0; r < 3; ++r) u0n[r] = u1n[r] = u2n[r] = (v4u){0u, 0u, 0u, 0u};
    if (gw < M) PREP_LOAD(gw, qc, kc, u0c, u1c, u2c);
    for (int row = gw; row < M; row += NGW) {
        const bool lat = row < ML; const int t = lat ? (row & (T - 1)) : ((row - ML) & (CL - 1));
        if (row + NGW < M) PREP_LOAD(row + NGW, qn, kn, u0n, u1n, u2n);
        f32x4 cs0 = {1.f, 1.f, 1.f, 1.f}, cs1 = cs0, sn0 = {0.f, 0.f, 0.f, 0.f}, sn1 = sn0;
        if (lat) { const int pos = colpart ? (t & 63) : (t >> 6); cs0 = *(const LAS f32x4*)(cosT + pos * 32 + fb); cs1 = *(const LAS f32x4*)(cosT + pos * 32 + fb + 4); sn0 = *(const LAS f32x4*)(sinT + pos * 32 + fb); sn1 = *(const LAS f32x4*)(sinT + pos * 32 + fb + 4);
            if (!second) { sn0 = -sn0; sn1 = -sn1; } }
        v4u qo, ko;
#pragma unroll
        for (int e = 0; e < 4; ++e) { const unsigned pq = (unsigned)__shfl_xor((int)qc[e], 4), pk = (unsigned)__shfl_xor((int)kc[e], 4);
            const float c0 = e < 2 ? cs0[2 * e] : cs1[2 * e - 4], c1 = e < 2 ? cs0[2 * e + 1] : cs1[2 * e - 3], s0 = e < 2 ? sn0[2 * e] : sn1[2 * e - 4], s1 = e < 2 ? sn0[2 * e + 1] : sn1[2 * e - 3];
            qo[e] = pk2(bflo(qc[e]) * c0 + bflo(pq) * s0, bfhi(qc[e]) * c1 + bfhi(pq) * s1); ko[e] = pk2(bflo(kc[e]) * c0 + bflo(pk) * s0, bfhi(kc[e]) * c1 + bfhi(pk) * s1); }
        *(v4u*)(pAQ + (size_t)row * 512 + 8 * lane) = qo;
        if (lane < 32) *(v4u*)(pAK + (size_t)row * 256 + 8 * lane) = ko;
#pragma unroll
        for (int r = 0; r < 3; ++r) {
            const int ch = 8 * lane + 512 * r;
            unsigned ow[4];
#pragma unroll
            for (int e2 = 0; e2 < 4; ++e2) { const int hf = e2 >> 1, k0 = 2 * (e2 & 1);
                const float ylo = w0[r][hf][k0] * bflo(u0c[r][e2]) + w1[r][hf][k0] * bflo(u1c[r][e2]) + w2[r][hf][k0] * bflo(u2c[r][e2]) + wb[r][hf][k0];
                const float yhi = w0[r][hf][k0 + 1] * bfhi(u0c[r][e2]) + w1[r][hf][k0 + 1] * bfhi(u1c[r][e2]) + w2[r][hf][k0 + 1] * bfhi(u2c[r][e2]) + wb[r][hf][k0 + 1];
                ow[e2] = pk2(silu(ylo), silu(yhi)); }
            const v4u o = {ow[0], ow[1], ow[2], ow[3]};
            if (ch < 1024) *(v4u*)(pSX + (size_t)row * 1024 + ch) = o;
            else if (ch < 1280) *(v4u*)(pSB + (size_t)row * 256 + (ch - 1024)) = o;
            else *(v4u*)(pSC + (size_t)row * 256 + (ch - 1280)) = o;
        }
        qc = qn; kc = kn;
#pragma unroll
        for (int r = 0; r < 3; ++r) { u0c[r] = u0n[r]; u1c[r] = u1n[r]; u2c[r] = u2n[r]; }
    }
#undef PREP_LOAD
    __syncthreads();
}

__device__ __forceinline__ int swz(int r, int c16) { return r * TS + (c16 << 4); }
__device__ __forceinline__ int swz_el(int r, int col) { return r * TS + (col << 1); }
template <int NT> __device__ __forceinline__ void mma_1xN(f32x4 (&acc)[NT], ldsp At, int arow0, ldsp Bt, int brow0, int lane) {
    const int r = lane & 15, g = lane >> 4;
#pragma unroll
    for (int ks = 0; ks < 4; ++ks) {
        const bf16x8 a = *(const LAS bf16x8*)(At + swz(arow0 + r, 4 * ks + g));
#pragma unroll
        for (int nt = 0; nt < NT; ++nt) {
            const bf16x8 b = *(const LAS bf16x8*)(Bt + swz(brow0 + 16 * nt + r, 4 * ks + g));
            acc[nt] = __builtin_amdgcn_mfma_f32_16x16x32_bf16(a, b, acc[nt], 0, 0, 0);
        }
        __builtin_amdgcn_sched_barrier(0);
    }
}
template <int NT> __device__ __forceinline__ void zero_acc(f32x4 (&acc)[NT]) {
#pragma unroll
    for (int i = 0; i < NT; ++i) acc[i] = (f32x4){0.f, 0.f, 0.f, 0.f};
}
__device__ __forceinline__ void stage_direct(ldsp tile, const bf16* g, int ld, int rows, int tid) {
    for (int c = tid; c < rows * 16; c += NTHR) { const int r = c >> 4, ch = c & 15; *(LAS v4u*)(tile + swz(r, ch)) = *(const v4u*)(g + (size_t)r * ld + ch * 8); }
}
__device__ __forceinline__ void stage_direct_f32(ldsp tile, const float* g, int ld, int rows, int tid) {
    for (int c = tid; c < rows * 16; c += NTHR) { const int r = c >> 4, ch = c & 15; const f32x4 a = *(const f32x4*)(g + (size_t)r * ld + ch * 8), b = *(const f32x4*)(g + (size_t)r * ld + ch * 8 + 4);
        *(LAS v4u*)(tile + swz(r, ch)) = (v4u){pk2(a.x, a.y), pk2(a.z, a.w), pk2(b.x, b.y), pk2(b.z, b.w)}; }
}
__device__ __forceinline__ void stage_tr(ldsp tile, const bf16* g, int ld, int ncols, const LAS float* rs, int tid) {
    const int nch = ncols >> 3;
    for (int c = tid; c < 128 * nch; c += NTHR) { const int r = c & 127, ch = c >> 7; const v4u v = *(const v4u*)(g + (size_t)r * ld + ch * 8); const float sc = rs ? rs[r] : 1.0f;
#pragma unroll
        for (int i = 0; i < 4; ++i) { const float lo = bflo(v[i]) * sc, hi = bfhi(v[i]) * sc;
            *(LAS bf16*)(tile + swz_el(ch * 8 + 2 * i, r)) = (bf16)f2bf(lo); *(LAS bf16*)(tile + swz_el(ch * 8 + 2 * i + 1, r)) = (bf16)f2bf(hi); } }
}

typedef short s16x4 __attribute__((ext_vector_type(4)));
constexpr int TSR = 272;
constexpr int TST = 288;
constexpr int TSX = 544;
__device__ __forceinline__ bf16x8 row_frag(ldsp t, int ts, int row0, int ks, int lane) { return *(const LAS bf16x8*)(t + (row0 + (lane & 15)) * ts + ((4 * ks + (lane >> 4)) << 4)); }
__device__ __forceinline__ bf16x8 tr_frag(ldsp t, int ts, int k0, int c0, int lane) {
    ldsp a = t + (k0 + 4 * (lane >> 4) + ((lane >> 2) & 3)) * ts + (c0 + 4 * (lane & 3)) * 2;
    const s16x4 lo = __builtin_amdgcn_ds_read_tr16_b64_v4i16((LAS s16x4*)a), hi = __builtin_amdgcn_ds_read_tr16_b64_v4i16((LAS s16x4*)(a + 16 * ts));
    return (bf16x8){lo[0], lo[1], lo[2], lo[3], hi[0], hi[1], hi[2], hi[3]};
}
__device__ __forceinline__ bf16x8 acc_frag(f32x4 lo, f32x4 hi) { const v4u w = {cvtpk(lo[0], lo[1]), cvtpk(lo[2], lo[3]), cvtpk(hi[0], hi[1]), cvtpk(hi[2], hi[3])}; return __builtin_bit_cast(bf16x8, w); }
__device__ __forceinline__ bf16x8 scale_frag(bf16x8 a, const LAS float* w, int k0, int lane) {
    const f32x4 wl = *(const LAS f32x4*)(w + k0 + 4 * (lane >> 4)), wh = *(const LAS f32x4*)(w + k0 + 16 + 4 * (lane >> 4)); const v4u x = __builtin_bit_cast(v4u, a);
    const v4u o = {cvtpk(bflo(x[0]) * wl[0], bfhi(x[0]) * wl[1]), cvtpk(bflo(x[1]) * wl[2], bfhi(x[1]) * wl[3]), cvtpk(bflo(x[2]) * wh[0], bfhi(x[2]) * wh[1]), cvtpk(bflo(x[3]) * wh[2], bfhi(x[3]) * wh[3])};
    return __builtin_bit_cast(bf16x8, o);
}
#define MFMA16(a, b, c) __builtin_amdgcn_mfma_f32_16x16x32_bf16(a, b, c, 0, 0, 0)
#define SCHED_FENCE() __builtin_amdgcn_sched_barrier(0)
template <int MT> __device__ __forceinline__ void mma_xt(f32x4 (&acc)[MT], ldsp t, int ts, const bf16x8 (&own)[4], int lane) {
    bf16x8 a[MT];
#pragma unroll
    for (int mt = 0; mt < MT; ++mt) a[mt] = row_frag(t, ts, 16 * mt, 0, lane);
#pragma unroll
    for (int ks = 0; ks < 4; ++ks) { bf16x8 an[MT];
        if (ks < 3) {
#pragma unroll
            for (int mt = 0; mt < MT; ++mt) an[mt] = row_frag(t, ts, 16 * mt, ks + 1, lane); }
#pragma unroll
        for (int mt = 0; mt < MT; ++mt) acc[mt] = MFMA16(a[mt], own[ks], acc[mt]);
        SCHED_FENCE();
        if (ks < 3) {
#pragma unroll
            for (int mt = 0; mt < MT; ++mt) a[mt] = an[mt]; }
    }
}
template <int NT, bool SWAP = false> __device__ __forceinline__ void mma_at(f32x4 (&acc)[NT], const bf16x8 (&afr)[4], ldsp t, int ts, int c0, int lane) {
    bf16x8 b[NT];
#pragma unroll
    for (int nt = 0; nt < NT; ++nt) b[nt] = tr_frag(t, ts, 0, c0 + 16 * nt, lane);
#pragma unroll
    for (int ks = 0; ks < 4; ++ks) { bf16x8 bn[NT];
        if (ks < 3) {
#pragma unroll
            for (int nt = 0; nt < NT; ++nt) bn[nt] = tr_frag(t, ts, 32 * (ks + 1), c0 + 16 * nt, lane); }
#pragma unroll
        for (int nt = 0; nt < NT; ++nt) acc[nt] = SWAP ? MFMA16(b[nt], afr[ks], acc[nt]) : MFMA16(afr[ks], b[nt], acc[nt]);
        SCHED_FENCE();
        if (ks < 3) {
#pragma unroll
            for (int nt = 0; nt < NT; ++nt) b[nt] = bn[nt]; }
    }
}
template <int ROWS, int COLS> struct Stage { static constexpr int CPR = COLS / 8, N = ROWS * CPR / NTHR; v4u v[N];
    __device__ __forceinline__ void load(const bf16* g, int ld, int tid) {
#pragma unroll
        for (int i = 0; i < N; ++i) { const int c = tid + NTHR * i, r = c / CPR, ch = c % CPR; v[i] = *(const v4u*)(g + (size_t)r * ld + ch * 8); } }
    __device__ __forceinline__ void store(ldsp tile, int ts, int tid) const {
#pragma unroll
        for (int i = 0; i < N; ++i) { const int c = tid + NTHR * i, r = c / CPR, ch = c % CPR; *(LAS v4u*)(tile + r * ts + (ch << 4)) = v[i]; } }
};

constexpr int STG_OFF = 104448, STG_WAVE = 16 * 272;
static_assert(STG_OFF + NWAVES * STG_WAVE <= AUX_OFF, "staging strip");
template <int NT> __device__ __forceinline__ void st_tile(ldsp lds, const f32x4 (&acc)[NT], bf16* g, int ld, int lane, int w) {
    ldsp st = lds + STG_OFF + w * STG_WAVE;
    const int r = lane & 15, gq = lane >> 4;
#pragma unroll
    for (int nt = 0; nt < NT; ++nt) *(LAS unsigned long long*)(st + r * 272 + (16 * nt + 4 * gq) * 2) = (unsigned long long)cvtpk(acc[nt][0], acc[nt][1]) | ((unsigned long long)cvtpk(acc[nt][2], acc[nt][3]) << 32);
    if (NT == 8) {
#pragma unroll
        for (int i = 0; i < 4; ++i) { const int row = 4 * i + (lane >> 4), ch = lane & 15; const v4u v = *(const LAS v4u*)(st + row * 272 + ch * 16); *(v4u*)(g + (size_t)row * ld + ch * 8) = v; }
    } else {
#pragma unroll
        for (int i = 0; i < 2; ++i) { const int row = 8 * i + (lane >> 3), ch = lane & 7; const v4u v = *(const LAS v4u*)(st + row * 272 + ch * 16); *(v4u*)(g + (size_t)row * ld + ch * 8) = v; }
    }
}
__device__ __forceinline__ void m2_ret_unit(Frame& F, int layer, int cr, int h, bool need_y) {
    const int tid = launder(F.tid), lane = tid & 63, w = __builtin_amdgcn_readfirstlane(tid >> 6), r = lane & 15, g = lane >> 4;
    const bf16* Pm = wsb(F, WS_PH) + (size_t)cr * 128 * INP; bf16* const pYR = wsb(F, WS_YR); bf16* const pRS = wsb(F, WS_RS);
    ldsp TK = F.lds, TV = F.lds + 128 * TSR;
    LAS float* aux = (LAS float*)(F.lds + AUX_OFF);
    LAS float* ef = aux; LAS float* eb = aux + 128; LAS float* nf = aux + 256; LAS float* nb = aux + 384; LAS float* wf = aux + 512; LAS float* wb = aux + 640;
    const float scale = 0.08838834764831845f;
    Stage<128, 128> sk, sv; sk.load(Pm + PC_RK + h * 128, INP, tid); sv.load(Pm + PC_RV + h * 128, INP, tid);
    bf16x8 qf[4];
#pragma unroll
    for (int ks = 0; ks < 4; ++ks) qf[ks] = *(const bf16x8*)(Pm + (size_t)(16 * w + r) * INP + PC_RQ + h * 128 + 32 * ks + 8 * g);
    const float lgf = -fabsf(inp(I_RDEC)[layer * 8 + h]), lgb = -fabsf(inp(I_RDEC)[layer * 8 + 4 + h]);
    __syncthreads();
    sk.store(TK, TSR, tid); sv.store(TV, TST, tid);
    if (tid < 128) { const float t = (float)tid; ef[tid] = __expf(lgf * t); nf[tid] = __expf(-lgf * t); eb[tid] = __expf(lgb * t); nb[tid] = __expf(-lgb * t); wf[tid] = __expf(lgf * (127.f - t)); wb[tid] = __expf(lgb * t); }
    __syncthreads();
    f32x4 s[8]; zero_acc(s); mma_xt<8>(s, TK, TSR, qf, lane);
    { const int i = 16 * w + r; const float efi = ef[i] * scale, nbi = nb[i] * scale;
#pragma unroll
      for (int mt = 0; mt < 8; ++mt) { const int j0 = 16 * mt + 4 * g; const f32x4 nfj = *(const LAS f32x4*)(nf + j0), ebj = *(const LAS f32x4*)(eb + j0);
#pragma unroll
          for (int q = 0; q < 4; ++q) { const int j = j0 + q; const float dec = (i >= j ? efi * nfj[q] : 0.f) + (i <= j ? nbi * ebj[q] : 0.f); s[mt][q] *= dec; } } }
    bf16x8 pa[4];
#pragma unroll
    for (int ks = 0; ks < 4; ++ks) pa[ks] = acc_frag(s[2 * ks], s[2 * ks + 1]);
    if (need_y) { f32x4 y[8]; zero_acc(y); mma_at<8, true>(y, pa, TV, TST, 0, lane);
        st_tile<8>(F.lds, y, pYR + (size_t)(cr * 128 + 16 * w) * 512 + h * 128, 512, lane, w); }
#pragma unroll
    for (int dir = 0; dir < 2; ++dir) { bf16x8 va[4];
#pragma unroll
        for (int ks = 0; ks < 4; ++ks) va[ks] = scale_frag(tr_frag(TV, TST, 32 * ks, 16 * w, lane), dir ? wb : wf, 32 * ks, lane);
        f32x4 u[8]; zero_acc(u); mma_at<8, true>(u, va, TK, TSR, 0, lane);
        st_tile<8>(F.lds, u, pRS + ((size_t)(cr * 4 + h) * 2 + dir) * 16384 + (16 * w) * 128, 128, lane, w); }
}
__device__ __forceinline__ void m2_ssd_unit(Frame& F, int layer, int cr, int grp, int hq, bool need_y) {
    const int tid = launder(F.tid), lane = tid & 63, w = __builtin_amdgcn_readfirstlane(tid >> 6), r = lane & 15, g = lane >> 4, m0 = cr * 128, h0 = grp * 8 + hq * 4;
    const bf16* const pSX = wsb(F, WS_SX); const bf16* const pSB = wsb(F, WS_SB); const bf16* const pSC = wsb(F, WS_SC); const float* const pDT = wsf(F, WS_DT);
    float* const pCUMF = wsf(F, WS_CUMF); float* const pRCUMB = wsf(F, WS_RCUMB); float* const pSDEC = wsf(F, WS_SDEC); bf16* const pYS = wsb(F, WS_YS); bf16* const pSS = wsb(F, WS_SS);
    ldsp TB = F.lds, TX = F.lds + 128 * TSR;
    LAS float* aux = (LAS float*)(F.lds + AUX_OFF);
    Stage<128, 128> sb; Stage<128, 256> sx; sb.load(pSB + (size_t)m0 * 256 + grp * 128, 256, tid); sx.load(pSX + (size_t)m0 * 1024 + h0 * 64, 1024, tid);
    bf16x8 cf[4];
#pragma unroll
    for (int ks = 0; ks < 4; ++ks) cf[ks] = *(const bf16x8*)(pSC + (size_t)(m0 + 16 * w + r) * 256 + grp * 128 + 32 * ks + 8 * g);
    const int chh = w >> 1, cdir = w & 1, ch_ = h0 + chh;
    const float alog_ = inp(I_ALOG)[layer * 32 + cdir * 16 + ch_], d0 = pDT[(size_t)(m0 + lane) * 32 + cdir * 16 + ch_], d1 = pDT[(size_t)(m0 + 64 + lane) * 32 + cdir * 16 + ch_];
    __syncthreads();
    sb.store(TB, TSR, tid); sx.store(TX, TSX, tid);
    {
      const int hh = chh, dir = cdir, h = ch_; const float a = -__expf(alog_);
      float p0 = d0 * a, p1 = d1 * a; const float l0 = p0, l1 = p1;
#pragma unroll
      for (int o = 1; o < 64; o <<= 1) { const float t0 = __shfl_up(p0, o), t1 = __shfl_up(p1, o); if (lane >= o) { p0 += t0; p1 += t1; } }
      const float tot0 = __shfl(p0, 63), tot = tot0 + __shfl(p1, 63); p1 += tot0;
      float c0, c1, w0, w1;
      if (dir == 0) { c0 = p0; c1 = p1; w0 = d0 * __expf(tot - p0); w1 = d1 * __expf(tot - p1); }
      else { c0 = tot - p0 + l0; c1 = tot - p1 + l1; w0 = d0 * __expf(tot - c0); w1 = d1 * __expf(tot - c1); }
      LAS float* base = aux + (hh * 2 + dir) * 384;
      const float L2E = 1.44269504089f;
      base[lane] = c0 * L2E; base[64 + lane] = c1 * L2E; base[128 + lane] = d0; base[192 + lane] = d1; base[256 + lane] = w0; base[320 + lane] = w1;
      float* cg = dir ? pRCUMB : pCUMF; cg[(size_t)(m0 + lane) * 16 + h] = c0 * L2E; cg[(size_t)(m0 + 64 + lane) * 16 + h] = c1 * L2E;
      if (lane == 0) pSDEC[(size_t)(cr * 16 + h) * 2 + dir] = __expf(tot);
    }
    __syncthreads();
    f32x4 cb[8]; zero_acc(cb); mma_xt<8>(cb, TB, TSR, cf, lane);
    for (int hh = 0; hh < 4; ++hh) {
        const int h = h0 + hh, l = 16 * w + r;
        const LAS float* cumf = aux + (hh * 2) * 384; const LAS float* dtf = cumf + 128; const LAS float* wf = cumf + 256;
        const LAS float* rcum = aux + (hh * 2 + 1) * 384; const LAS float* dtb = rcum + 128; const LAS float* wb = rcum + 256;
        const float cfl = cumf[l], rcl = rcum[l];
        f32x4 m[8];
#pragma unroll
        for (int mt = 0; mt < 8; ++mt) { const int s0 = 16 * mt + 4 * g;
            if (mt < w) { const f32x4 cs = *(const LAS f32x4*)(cumf + s0), ds = *(const LAS f32x4*)(dtf + s0);
#pragma unroll
                for (int q = 0; q < 4; ++q) m[mt][q] = cb[mt][q] * (__builtin_amdgcn_exp2f(cfl - cs[q]) * ds[q]);
            } else if (mt > w) { const f32x4 rs = *(const LAS f32x4*)(rcum + s0), es = *(const LAS f32x4*)(dtb + s0);
#pragma unroll
                for (int q = 0; q < 4; ++q) m[mt][q] = cb[mt][q] * (__builtin_amdgcn_exp2f(rcl - rs[q]) * es[q]);
            } else { const f32x4 cs = *(const LAS f32x4*)(cumf + s0), ds = *(const LAS f32x4*)(dtf + s0), rs = *(const LAS f32x4*)(rcum + s0), es = *(const LAS f32x4*)(dtb + s0);
#pragma unroll
                for (int q = 0; q < 4; ++q) { const int s = s0 + q; const float mf = (l >= s) ? __builtin_amdgcn_exp2f(cfl - cs[q]) * ds[q] : 0.f, mb = (l <= s) ? __builtin_amdgcn_exp2f(rcl - rs[q]) * es[q] : 0.f; m[mt][q] = cb[mt][q] * (mf + mb); } } }
        bf16x8 pa[4];
#pragma unroll
        for (int ks = 0; ks < 4; ++ks) pa[ks] = acc_frag(m[2 * ks], m[2 * ks + 1]);
        if (need_y) { f32x4 y[4]; zero_acc(y); mma_at<4, true>(y, pa, TX, TSX, hh * 64, lane);
            st_tile<4>(F.lds, y, pYS + (size_t)(m0 + 16 * w) * 1024 + h * 64, 1024, lane, w); }
#pragma unroll
        for (int dir = 0; dir < 2; ++dir) { bf16x8 xa[4];
#pragma unroll
            for (int ks = 0; ks < 4; ++ks) xa[ks] = scale_frag(tr_frag(TX, TSX, 32 * ks, hh * 64 + 16 * (w & 3), lane), dir ? wb : wf, 32 * ks, lane);
            f32x4 u[4]; zero_acc(u); mma_at<4, true>(u, xa, TB, TSR, 64 * (w >> 2), lane);
            st_tile<4>(F.lds, u, pSS + ((size_t)(cr * 16 + h) * 2 + dir) * 8192 + (16 * (w & 3)) * 128 + 64 * (w >> 2), 128, lane, w); }
    }
}
__device__ __forceinline__ void m2_att_unit(Frame& F, int layer, int b, int qb, int qh, bool is_ctx) {
    const int tid = launder(F.tid), lane = tid & 63, w = __builtin_amdgcn_readfirstlane(tid >> 6), r = lane & 15, g = lane >> 4, kvh = qh >> 1;
    const bf16* const pAQ = wsb(F, WS_AQ); const bf16* const pAK = wsb(F, WS_AK); const bf16* const pP = wsb(F, WS_PH); bf16* const pA = wsb(F, WS_A);
    const int qrow0 = is_ctx ? (ML + b * CL + qb * 128) : (b * T + qb * 128);
    constexpr int KVB = 128 * TSR + 128 * TST;
    const float scale = 0.08838834764831845f;
    const int nleft = (!is_ctx && qb > 0) ? 1 : 0, nright = (!is_ctx && qb < T / 128 - 1) ? 1 : 0, nt_ = is_ctx ? 2 : 3 + nleft + nright, crow = ML + b * CL;
#define TILE_INFO(ti, row, mode) do { int t_ = (ti); row = crow + t_ * 128; mode = 0; \
        if (!is_ctx) { if (t_ == 0) row = qrow0; else if (nleft && t_ == 1) { row = qrow0 - 128; mode = 1; } else if (nright && t_ == 1 + nleft) { row = qrow0 + 128; mode = 2; } else row = crow + (t_ - 1 - nleft - nright) * 128; } } while (0)
    bf16x8 qf[4];
#pragma unroll
    for (int ks = 0; ks < 4; ++ks) qf[ks] = *(const bf16x8*)(pAQ + (size_t)(qrow0 + 16 * w + r) * 512 + qh * 128 + 32 * ks + 8 * g);
    float mrun = -1e30f, lrun = 0.f; f32x4 o[8]; zero_acc(o);
    v4u kr[4], vr[4];
    const int srow = tid >> 4, sch = tid & 15;
    { int row0_, mode0_; TILE_INFO(0, row0_, mode0_); (void)mode0_; const bf16* kg = pAK + (size_t)(row0_ + srow) * 256 + kvh * 128 + sch * 8; const bf16* vg = pP + (size_t)(row0_ + srow) * INP + PC_AV + kvh * 128 + sch * 8;
#pragma unroll
      for (int k = 0; k < 4; ++k) { kr[k] = *(const v4u*)(kg + (size_t)(32 * k) * 256); vr[k] = *(const v4u*)(vg + (size_t)(32 * k) * INP); } }
    __syncthreads();
#pragma unroll
    for (int k = 0; k < 4; ++k) { *(LAS v4u*)(F.lds + (srow + 32 * k) * TSR + (sch << 4)) = kr[k]; *(LAS v4u*)(F.lds + 128 * TSR + (srow + 32 * k) * TST + (sch << 4)) = vr[k]; }
    __syncthreads();
    for (int ti = 0; ti < nt_; ++ti) {
        ldsp TK = F.lds + (ti & 1) * KVB, TV = TK + 128 * TSR;
        int mode, row_cur; TILE_INFO(ti, row_cur, mode); (void)row_cur;
        if (ti + 1 < nt_) { int tr_, mode_n; TILE_INFO(ti + 1, tr_, mode_n); (void)mode_n; const bf16* kg = pAK + (size_t)(tr_ + srow) * 256 + kvh * 128 + sch * 8; const bf16* vg = pP + (size_t)(tr_ + srow) * INP + PC_AV + kvh * 128 + sch * 8;
#pragma unroll
            for (int k = 0; k < 4; ++k) { kr[k] = *(const v4u*)(kg + (size_t)(32 * k) * 256); vr[k] = *(const v4u*)(vg + (size_t)(32 * k) * INP); } }
        f32x4 s[8]; zero_acc(s); mma_xt<8>(s, TK, TSR, qf, lane);
        const int i = 16 * w + r; float mx = -1e30f;
#pragma unroll
        for (int mt = 0; mt < 8; ++mt)
#pragma unroll
            for (int q = 0; q < 4; ++q) { const int j = 16 * mt + 4 * g + q; const bool valid = (mode == 0) || (mode == 1 ? (j >= i) : (j <= i)); const float v = valid ? s[mt][q] * scale : -INFINITY; s[mt][q] = v; mx = fmaxf(mx, v); }
        mx = fmaxf(mx, __shfl_xor(mx, 16)); mx = fmaxf(mx, __shfl_xor(mx, 32));
        const float mnew = fmaxf(mrun, mx), alpha = __expf(mrun - mnew); float rsum = 0.f;
#pragma unroll
        for (int mt = 0; mt < 8; ++mt)
#pragma unroll
            for (int q = 0; q < 4; ++q) { const float p = __expf(s[mt][q] - mnew); s[mt][q] = p; rsum += p; }
        rsum += __shfl_xor(rsum, 16); rsum += __shfl_xor(rsum, 32);
        lrun = lrun * alpha + rsum; mrun = mnew;
        bf16x8 pa[4];
#pragma unroll
        for (int ks = 0; ks < 4; ++ks) pa[ks] = acc_frag(s[2 * ks], s[2 * ks + 1]);
#pragma unroll
        for (int nt = 0; nt < 8; ++nt) o[nt] = o[nt] * alpha;
        mma_at<8, true>(o, pa, TV, TST, 0, lane);
        if (ti + 1 < nt_) { ldsp NK = F.lds + ((ti + 1) & 1) * KVB, NV = NK + 128 * TSR;
#pragma unroll
            for (int k = 0; k < 4; ++k) { *(LAS v4u*)(NK + (srow + 32 * k) * TSR + (sch << 4)) = kr[k]; *(LAS v4u*)(NV + (srow + 32 * k) * TST + (sch << 4)) = vr[k]; } }
        __syncthreads();
    }
    const float sk = inp(I_SINK)[layer * 4 + qh];
    const float mfin = fmaxf(mrun, sk), afin = __expf(mrun - mfin), lfin = lrun * afin + __expf(sk - mfin), fq_ = afin / lfin;
#pragma unroll
    for (int nt = 0; nt < 8; ++nt) o[nt] = o[nt] * fq_;
    st_tile<8>(F.lds, o, pA + (size_t)(qrow0 + 16 * w) * D + 512 + qh * 128, D, lane, w);
#undef TILE_INFO
}
__device__ __forceinline__ void ph_m2(Frame& F, int layer, bool ctx_out, int which = 7) {
    const int tid = launder(F.tid), lane = tid & 63, wave = __builtin_amdgcn_readfirstlane(tid >> 6), bid = opaque_s(F.bid); (void)lane; (void)wave; (void)bid;
    const int natt = 512 + (ctx_out ? 32 : 0);
    const int vb = (F.G & 7) == 0 ? (bid & 7) * (F.G >> 3) + (bid >> 3) : bid;
    if (which & 1) for (int u = vb; u < natt; u += F.G) {
        if (u < 512) m2_att_unit(F, layer, u >> 7, (u >> 2) & 31, u & 3, false);
        else { const int v = u - 512; m2_att_unit(F, layer, v >> 3, (v >> 2) & 1, v & 3, true); }
    }
    if (which & 2) for (int u = (vb + 224) % F.G; u < NCR * 4; u += F.G) { const int cr = u >> 2; m2_ssd_unit(F, layer, cr, (u >> 1) & 1, u & 1, ctx_out || cr < 128); }
    if (which & 4) {
        if (F.G == 256) {
            if (vb >= 64) { const int c = vb - 64; for (int k = 0; k < (c < 128 ? 3 : 2); ++k) { const int u = c + 192 * k; const int cr = u >> 2; m2_ret_unit(F, layer, cr, u & 3, ctx_out || cr < 128); } }
            else if (vb < 32) { const int u = 512 + vb; const int cr = u >> 2; m2_ret_unit(F, layer, cr, u & 3, ctx_out || cr < 128); }
        } else for (int u = (vb + 192) % F.G; u < NCR * 4; u += F.G) { const int cr = u >> 2; m2_ret_unit(F, layer, cr, u & 3, ctx_out || cr < 128); }
    }
    __syncthreads();
}

__device__ __forceinline__ int chain_cr(int b, int dir, int step) {
    if (step < 2) return 128 + b * 2 + (dir ? 1 - step : step);
    return b * 32 + (dir ? 33 - step : step - 2);
}
__device__ __forceinline__ void ph_scan(Frame& F, int layer) {
    const int tid = launder(F.tid), bid = opaque_s(F.bid);
    const bf16* const pRS = wsb(F, WS_RS); const bf16* const pSS = wsb(F, WS_SS); const float* const pSDEC = wsf(F, WS_SDEC); const float* const iRDEC = inp(I_RDEC);
    bf16* const pRSB = wsb(F, WS_RSB); bf16* const pSSB = wsb(F, WS_SSB);
    const int gt = bid * NTHR + tid, NT_ = F.G * NTHR;
    for (int it = gt; it < 65536 + 131072; it += NT_) {
        const bool ret = it < 65536; const int j = ret ? it : it - 65536;
        int e8, x, dir, h, b; if (ret) { e8 = j & 2047; x = j >> 11; dir = x & 1; h = (x >> 1) & 3; b = x >> 3; } else { e8 = j & 1023; x = j >> 10; dir = x & 1; h = (x >> 1) & 15; b = x >> 5; }
        const bf16* src = ret ? pRS : pSS; bf16* dstb = ret ? pRSB : pSSB; const int nh = ret ? 4 : 16, tsz = ret ? 16384 : 8192;
        const float rdec = ret ? __expf(-fabsf(iRDEC[layer * 8 + dir * 4 + h]) * 128.0f) : 0.f;
        float s[8];
#pragma unroll
        for (int k = 0; k < 8; ++k) s[k] = 0.f;
#pragma unroll
        for (int b0 = 0; b0 < 34; b0 += 12) { constexpr int NBMAX = 12; v4u u[NBMAX]; float dc[NBMAX]; size_t of[NBMAX];
#pragma unroll
            for (int i = 0; i < NBMAX; ++i) if (b0 + i < 34) { const int cr = chain_cr(b, dir, b0 + i); of[i] = ((size_t)(cr * nh + h) * 2 + dir) * tsz + e8 * 8; u[i] = *(const v4u*)(src + of[i]); dc[i] = ret ? rdec : pSDEC[(size_t)(cr * 16 + h) * 2 + dir]; }
#pragma unroll
            for (int i = 0; i < NBMAX; ++i) if (b0 + i < 34) {
                *(v4u*)(dstb + of[i]) = (v4u){pk2(s[0], s[1]), pk2(s[2], s[3]), pk2(s[4], s[5]), pk2(s[6], s[7])};
#pragma unroll
                for (int k = 0; k < 4; ++k) { s[2 * k] = s[2 * k] * dc[i] + bflo(u[i][k]); s[2 * k + 1] = s[2 * k + 1] * dc[i] + bfhi(u[i][k]); } } }
    }
}


__device__ __forceinline__ void m4_ret_unit(Frame& F, int layer, int cr, int h) {
    const int tid = launder(F.tid), lane = tid & 63, w = __builtin_amdgcn_readfirstlane(tid >> 6), r = lane & 15, g = lane >> 4, i = 16 * w + r;
    const bf16* const pYR = wsb(F, WS_YR); const bf16* const pRSB = wsb(F, WS_RSB); bf16* const pA = wsb(F, WS_A); const bf16* const pP = wsb(F, WS_PH);
    const size_t m = (size_t)cr * 128 + i;
    const float scale = 0.08838834764831845f;
    ldsp T0 = F.lds, T1 = F.lds + 128 * TSR;
    Stage<128, 128> s0, s1; s0.load(pRSB + ((size_t)(cr * 4 + h) * 2 + 0) * 16384, 128, tid); s1.load(pRSB + ((size_t)(cr * 4 + h) * 2 + 1) * 16384, 128, tid);
    bf16x8 qf[4];
#pragma unroll
    for (int ks = 0; ks < 4; ++ks) qf[ks] = *(const bf16x8*)(pP + m * INP + PC_RQ + h * 128 + 32 * ks + 8 * g);
    unsigned long long yq[8], gq[8];
#pragma unroll
    for (int mt = 0; mt < 8; ++mt) { yq[mt] = *(const unsigned long long*)(pYR + m * 512 + h * 128 + 16 * mt + 4 * g); gq[mt] = *(const unsigned long long*)(pP + m * INP + PC_RG + h * 128 + 16 * mt + 4 * g); }
    const float lgf = -fabsf(inp(I_RDEC)[layer * 8 + h]), lgb = -fabsf(inp(I_RDEC)[layer * 8 + 4 + h]);
    __syncthreads();
    s0.store(T0, TSR, tid); s1.store(T1, TSR, tid);
    __syncthreads();
    f32x4 af[8], ab[8]; zero_acc(af); zero_acc(ab);
    mma_xt<8>(af, T0, TSR, qf, lane); mma_xt<8>(ab, T1, TSR, qf, lane);
    const float qfac = __expf(lgf * (float)(i + 1)) * scale, qbac = __expf(lgb * (float)(128 - i)) * scale;
    f32x4 y[8]; float sm = 0.f;
#pragma unroll
    for (int mt = 0; mt < 8; ++mt) { const unsigned long long yw = yq[mt]; const unsigned y0 = (unsigned)yw, y1 = (unsigned)(yw >> 32);
        y[mt] = (f32x4){bflo(y0), bfhi(y0), bflo(y1), bfhi(y1)} + af[mt] * qfac + ab[mt] * qbac; sm += (y[mt][0] + y[mt][1]) + (y[mt][2] + y[mt][3]); }
    sm += __shfl_xor(sm, 16); sm += __shfl_xor(sm, 32);
    const float mu = sm * (1.0f / 128.0f); float vs = 0.f;
#pragma unroll
    for (int mt = 0; mt < 8; ++mt) { y[mt] = y[mt] - mu; vs += (y[mt][0] * y[mt][0] + y[mt][1] * y[mt][1]) + (y[mt][2] * y[mt][2] + y[mt][3] * y[mt][3]); }
    vs += __shfl_xor(vs, 16); vs += __shfl_xor(vs, 32);
    const float rstd = rsq(vs * (1.0f / 128.0f) + EPS);
    const float* nw = inp(I_RNW) + layer * 512 + h * 128;
#pragma unroll
    for (int mt = 0; mt < 8; ++mt) { const int e = 16 * mt + 4 * g; const f32x4 wv = *(const f32x4*)(nw + e);
        const unsigned long long gt = gq[mt]; const unsigned g0 = (unsigned)gt, g1 = (unsigned)(gt >> 32);
        const f32x4 o = y[mt] * rstd * wv;
        *(unsigned long long*)(pA + m * D + h * 128 + e) = (unsigned long long)pk2(o[0] * silu(bflo(g0)), o[1] * silu(bfhi(g0))) | ((unsigned long long)pk2(o[2] * silu(bflo(g1)), o[3] * silu(bfhi(g1))) << 32); }
}
__device__ __forceinline__ void m4_ssd_unit(Frame& F, int layer, int cr, int flags = 7) {
    const int tid = launder(F.tid), lane = tid & 63, w = __builtin_amdgcn_readfirstlane(tid >> 6), r = lane & 15, g = lane >> 4;
    const float* const pCUMF = wsf(F, WS_CUMF); const float* const pRCUMB = wsf(F, WS_RCUMB); const bf16* const pYS = wsb(F, WS_YS); const bf16* const pSSB = wsb(F, WS_SSB);
    bf16* const pA = wsb(F, WS_A); const bf16* const pP = wsb(F, WS_PH); const bf16* const pSX = wsb(F, WS_SX); const bf16* const pSC = wsb(F, WS_SC);
    const float* const nw = inp(I_SNW) + layer * 1024; const float* const dskp = inp(I_DSKIP) + layer * 16;
    const size_t m = (size_t)cr * 128 + 16 * w + r;
    typedef unsigned long long u64;
    constexpr int HB = 4 * 64 * TSR;
    v4u sr[8];
    const bf16* sbase = pSSB + (size_t)(cr * 16) * 2 * 8192 + (size_t)tid * 8;
#define M4_RHO(p) (16 * (2 * ((p) >> 5) + (((p) >> 2) & 1)) + 4 * (((p) >> 3) & 3) + ((p) & 3))
#define M4_COL(mt) (32 * ((mt) >> 1) + 8 * g + 4 * ((mt) & 1))
#define M4_STAGE_LD(step) _Pragma("unroll") for (int k = 0; k < 8; ++k) sr[k] = *(const v4u*)(sbase + (size_t)(step) * 32768 + (size_t)k * 4096)
#define M4_STAGE_ST(buf) _Pragma("unroll") for (int k = 0; k < 8; ++k) { const int c = tid + 512 * k; *(LAS v4u*)(F.lds + (buf) * HB + (c >> 10) * (64 * TSR) + M4_RHO((c >> 4) & 63) * TSR + ((c & 15) << 4)) = sr[k]; }
    u64 yq[2][4], xq[2][4], zq[2][4]; float cfq[2], cbq[2], dq[2];
#define M4_EPI_LD(step) _Pragma("unroll") for (int j = 0; j < 2; ++j) { const int hh_ = 2 * (step) + j; \
        _Pragma("unroll") for (int mt = 0; mt < 4; ++mt) { const int c = hh_ * 64 + M4_COL(mt); yq[j][mt] = *(const u64*)(pYS + m * 1024 + c); xq[j][mt] = *(const u64*)(pSX + m * 1024 + c); \
            zq[j][mt] = *(const u64*)(pP + m * INP + PC_Z + c); } \
        cfq[j] = pCUMF[m * 16 + hh_]; cbq[j] = pRCUMB[m * 16 + hh_]; dq[j] = dskp[hh_]; }
    const int s0 = cr & 7;
    M4_STAGE_LD(s0); M4_EPI_LD(s0);
    __syncthreads();
    M4_STAGE_ST(0);
    __syncthreads();
    bf16x8 cf[4]; float ssq = 0.f;
    for (int s = 0; s < 8; ++s) { const int sp = (s + s0) & 7, spn = (s + 1 + s0) & 7;
        if (s == 0 || (sp & 3) == 0) {
#pragma unroll
            for (int ks = 0; ks < 4; ++ks) cf[ks] = *(const bf16x8*)(pSC + m * 256 + (sp >> 2) * 128 + 32 * ks + 8 * g); }
        if (s < 7) { M4_STAGE_LD(spn); }
        ldsp T = F.lds + (s & 1) * HB;
        f32x4 acc[2][2][4];
#pragma unroll
        for (int j = 0; j < 2; ++j)
#pragma unroll
            for (int dir = 0; dir < 2; ++dir) { zero_acc(acc[j][dir]); if (flags & 1) mma_xt<4>(acc[j][dir], T + (2 * j + dir) * (64 * TSR), TSR, cf, lane); }
        if (flags & 2)
#pragma unroll
        for (int j = 0; j < 2; ++j) { const float ef = __builtin_amdgcn_exp2f(cfq[j]), eb = __builtin_amdgcn_exp2f(cbq[j]), dsk = dq[j];
#pragma unroll
            for (int mt = 0; mt < 4; ++mt) { const int c = (2 * sp + j) * 64 + M4_COL(mt);
                const unsigned x0 = (unsigned)xq[j][mt], x1 = (unsigned)(xq[j][mt] >> 32), z0 = (unsigned)zq[j][mt], z1 = (unsigned)(zq[j][mt] >> 32), y0 = (unsigned)yq[j][mt], y1 = (unsigned)(yq[j][mt] >> 32);
                f32x4 y = (f32x4){bflo(y0), bfhi(y0), bflo(y1), bfhi(y1)} + acc[j][0][mt] * ef + acc[j][1][mt] * eb;
                y[0] = (y[0] + dsk * bflo(x0)) * silu(bflo(z0)); y[1] = (y[1] + dsk * bfhi(x0)) * silu(bfhi(z0)); y[2] = (y[2] + dsk * bflo(x1)) * silu(bflo(z1)); y[3] = (y[3] + dsk * bfhi(x1)) * silu(bfhi(z1));
                ssq += (y[0] * y[0] + y[1] * y[1]) + (y[2] * y[2] + y[3] * y[3]);
                *(u64*)(pA + m * D + 1024 + c) = (u64)pk2(y[0], y[1]) | ((u64)pk2(y[2], y[3]) << 32); } }
        if (s < 7) { M4_EPI_LD(spn); M4_STAGE_ST((s + 1) & 1); }
        __syncthreads();
    }
#undef M4_RHO
#undef M4_STAGE_LD
#undef M4_STAGE_ST
#undef M4_EPI_LD
    ssq += __shfl_xor(ssq, 16); ssq += __shfl_xor(ssq, 32);
    const float rs = rsq(ssq * (1.0f / 1024.0f) + EPS);
    if (flags & 4)
#pragma unroll
    for (int bq = 0; bq < 4; ++bq) { u64 v[16]; f32x4 nv[16];
#pragma unroll
        for (int k = 0; k < 16; ++k) { const int c = (4 * bq + (k >> 2)) * 64 + M4_COL(k & 3); v[k] = *(const u64*)(pA + m * D + 1024 + c); nv[k] = *(const f32x4*)(nw + c); }
#pragma unroll
        for (int k = 0; k < 16; ++k) { const unsigned v0 = (unsigned)v[k], v1 = (unsigned)(v[k] >> 32); const f32x4 sc = nv[k] * rs;
            *(u64*)(pA + m * D + 1024 + (4 * bq + (k >> 2)) * 64 + M4_COL(k & 3)) = (u64)pk2(bflo(v0) * sc[0], bfhi(v0) * sc[1]) | ((u64)pk2(bflo(v1) * sc[2], bfhi(v1) * sc[3]) << 32); } }
#undef M4_COL
}
#if defined(PROBE_SEG)
#define SEG_BEGIN(id) unsigned long long segt0_##id = 0; if ((PROBE_SEG >> (id)) & 1) segt0_##id = __builtin_amdgcn_s_memrealtime();
#define SEG_END(id) if ((PROBE_SEG >> (id)) & 1) { __syncthreads(); const unsigned long long t1_ = __builtin_amdgcn_s_memrealtime(); while (__builtin_amdgcn_s_memrealtime() - t1_ < t1_ - segt0_##id) __builtin_amdgcn_s_sleep(16); __syncthreads(); }
#else
#define SEG_BEGIN(id)
#define SEG_END(id)
#endif
__device__ __forceinline__ void ph_m4(Frame& F, int layer, bool ctx_out, int which = 3) {
    const int bid = opaque_s(F.bid);
    const int ncr = ctx_out ? NCR : 128;
    if (bid < ncr) { if (which & 1) {
#ifdef PROBE_M4FLAGS
        for (int rep_ = 0; rep_ < 4; ++rep_) m4_ssd_unit(F, layer, bid, opaque_s(PROBE_M4FLAGS));
#endif
        SEG_BEGIN(0) m4_ssd_unit(F, layer, bid); SEG_END(0) } }
    else if (which & 2) { SEG_BEGIN(1) for (int u = bid - ncr; u < ncr * 4; u += F.G - ncr) m4_ret_unit(F, layer, u >> 2, u & 3); SEG_END(1) }
    __syncthreads();
    SEG_BEGIN(2)
    if (ctx_out && which == 3) convert_set(F, layer + 1, false, ncr, 1);
    SEG_END(2)
}

constexpr int PH_PER_LAYER = 13, PH_TOTAL = 3 + NLAYER * PH_PER_LAYER;
__global__ void __launch_bounds__(NTHR, 2) fwd_kernel(Args args) {
    extern __shared__ __attribute__((aligned(16))) unsigned char lds_raw[];
    Frame F;
    F.lds = (ldsp)lds_raw; F.MISC = (volatile LAS unsigned*)(F.lds + MISC_OFF);
    F.tid = threadIdx.x; F.lane = F.tid & 63; F.wave = __builtin_amdgcn_readfirstlane(F.tid >> 6); F.G = gridDim.x; F.bid = blockIdx.x;
    F.out = args.out; unsigned char* ws = args.ws; F.ws = ws;
    for (int u = F.tid; u < (LDS_BYTES - MISC_OFF) / 4; u += NTHR) ((LAS unsigned*)(F.lds + MISC_OFF))[u] = 0u;
    __syncthreads();
    const int lo = args.ph_lo, hi = args.ph_hi;
    XcdBarrier bar; bar.bar = (unsigned*)(ws + WS_CTL) + CW_BAR; bar.x = 0; bar.st = nullptr;
    if (hi - lo > 1) bar = xcd_barrier_post((unsigned*)(ws + WS_CTL) + CW_BAR, F.MISC + 8);
#define IN(k) ((unsigned)(opaque_s(k) - lo) < (unsigned)(hi - lo))
#if defined(PROBE_REP) && (PROBE_REP & 8)
#define PROBE_ROWS(x) x __syncthreads();
#else
#define PROBE_ROWS(x)
#endif
#if defined(PROBE_SPIN)
#ifndef PROBE_MULT
#define PROBE_MULT 1
#endif
    unsigned long long tprev_ = __builtin_amdgcn_s_memrealtime();
#define SEAM(k) do { if (IN(k) && IN((k) + 1)) xcd_barrier(bar); \
        if (((unsigned long long)(PROBE_SPIN) >> (k)) & 1ull) { const unsigned long long t1_ = __builtin_amdgcn_s_memrealtime(); \
            while (__builtin_amdgcn_s_memrealtime() - t1_ < (unsigned long long)(PROBE_MULT) * (t1_ - tprev_)) __builtin_amdgcn_s_sleep(16); __syncthreads(); } \
        tprev_ = __builtin_amdgcn_s_memrealtime(); } while (0)
#else
#define SEAM(k) do { if (IN(k) && IN((k) + 1)) xcd_barrier(bar); } while (0)
#endif

    if (IN(0)) { ph_adaln_partial(F); convert_set(F, 0, false, 0);
    }
    SEAM(0);
    if (IN(1)) ph_mod_reduce(F);
    SEAM(1);
    if (IN(2)) ph_rows<false, false>(F, M, inp(I_X), inp(I_CTX), nullptr, nullptr, nullptr, nullptr, nullptr, 0, nullptr, 0.f, wsb(F, WS_A), wsf(F, WS_MOD), 0, inp(I_NORMW));
    SEAM(2);
    for (int layer = 0; layer < NLAYER; ++layer) {
        const int pb = 3 + layer * PH_PER_LAYER; const bool last = layer == NLAYER - 1; const int Mrows = last ? ML : M;
#define modL (wsf(F, WS_MOD) + (size_t)layer * 5 * NMODC)
#define nw (inp(I_NORMW) + (size_t)layer * 6 * D)
        if (IN(pb + 0)) { pg8::Gemm gm{wsb(F, WS_A), wsb(F, WS_WGU1), D, D}; pg8::StaticOrder S; S.init(M, NGU, D, F.G, opaque_s(F.bid)); pg8::EpiSwiGLU E{wsb(F, WS_PH), DFF};
            pg8::gemm_phase<pg8::EpiSwiGLU, pg8::StaticOrder, true, true>(F.lds + RING_OFF, gm, S, E);
#if defined(PROBE_REP) && (PROBE_REP & 4)
            __syncthreads(); pg8::gemm_phase<pg8::EpiSwiGLU, pg8::StaticOrder, true, true>(F.lds + RING_OFF, gm, S, E);
#endif
        }
        if (IN(pb + 0)) convert_set(F, layer, true, (M / 256) * (NGU / 256) % F.G, 3);
        SEAM(pb + 0);
        if (IN(pb + 1)) { pg8::Gemm gm{wsb(F, WS_PH), wsb(F, WS_WD1), DFF, DFF}; pg8::StaticOrder S; S.init(ML, D, DFF, F.G, opaque_s(F.bid), MC, KSPLIT); pg8::EpiYbf16 E{wsb(F, WS_Y), D, wsb(F, WS_YP), ML, MC};
            pg8::gemm_phase<pg8::EpiYbf16, pg8::StaticOrder, true, true>(F.lds + RING_OFF, gm, S, E);
#if defined(PROBE_REP) && (PROBE_REP & 128)
            __syncthreads(); pg8::gemm_phase<pg8::EpiYbf16, pg8::StaticOrder, true, true>(F.lds + RING_OFF, gm, S, E);
#endif
        }
        if (IN(pb + 1)) convert_set(F, layer, true, (MC / 256) * (D / 256) * KSPLIT, 2);
        SEAM(pb + 1);
        if (IN(pb + 2)) { bf16* xb = wsb(F, WS_XB);
            if (layer == 0) ph_rows<false, true>(F, M, inp(I_X), inp(I_CTX), xb, xb + (size_t)ML * D, wsb(F, WS_Y), wsb(F, WS_YP), modL, 2, nw + D, 0.5f, wsb(F, WS_A), modL, 3, nw + 2 * D);
            else ph_rows<true, true>(F, M, xb, xb + (size_t)ML * D, xb, xb + (size_t)ML * D, wsb(F, WS_Y), wsb(F, WS_YP), modL, 2, nw + D, 0.5f, wsb(F, WS_A), modL, 3, nw + 2 * D); }
        SEAM(pb + 2);
        if (IN(pb + 3)) { pg8::Gemm gm{wsb(F, WS_A), wsb(F, WS_WIN), D, D}; pg8::StaticOrder S; S.init(M, INP, D, F.G, opaque_s(F.bid)); pg8::EpiProj E{wsb(F, WS_PH), INP};
            pg8::gemm_phase<pg8::EpiProj, pg8::StaticOrder, true, true>(F.lds + RING_OFF, gm, S, E);
#if defined(PROBE_REP) && (PROBE_REP & 256)
            __syncthreads(); pg8::gemm_phase<pg8::EpiProj, pg8::StaticOrder, true, true>(F.lds + RING_OFF, gm, S, E);
#endif
        }
        if (IN(pb + 3)) convert_set(F, layer, true, (M / 256) * (INP / 256) % F.G, 4);
        SEAM(pb + 3);
        if (IN(pb + 4)) { { SEG_BEGIN(6) ph_dt_tasks(F, layer); SEG_END(6) } ph_prep(F, layer);
#if defined(PROBE_REP) && (PROBE_REP & 1)
            ph_prep(F, layer);
#endif
        }
        SEAM(pb + 4);
        if (IN(pb + 5)) { ph_m2(F, layer, !last);
#if defined(PROBE_REP) && (PROBE_REP & 2)
            for (int rep_ = 0; rep_ < 4; ++rep_) ph_m2(F, layer, !last, PROBE_WHICH);
#endif
        }
        SEAM(pb + 5);
        if (IN(pb + 6)) {
#if defined(PROBE_REP) && (PROBE_REP & 32)
            ph_scan(F, layer); __syncthreads();
#endif
            ph_scan(F, layer); }
        SEAM(pb + 6);
        if (IN(pb + 7)) {
#if defined(PROBE_REP) && (PROBE_REP & 64)
            for (int rep_ = 0; rep_ < 4; ++rep_) { ph_m4(F, layer, !last, PROBE_WHICH); __syncthreads(); }
#endif
            ph_m4(F, layer, !last); }
        SEAM(pb + 7);
        if (IN(pb + 8)) { pg8::Gemm gm{wsb(F, WS_A), wsb(F, WS_WOUT), D, D}; pg8::StaticOrder S; S.init(ML, D, D, F.G, opaque_s(F.bid), last ? 0 : MC, KSPLIT); pg8::EpiYbf16 E{wsb(F, WS_Y), D, wsb(F, WS_YP), ML, MC};
            pg8::gemm_phase<pg8::EpiYbf16, pg8::StaticOrder, true, true>(F.lds + RING_OFF, gm, S, E); }
        SEAM(pb + 8);
        if (IN(pb + 9)) ph_rows<true, true>(F, Mrows, wsb(F, WS_XB), wsb(F, WS_XB) + (size_t)ML * D, wsb(F, WS_XB), wsb(F, WS_XB) + (size_t)ML * D, wsb(F, WS_Y), wsb(F, WS_YP), modL, 5, nw + 3 * D, 1.0f, wsb(F, WS_A), modL, 6, nw + 4 * D);
        SEAM(pb + 9);
        if (IN(pb + 10)) { pg8::Gemm gm{wsb(F, WS_A), wsb(F, WS_WGU2), D, D}; pg8::StaticOrder S; S.init(Mrows, NGU, D, F.G, opaque_s(F.bid)); pg8::EpiSwiGLU E{wsb(F, WS_PH), DFF};
            pg8::gemm_phase<pg8::EpiSwiGLU, pg8::StaticOrder, true, true>(F.lds + RING_OFF, gm, S, E); }
        if (IN(pb + 10) && !last) convert_set(F, layer + 1, false, (M / 256) * (NGU / 256) % F.G, 5);
        SEAM(pb + 10);
        if (IN(pb + 11)) { pg8::Gemm gm{wsb(F, WS_PH), wsb(F, WS_WD2), DFF, DFF}; pg8::StaticOrder S; S.init(ML, D, DFF, F.G, opaque_s(F.bid), last ? 0 : MC, KSPLIT); pg8::EpiYbf16 E{wsb(F, WS_Y), D, wsb(F, WS_YP), ML, MC};
            pg8::gemm_phase<pg8::EpiYbf16, pg8::StaticOrder, true, true>(F.lds + RING_OFF, gm, S, E); }
        if (IN(pb + 11) && !last) convert_set(F, layer + 1, false, (MC / 256) * (D / 256) * KSPLIT, 6);
        SEAM(pb + 11);
        if (IN(pb + 12)) {
            if (!last) { ph_rows<true, true>(F, M, wsb(F, WS_XB), wsb(F, WS_XB) + (size_t)ML * D, wsb(F, WS_XB), wsb(F, WS_XB) + (size_t)ML * D, wsb(F, WS_Y), wsb(F, WS_YP), modL, 8, nw + 5 * D, 0.5f, wsb(F, WS_A), modL + 5 * NMODC, 0, nw + 6 * D);
            }
            else ph_rows<true, false>(F, ML, wsb(F, WS_XB), wsb(F, WS_XB) + (size_t)ML * D, F.out, nullptr, wsb(F, WS_Y), nullptr, modL, 8, nw + 5 * D, 0.5f, nullptr, nullptr, 0, nullptr);
        }
        SEAM(pb + 12);
    }
#undef modL
#undef nw
#undef IN
#undef SEAM
}

#ifndef MK_SINGLE
#define MK_SINGLE 1
#endif
extern "C" void kernel_launch(void* const* d_in, const int* in_sizes, int n_in, void* d_out, int out_size, void* d_ws, size_t ws_size, hipStream_t stream) {
    static int grid = 0;
    if (grid == 0) {
        if (n_in != 22 || in_sizes[0] != ML * D || out_size != ML * D || ws_size < WS_END) { fprintf(stderr, "kernel_launch: unexpected shapes (n_in %d, in0 %d, out %d, ws %zu < %zu?); nothing launched\n", n_in, n_in > 0 ? in_sizes[0] : -1, out_size, ws_size, (size_t)WS_END); grid = -1; return; }
        int dev = 0, cus = 0, per_cu = 0;
        if (hipGetDevice(&dev) != hipSuccess || hipDeviceGetAttribute(&cus, hipDeviceAttributeMultiprocessorCount, dev) != hipSuccess) { grid = -1; return; }
        if (hipFuncSetAttribute((const void*)fwd_kernel, hipFuncAttributeMaxDynamicSharedMemorySize, LDS_BYTES) != hipSuccess) { fprintf(stderr, "kernel_launch: hipFuncSetAttribute failed\n"); grid = -1; return; }
        if (hipOccupancyMaxActiveBlocksPerMultiprocessor(&per_cu, (const void*)fwd_kernel, NTHR, LDS_BYTES) != hipSuccess || per_cu < 1) fprintf(stderr, "kernel_launch: occupancy query reports %d\n", per_cu);
        (void)hipGetLastError();
        grid = cus;
    }
    if (grid < 0) return;
    (void)hipMemsetAsync((char*)d_ws + WS_CTL, 0, CTL_ZERO_BYTES, stream);
    Args a{};
    for (int i = 0; i < 22; ++i) a.in[i] = (const float*)d_in[i];
    a.out = (float*)d_out; a.ws = (unsigned char*)d_ws;
#if MK_SINGLE
    a.ph_lo = 0; a.ph_hi = PH_TOTAL;
    hipLaunchKernelGGL(fwd_kernel, dim3(grid), dim3(NTHR), LDS_BYTES, stream, a);
#else
    for (int p = 0; p < PH_TOTAL; ++p) { a.ph_lo = p; a.ph_hi = p + 1; hipLaunchKernelGGL(fwd_kernel, dim3(grid), dim3(NTHR), LDS_BYTES, stream, a); }
#endif
}
```
